# Optimizing an MI355X kernel written in HIP

```python
import math
import jax, jax.numpy as jnp
from jax import lax
import numpy as np

D_MODEL = 1024
BATCH = 8
SEQ = 4096
DEPTH = 4

N_EVEN = (DEPTH + 1) // 2
N_ODD = DEPTH // 2
EPS = 1e-6

GM_GROUPS = 4
GM_CH = D_MODEL // 8
GM_WIDTH = GM_GROUPS * GM_CH
GM_CHUNK = 128
POOL_WINDOWS = (2, 4, 8, 16)
POOL_GROUPS = len(POOL_WINDOWS)
POOL_CH = D_MODEL // 8
POOL_WIDTH = POOL_GROUPS * POOL_CH
POOL_MAXW = max(POOL_WINDOWS)
EVEN_IN = 2 * GM_WIDTH + POOL_WIDTH
EVEN_MIX = GM_WIDTH + POOL_WIDTH

DA_HEADS = D_MODEL // 128
DA_QK_DIM = 64
DA_V_DIM = 2 * DA_QK_DIM
DA_Q_WIDTH = DA_HEADS * 2 * DA_QK_DIM
DA_V_WIDTH = DA_HEADS * DA_V_DIM
ODD_IN = 2 * DA_Q_WIDTH + DA_V_WIDTH
Q_BLOCK = 128
ROPE_THETA = 10000.0

PEER_HEADS = 8
PEER_NKEYS = 128
PEER_EXPERTS = PEER_NKEYS * PEER_NKEYS
PEER_QDIM = 256
PEER_HALF = PEER_QDIM // 2
PEER_TOPK = 16
PEER_TOKEN_BLOCK = 128

kernel_name = "hybrid_gmlp_pool_diffattn_peer_adaln"


def rmsnorm(x, g):
    xf = x.astype(jnp.float32)
    y = xf * lax.rsqrt(jnp.mean(xf * xf, axis=-1, keepdims=True) + EPS) * g
    return y.astype(x.dtype)


def apply_rope(t, cos, sin):
    t1, t2 = jnp.split(t, 2, axis=-1)
    return jnp.concatenate([t1 * cos - t2 * sin, t2 * cos + t1 * sin], axis=-1)


def chunked_spatial_gating(u, v, w_s, b_s, g_v):
    B, S, _ = v.shape
    vf = v.astype(jnp.float32)
    mu = jnp.mean(vf, axis=-1, keepdims=True)
    var = jnp.mean((vf - mu) ** 2, axis=-1, keepdims=True)
    vn = ((vf - mu) * lax.rsqrt(var + EPS) * g_v).astype(v.dtype)
    vn = vn.reshape(B, S // GM_CHUNK, GM_CHUNK, GM_GROUPS, GM_CH)
    causal = jnp.tril(jnp.ones((GM_CHUNK, GM_CHUNK), dtype=bool))
    w = jnp.where(causal[None], w_s, 0)
    sv = jnp.einsum('gts,bnsgc->bntgc', w, vn) + b_s.T[None, None, :, :, None]
    return u * sv.reshape(B, S, GM_WIDTH)


def multiscale_pool(p, w_pool, ls):
    B, S, _ = p.shape
    pf = p.astype(jnp.float32)
    cs = jnp.cumsum(pf, axis=1)
    cs_pad = jnp.pad(cs, ((0, 0), (POOL_MAXW, 0), (0, 0)))
    t = jnp.arange(S)
    outs = []
    for g, w in enumerate(POOL_WINDOWS):
        sl = slice(g * POOL_CH, (g + 1) * POOL_CH)
        lag = cs_pad[:, POOL_MAXW - w:POOL_MAXW - w + S, sl]
        cnt = jnp.minimum(t + 1, w).astype(jnp.float32)[None, :, None]
        outs.append((cs[..., sl] - lag) / cnt - pf[..., sl])
    pooled = jnp.stack(outs, axis=2).astype(p.dtype)
    mixed = jnp.einsum('bsgc,gcd->bsgd', pooled, w_pool).reshape(B, S, POOL_WIDTH)
    return mixed * ls


def diff_attention(h, w_in, lam_q1, lam_k1, lam_q2, lam_k2, g_sub, w_out, cos, sin, lam_init):
    B, S, _ = h.shape
    proj = h @ w_in
    q = proj[..., :DA_Q_WIDTH].reshape(B, S, DA_HEADS, 2, DA_QK_DIM)
    k = proj[..., DA_Q_WIDTH:2 * DA_Q_WIDTH].reshape(B, S, DA_HEADS, 2, DA_QK_DIM)
    v = proj[..., 2 * DA_Q_WIDTH:].reshape(B, S, DA_HEADS, DA_V_DIM)
    q = apply_rope(q, cos, sin)
    k = apply_rope(k, cos, sin)
    lam = (jnp.exp(jnp.sum(lam_q1.astype(jnp.float32) * lam_k1.astype(jnp.float32)))
           - jnp.exp(jnp.sum(lam_q2.astype(jnp.float32) * lam_k2.astype(jnp.float32)))
           + lam_init)
    scale = DA_QK_DIM ** -0.5
    outs = []
    for i in range(S // Q_BLOCK):
        kv_len = (i + 1) * Q_BLOCK
        q_i = q[:, i * Q_BLOCK:kv_len]
        s = jnp.einsum('bqhmd,bkhmd->bhmqk', q_i, k[:, :kv_len]).astype(jnp.float32) * scale
        q_pos = i * Q_BLOCK + jnp.arange(Q_BLOCK)
        mask = jnp.arange(kv_len)[None, :] <= q_pos[:, None]
        s = jnp.where(mask, s, -jnp.inf)
        pr = jax.nn.softmax(s, axis=-1)
        a = pr[:, :, 0] - lam * pr[:, :, 1]
        outs.append(jnp.einsum('bhqk,bkhd->bqhd', a.astype(v.dtype), v[:, :kv_len]))
    o = jnp.concatenate(outs, axis=1).astype(jnp.float32)
    o = o * lax.rsqrt(jnp.mean(o * o, axis=-1, keepdims=True) + EPS) * g_sub * (1.0 - lam_init)
    return o.astype(h.dtype).reshape(B, S, DA_V_WIDTH) @ w_out


def peer(h, w_q, sub_keys, u_emb, v_emb):
    B, S, D = h.shape
    T = PEER_TOKEN_BLOCK
    K = PEER_TOPK
    hb = h.reshape(B * S // T, T, D)

    def block(x_t):
        q = jnp.einsum('td,dhk->thk', x_t, w_q).reshape(T, PEER_HEADS, 2, PEER_HALF)
        s = jnp.einsum('thpk,hpnk->thpn', q, sub_keys).astype(jnp.float32)
        sv, si = lax.top_k(s, K)
        cand = (sv[:, :, 0, :, None] + sv[:, :, 1, None, :]).reshape(T, PEER_HEADS, K * K)
        cidx = (si[:, :, 0, :, None] * PEER_NKEYS + si[:, :, 1, None, :]).reshape(T, PEER_HEADS, K * K)
        fv, fpos = lax.top_k(cand, K)
        eidx = jnp.take_along_axis(cidx, fpos, axis=-1)
        gate = jax.nn.softmax(fv, axis=-1)
        u = u_emb[eidx]
        v = v_emb[eidx]
        act = jax.nn.gelu(jnp.einsum('thkd,td->thk', u, x_t).astype(jnp.float32), approximate=False)
        return jnp.einsum('thk,thkd->td', (gate * act).astype(x_t.dtype), v)

    return lax.map(block, hb).reshape(B, S, D)


def setup_inputs(seed: int = 0) -> dict:
    key = jax.random.key(seed)
    ks = jax.random.split(key, 32)
    f32 = jnp.float32
    D = D_MODEL

    def nrm(k, shape, scale):
        return jax.random.normal(k, shape, f32) * scale

    def gain(k, shape):
        return 1.0 + 0.02 * jax.random.normal(k, shape, f32)

    return {
        "x": nrm(ks[0], (BATCH, SEQ, D), 1.0),
        "c": nrm(ks[1], (BATCH, D), 1.0),
        "positions": jnp.tile(jnp.arange(SEQ, dtype=jnp.int32)[None, :], (BATCH, 1)),
        "ada_w": nrm(ks[2], (DEPTH, D, 6 * D), 0.5 * D ** -0.5),
        "ada_b": nrm(ks[3], (DEPTH, 6 * D), 0.02),
        "norm_mix": gain(ks[4], (DEPTH, D)),
        "norm_ffn": gain(ks[5], (DEPTH, D)),
        "ev_w_in": nrm(ks[6], (N_EVEN, D, EVEN_IN), D ** -0.5),
        "ev_g_v": gain(ks[7], (N_EVEN, GM_WIDTH)),
        "ev_w_s": nrm(ks[8], (N_EVEN, GM_GROUPS, GM_CHUNK, GM_CHUNK), GM_CHUNK ** -0.5),
        "ev_b_s": gain(ks[9], (N_EVEN, GM_GROUPS, GM_CHUNK)),
        "ev_w_pool": nrm(ks[10], (N_EVEN, POOL_GROUPS, POOL_CH, POOL_CH), POOL_CH ** -0.5),
        "ev_pool_scale": gain(ks[11], (N_EVEN, POOL_WIDTH)),
        "ev_w_out": nrm(ks[12], (N_EVEN, EVEN_MIX, D), EVEN_MIX ** -0.5),
        "od_w_in": nrm(ks[13], (N_ODD, D, ODD_IN), D ** -0.5),
        "od_lam_q1": nrm(ks[14], (N_ODD, DA_QK_DIM), 0.1),
        "od_lam_k1": nrm(ks[15], (N_ODD, DA_QK_DIM), 0.1),
        "od_lam_q2": nrm(ks[16], (N_ODD, DA_QK_DIM), 0.1),
        "od_lam_k2": nrm(ks[17], (N_ODD, DA_QK_DIM), 0.1),
        "od_g_sub": gain(ks[18], (N_ODD, DA_V_DIM)),
        "od_w_out": nrm(ks[19], (N_ODD, DA_V_WIDTH, D), DA_V_WIDTH ** -0.5),
        "peer_w_q": nrm(ks[20], (DEPTH, D, PEER_HEADS, PEER_QDIM), D ** -0.5),
        "peer_sub_keys": nrm(ks[21], (DEPTH, PEER_HEADS, 2, PEER_NKEYS, PEER_HALF), PEER_HALF ** -0.5),
        "peer_u": nrm(ks[22], (DEPTH, PEER_EXPERTS, D), D ** -0.5),
        "peer_v": nrm(ks[23], (DEPTH, PEER_EXPERTS, D), PEER_HEADS ** -0.5),
        "final_norm": gain(ks[24], (D,)),
    }


def reference(x, c, positions, ada_w, ada_b, norm_mix, norm_ffn,
              ev_w_in, ev_g_v, ev_w_s, ev_b_s, ev_w_pool, ev_pool_scale, ev_w_out,
              od_w_in, od_lam_q1, od_lam_k1, od_lam_q2, od_lam_k2, od_g_sub, od_w_out,
              peer_w_q, peer_sub_keys, peer_u, peer_v, final_norm):
    B, S, D = x.shape
    inv_freq = 1.0 / (ROPE_THETA ** (jnp.arange(0, DA_QK_DIM, 2, dtype=jnp.float32) / DA_QK_DIM))
    ang = positions.astype(jnp.float32)[..., None] * inv_freq
    cos = jnp.cos(ang)[:, :, None, None, :].astype(x.dtype)
    sin = jnp.sin(ang)[:, :, None, None, :].astype(x.dtype)
    c_act = jax.nn.silu(c)
    for l in range(DEPTH):
        mod = (c_act @ ada_w[l] + ada_b[l]).reshape(B, 6, D)[:, :, None, :]
        sh1, sc1, g1, sh2, sc2, g2 = (mod[:, i] for i in range(6))
        h = rmsnorm(x, norm_mix[l]) * (1 + sc1) + sh1
        if l % 2 == 0:
            e = l // 2
            proj = h @ ev_w_in[e]
            z = jax.nn.gelu(proj[..., :2 * GM_WIDTH], approximate=False)
            ya = chunked_spatial_gating(z[..., :GM_WIDTH], z[..., GM_WIDTH:],
                                        ev_w_s[e], ev_b_s[e], ev_g_v[e])
            yb = multiscale_pool(proj[..., 2 * GM_WIDTH:], ev_w_pool[e], ev_pool_scale[e])
            y = jnp.concatenate([ya, yb], axis=-1) @ ev_w_out[e]
        else:
            o = l // 2
            lam_init = 0.8 - 0.6 * math.exp(-0.3 * l)
            y = diff_attention(h, od_w_in[o], od_lam_q1[o], od_lam_k1[o], od_lam_q2[o],
                               od_lam_k2[o], od_g_sub[o], od_w_out[o], cos, sin, lam_init)
        x = x + g1 * y
        h = rmsnorm(x, norm_ffn[l]) * (1 + sc2) + sh2
        x = x + g2 * peer(h, peer_w_q[l], peer_sub_keys[l], peer_u[l], peer_v[l])
    return rmsnorm(x, final_norm)
```

```cpp
#include <hip/hip_runtime.h>
__device__ __forceinline__ int mk_lane() { int l = (int)__builtin_amdgcn_mbcnt_hi(~0u, __builtin_amdgcn_mbcnt_lo(~0u, 0u)); asm volatile("" : "+v"(l)); return l; }
#define MK_TID(wave_s) ((wave_s) * 64 + mk_lane())
template <class T> __device__ __forceinline__ T lshfl(T v, int src) { return __builtin_bit_cast(T, __builtin_amdgcn_ds_bpermute(src << 2, __builtin_bit_cast(int, v))); }
#include <hip/hip_runtime.h>
#include <cstdio>
#include <cstdint>
namespace pg8 {
#define PG8_LAS __attribute__((address_space(3)))
typedef unsigned short bf16_t;
typedef short bf16x8 __attribute__((ext_vector_type(8)));
typedef float f32x4 __attribute__((ext_vector_type(4)));
typedef unsigned u32x4 __attribute__((ext_vector_type(4)));
constexpr int BM = 256, BK = 64, HALF = 128, HTB = HALF * BK * 2  , STAGE_BYTES = 8 * HTB, NXCD = 8, WGM = 8;

__host__ __device__ __forceinline__ int lds_byte(int r, int c) { const int st = (r >> 4) * 2 + (c >> 5), rr = r & 15, cc = c & 31, ob = rr * 64 + cc * 2; return st * 1024 + (ob ^ (((ob >> 9) & 1) << 5)); }
__host__ __device__ __forceinline__ void stage_rc(int b, int& R, int& C) { const int st = b / 1024, sb = b % 1024, swz = sb ^ (((sb >> 9) & 1) << 5); R = (st >> 1) * 16 + swz / 64; C = (st & 1) * 32 + (swz % 64) / 2; }
__host__ __device__ __forceinline__ int perm32(int rho) { const int n = rho >> 4, i = rho & 15; return 8 * (i >> 2) + 4 * n + (i & 3); }

struct Unit { int pm, pn; };
typedef int pg8_v4i __attribute__((ext_vector_type(4)));
typedef int pg8_v8i __attribute__((ext_vector_type(8)));
constexpr int FP8_SCALE_A = 0x7c7c7c7c, FP8_SCALE_W = 0x77777777;
struct Gemm { const bf16_t* A; const bf16_t* Bt; int M, N, K, lda; };

struct StaticOrder {
    int nM, nN, nwg, G, c;
    __host__ __device__ void init(int M, int N, int G_, int c_) { nM = M / BM; nN = N / BM; nwg = nM * nN; G = G_; c = c_; }
    __host__ __device__ bool next(int i, Unit& u) const {
        const long L = (long)i * G + c; if (L >= nwg) return false;
        int wgid = (int)L; { const int q = nwg / NXCD, r = nwg % NXCD, xcd = wgid % NXCD, off = wgid / NXCD; wgid = (xcd < r ? xcd * (q + 1) : r * (q + 1) + (xcd - r) * q) + off; }
        const int nig = WGM * nN, gid = wgid / nig, fm = gid * WGM, gsz = (nM - fm) < WGM ? (nM - fm) : WGM;
        u.pm = fm + ((wgid % nig) % gsz); u.pn = (wgid % nig) / gsz; return true;
    }
    __device__ __forceinline__ void a_ready(const Unit&) const {}
    __device__ __forceinline__ void done(const Unit&) const {}
};

__device__ __forceinline__ unsigned cvt_pk_bf16(float lo, float hi) { unsigned r; asm volatile("v_cvt_pk_bf16_f32 %0, %1, %2" : "=v"(r) : "v"(lo), "v"(hi)); return r; }
typedef float f32x2 __attribute__((ext_vector_type(2)));
__device__ __forceinline__ f32x2 gelu_pk(f32x2 v) {
    const f32x2 av = __builtin_elementwise_abs(v), d = av * 0.2316418882f + 1.0f;
    f32x2 t; t.x = __builtin_amdgcn_rcpf(d.x); t.y = __builtin_amdgcn_rcpf(d.y);
    f32x2 q = t * 0.5307027145f + (-0.7265760135f); q = q * t + 0.7107068705f; q = q * t + (-0.142248368f); q = q * t + 0.127414796f; q = q * t;
    const f32x2 s = (v * v) * (-0.72134752044f);
    f32x2 e; e.x = __builtin_amdgcn_exp2f(s.x); e.y = __builtin_amdgcn_exp2f(s.y);
    const f32x2 m = v * (q * e), r = v - m;
    f32x2 o; o.x = v.x < 0.f ? m.x : r.x; o.y = v.y < 0.f ? m.y : r.y; return o;
}

template <int ACT  > struct EpiBf16 {
    static constexpr bool PERM = true, AFTER_DRAIN = false; static_assert(ACT == 0 || ACT == 1, "EpiBf16: ACT is 0 (none) or 1 (gelu_pk)");
    bf16_t* O; int ldc; const float* bias; int split_cols; size_t split_stride; float scale0;
    __device__ __forceinline__ void operator()(const f32x4 (&acc)[2][2][4][2], const Unit& u, int wr, int wc, int fr, int fq) const {
        const int row0 = u.pm * BM + wr * 64 + fr; int colt = u.pn * BM; bf16_t* base = O;
        float sc = 1.f; if (split_cols) { const int t = colt / split_cols; base += (size_t)t * split_stride; colt -= t * split_cols; if (t == 0) sc = scale0; }
        const int col0 = colt + wc * 32 + 8 * fq, bcol0 = u.pn * BM + wc * 32 + 8 * fq;
        f32x4 bv[2][2];
#pragma unroll
        for (int bj = 0; bj < 2; ++bj)
#pragma unroll
            for (int n = 0; n < 2; ++n) bv[bj][n] = bias ? *(const f32x4*)(bias + bcol0 + bj * HALF + 4 * n) : (f32x4){0.f, 0.f, 0.f, 0.f};
#pragma unroll
        for (int ai = 0; ai < 2; ++ai)
#pragma unroll
            for (int m = 0; m < 4; ++m) { bf16_t* rowp = base + (size_t)(row0 + ai * HALF + m * 16) * ldc + col0;
#pragma unroll
                for (int bj = 0; bj < 2; ++bj) { f32x4 v0 = acc[ai][bj][m][0] + bv[bj][0], v1 = acc[ai][bj][m][1] + bv[bj][1];
                    if (ACT == 1) { f32x2 a = gelu_pk((f32x2){v0[0], v0[1]}), b = gelu_pk((f32x2){v0[2], v0[3]}), c = gelu_pk((f32x2){v1[0], v1[1]}), d = gelu_pk((f32x2){v1[2], v1[3]});
                        v0 = (f32x4){a.x, a.y, b.x, b.y}; v1 = (f32x4){c.x, c.y, d.x, d.y}; }
                    v0 = v0 * sc; v1 = v1 * sc; u32x4 w; w.x = cvt_pk_bf16(v0[0], v0[1]); w.y = cvt_pk_bf16(v0[2], v0[3]); w.z = cvt_pk_bf16(v1[0], v1[1]); w.w = cvt_pk_bf16(v1[2], v1[3]);
                    *(u32x4*)(rowp + bj * HALF) = w; } }
    }
};

struct EpiActTiles {
    static constexpr bool PERM = true, AFTER_DRAIN = false;
    bf16_t* O; int ldc; int gelu_tiles;
    __device__ __forceinline__ void operator()(const f32x4 (&acc)[2][2][4][2], const Unit& u, int wr, int wc, int fr, int fq) const {
        const int row0 = u.pm * BM + wr * 64 + fr; const int col0 = u.pn * BM + wc * 32 + 8 * fq; const bool act = u.pn < gelu_tiles;
#pragma unroll
        for (int ai = 0; ai < 2; ++ai)
#pragma unroll
            for (int m = 0; m < 4; ++m) { bf16_t* rowp = O + (size_t)(row0 + ai * HALF + m * 16) * ldc + col0;
#pragma unroll
                for (int bj = 0; bj < 2; ++bj) { f32x4 v0 = acc[ai][bj][m][0], v1 = acc[ai][bj][m][1];
                    if (act) { f32x2 a = gelu_pk((f32x2){v0[0], v0[1]}), b = gelu_pk((f32x2){v0[2], v0[3]}), c = gelu_pk((f32x2){v1[0], v1[1]}), d = gelu_pk((f32x2){v1[2], v1[3]});
                        v0 = (f32x4){a.x, a.y, b.x, b.y}; v1 = (f32x4){c.x, c.y, d.x, d.y}; }
                    u32x4 w; w.x = cvt_pk_bf16(v0[0], v0[1]); w.y = cvt_pk_bf16(v0[2], v0[3]); w.z = cvt_pk_bf16(v1[0], v1[1]); w.w = cvt_pk_bf16(v1[2], v1[3]);
                    *(u32x4*)(rowp + bj * HALF) = w; } }
    }
};
struct EpiRope {
    static constexpr bool PERM = true, AFTER_DRAIN = false;
    bf16_t* O; int ldc; const float* rope; float qscale;
    __device__ __forceinline__ void operator()(const f32x4 (&acc)[2][2][4][2], const Unit& u, int wr, int wc, int fr, int fq) const {
        const int row0 = u.pm * BM + wr * 64 + fr; const int col0 = u.pn * BM + wc * 32 + 8 * fq; const int kind = u.pn >> 2;
        const int i0 = 16 * (wc & 1) + 4 * fq;
#pragma unroll
        for (int ai = 0; ai < 2; ++ai)
#pragma unroll
            for (int m = 0; m < 4; ++m) { const int row = row0 + ai * HALF + m * 16; bf16_t* rowp = O + (size_t)row * ldc + col0;
                f32x4 cs0 = (f32x4){1.f, 0.f, 1.f, 0.f}, cs1 = cs0;
                if (kind < 2) { const float* rp = rope + ((size_t)row * 32 + i0) * 2; cs0 = *(const f32x4*)rp; cs1 = *(const f32x4*)(rp + 4); }
#pragma unroll
                for (int bj = 0; bj < 2; ++bj) { f32x4 v0 = acc[ai][bj][m][0], v1 = acc[ai][bj][m][1];
                    if (kind < 2) {
                        f32x4 r0, r1;
                        r0[0] = v0[0] * cs0[0] - v0[1] * cs0[1]; r0[1] = v0[1] * cs0[0] + v0[0] * cs0[1]; r0[2] = v0[2] * cs0[2] - v0[3] * cs0[3]; r0[3] = v0[3] * cs0[2] + v0[2] * cs0[3];
                        r1[0] = v1[0] * cs1[0] - v1[1] * cs1[1]; r1[1] = v1[1] * cs1[0] + v1[0] * cs1[1]; r1[2] = v1[2] * cs1[2] - v1[3] * cs1[3]; r1[3] = v1[3] * cs1[2] + v1[2] * cs1[3];
                        v0 = r0; v1 = r1;
                        if (kind == 0) { v0 = v0 * qscale; v1 = v1 * qscale; } }
                    u32x4 w; w.x = cvt_pk_bf16(v0[0], v0[1]); w.y = cvt_pk_bf16(v0[2], v0[3]); w.z = cvt_pk_bf16(v1[0], v1[1]); w.w = cvt_pk_bf16(v1[2], v1[3]);
                    *(u32x4*)(rowp + bj * HALF) = w; } }
    }
};
template <bool BASE_F32>
struct EpiResid {
    static constexpr bool PERM = false, AFTER_DRAIN = false;
    const void* base; bf16_t* out; const float* gate; int gpitch; const float* gain2; const float* sc2; bf16_t* xs; float* ssq;
    typedef unsigned u32x2v __attribute__((ext_vector_type(2)));
    __device__ __forceinline__ f32x4 ldbase(size_t off) const {
        if constexpr (BASE_F32) return *(const f32x4*)((const float*)base + off);
        else { const u32x2v r = *(const u32x2v*)((const bf16_t*)base + off); return (f32x4){__builtin_bit_cast(float, r.x << 16), __builtin_bit_cast(float, r.x & 0xffff0000u), __builtin_bit_cast(float, r.y << 16), __builtin_bit_cast(float, r.y & 0xffff0000u)}; } }
    __device__ __forceinline__ void operator()(const f32x4 (&acc)[2][2][4][2], const Unit& u, int wr, int wc, int fr, int fq) const {
        const int row0 = u.pm * BM + wr * 64 + fr; const int col0 = u.pn * BM + wc * 32 + 4 * fq; const int b = (u.pm * BM) >> 12;
        f32x4 gv[2][2], gs[2][2];
#pragma unroll
        for (int bj = 0; bj < 2; ++bj)
#pragma unroll
            for (int n = 0; n < 2; ++n) { gv[bj][n] = *(const f32x4*)(gate + (size_t)b * gpitch + col0 + bj * HALF + n * 16);
                gs[bj][n] = *(const f32x4*)(gain2 + col0 + bj * HALF + n * 16) * (*(const f32x4*)(sc2 + (size_t)b * gpitch + col0 + bj * HALF + n * 16) + 1.0f); }
        f32x4 xb[2][2][2];
#pragma unroll
        for (int bj = 0; bj < 2; ++bj)
#pragma unroll
            for (int n = 0; n < 2; ++n) xb[0][bj][n] = ldbase((size_t)row0 * 1024 + col0 + bj * HALF + n * 16);
#pragma unroll
        for (int rg = 0; rg < 8; ++rg) { const int ai = rg >> 2, m = rg & 3; const int row = row0 + ai * HALF + m * 16; const size_t off = (size_t)row * 1024 + col0; float s2 = 0.f;
            if (rg + 1 < 8) { const int ai2 = (rg + 1) >> 2, m2 = (rg + 1) & 3; const size_t off2 = (size_t)(row0 + ai2 * HALF + m2 * 16) * 1024 + col0;
#pragma unroll
                for (int bj = 0; bj < 2; ++bj)
#pragma unroll
                    for (int n = 0; n < 2; ++n) xb[(rg + 1) & 1][bj][n] = ldbase(off2 + bj * HALF + n * 16); }
#pragma unroll
            for (int bj = 0; bj < 2; ++bj)
#pragma unroll
                for (int n = 0; n < 2; ++n) { const f32x4 x = xb[rg & 1][bj][n];
                    const f32x4 o = x + gv[bj][n] * acc[ai][bj][m][n];
                    { u32x2v w; w.x = cvt_pk_bf16(o[0], o[1]); w.y = cvt_pk_bf16(o[2], o[3]); *(u32x2v*)(out + off + bj * HALF + n * 16) = w; }
                    s2 += (o[0] * o[0] + o[1] * o[1]) + (o[2] * o[2] + o[3] * o[3]);
                    const f32x4 t = o * gs[bj][n]; u32x2v w; w.x = cvt_pk_bf16(t[0], t[1]); w.y = cvt_pk_bf16(t[2], t[3]);
                    *(u32x2v*)(xs + off + bj * HALF + n * 16) = w; }
            { const int ln = fr + 16 * fq; s2 += lshfl(s2, ln ^ 16); s2 += lshfl(s2, ln ^ 32); }
            if (fq == 0) ssq[(size_t)row * 16 + u.pn * 4 + wc] = s2; }
    }
};
struct EpiScaleShift {
    static constexpr bool PERM = true, AFTER_DRAIN = false;
    bf16_t* O; int ldc; const float* ssq; const float* shift; int spitch; float eps;
    __device__ __forceinline__ void operator()(const f32x4 (&acc)[2][2][4][2], const Unit& u, int wr, int wc, int fr, int fq) const {
        const int row0 = u.pm * BM + wr * 64 + fr; const int col0 = u.pn * BM + wc * 32 + 8 * fq; const int b = (u.pm * BM) >> 12;
        f32x4 sv[2][2];
#pragma unroll
        for (int bj = 0; bj < 2; ++bj)
#pragma unroll
            for (int n = 0; n < 2; ++n) sv[bj][n] = *(const f32x4*)(shift + (size_t)b * spitch + col0 + bj * HALF + 4 * n);
#pragma unroll
        for (int ai = 0; ai < 2; ++ai)
#pragma unroll
            for (int m = 0; m < 4; ++m) { const int row = row0 + ai * HALF + m * 16; bf16_t* rowp = O + (size_t)row * ldc + col0;
                float sq; { const f32x4 a = *(const f32x4*)(ssq + (size_t)row * 16), b2 = *(const f32x4*)(ssq + (size_t)row * 16 + 4), c = *(const f32x4*)(ssq + (size_t)row * 16 + 8), d = *(const f32x4*)(ssq + (size_t)row * 16 + 12);
                    sq = (((a[0] + a[1]) + (a[2] + a[3])) + ((b2[0] + b2[1]) + (b2[2] + b2[3]))) + (((c[0] + c[1]) + (c[2] + c[3])) + ((d[0] + d[1]) + (d[2] + d[3]))); }
                const float rstd = 1.0f / sqrtf(sq * (1.0f / 1024.0f) + eps);
#pragma unroll
                for (int bj = 0; bj < 2; ++bj) { const f32x4 v0 = acc[ai][bj][m][0] * rstd + sv[bj][0], v1 = acc[ai][bj][m][1] * rstd + sv[bj][1];
                    u32x4 w; w.x = cvt_pk_bf16(v0[0], v0[1]); w.y = cvt_pk_bf16(v0[2], v0[3]); w.z = cvt_pk_bf16(v1[0], v1[1]); w.w = cvt_pk_bf16(v1[2], v1[3]);
                    *(u32x4*)(rowp + bj * HALF) = w; } }
    }
};

template <class Epi, class Sched, bool ALIGN_EPI = false, bool SP2 = false, bool FP8 = false>
__device__ __forceinline__ void gemm_phase(PG8_LAS unsigned char* lds, const Gemm g, const Sched& S, const Epi& E, int wave_s) {
    const int wid = wave_s, lane = mk_lane(), tid = wid * 64 + lane;
    const int wr = wid >> 2, wc = wid & 3, fr = lane & 15, fq = lane >> 4;
    const int K = g.K, nt = K / BK;
    unsigned voffA[2], voffB[2];
#pragma unroll
    for (int i = 0; i < 2; ++i) { int R, C; stage_rc(tid * 16 + i * 8192, R, C); const int Rb = Epi::PERM ? ((R & ~31) + perm32(R & 31)) : R;
        voffA[i] = (unsigned)(R * g.lda + C) * 2u; voffB[i] = (unsigned)(Rb * K + C) * 2u; }
    const size_t kstep = (size_t)(BK * 2);
    const size_t hstep = (size_t)HALF * K * 2;
    const size_t tstep = 2 * hstep;
    const size_t hstepA = (size_t)HALF * g.lda * 2, tstepA = 2 * hstepA;
    const unsigned ldsw = (unsigned)wid * 1024u;
    const int aoff = lds_byte(wr * 64 + fr, fq * 8), boff = lds_byte(wc * 32 + fr, fq * 8);
#define PG8_SA(b, h) (((b) * 2 + (h)) * HTB)
#define PG8_SB(b, h) ((4 + (b) * 2 + (h)) * HTB)
#define PG8_STAGE(bufoff, gbase, voff) do { _Pragma("unroll") for (int _i = 0; _i < 2; ++_i) \
        __builtin_amdgcn_global_load_lds((const unsigned*)((const char*)(gbase) + (voff)[_i]), (PG8_LAS unsigned*)(lds + (bufoff) + ldsw + _i * 8192), 16, 0, 0); } while (0)
#define PG8_LDA(dst, b, h) do { _Pragma("unroll") for (int m = 0; m < 4; ++m) { if constexpr (FP8) dst##8[m] = PG8_CAT8(*(const PG8_LAS bf16x8*)(lds + PG8_SA(b, h) + aoff + m * 2048), *(const PG8_LAS bf16x8*)(lds + PG8_SA(b, h) + aoff + m * 2048 + 1024)); \
        else { _Pragma("unroll") for (int k = 0; k < 2; ++k) dst[m][k] = *(const PG8_LAS bf16x8*)(lds + PG8_SA(b, h) + aoff + m * 2048 + k * 1024); } } } while (0)
#define PG8_LDB(dst, b, h) do { _Pragma("unroll") for (int n = 0; n < 2; ++n) { if constexpr (FP8) dst##8[n] = PG8_CAT8(*(const PG8_LAS bf16x8*)(lds + PG8_SB(b, h) + boff + n * 2048), *(const PG8_LAS bf16x8*)(lds + PG8_SB(b, h) + boff + n * 2048 + 1024)); \
        else { _Pragma("unroll") for (int k = 0; k < 2; ++k) dst[n][k] = *(const PG8_LAS bf16x8*)(lds + PG8_SB(b, h) + boff + n * 2048 + k * 1024); } } } while (0)
#define PG8_CAT8(x, y) __builtin_shufflevector(__builtin_bit_cast(pg8_v4i, x), __builtin_bit_cast(pg8_v4i, y), 0, 1, 2, 3, 4, 5, 6, 7)
#define PG8_MMA(ai, bj, At, Bt) do { __builtin_amdgcn_s_setprio(1); _Pragma("unroll") for (int m = 0; m < 4; ++m) _Pragma("unroll") for (int n = 0; n < 2; ++n) { \
        if constexpr (FP8) { acc[ai][bj][m][n] = __builtin_amdgcn_mfma_scale_f32_16x16x128_f8f6f4(Bt##8[n], At##8[m], acc[ai][bj][m][n], 0, 0, 0, FP8_SCALE_W, 0, FP8_SCALE_A); asm volatile("" : "+v"(acc[ai][bj][m][n])); }   \
        else { _Pragma("unroll") for (int k = 0; k < 2; ++k) acc[ai][bj][m][n] = __builtin_amdgcn_mfma_f32_16x16x32_bf16(Bt[n][k], At[m][k], acc[ai][bj][m][n], 0, 0, 0); } } __builtin_amdgcn_s_setprio(0); } while (0)
#define PG8_WAIT_V(n) asm volatile("s_waitcnt vmcnt(" #n ")" ::: "memory")
#define PG8_WAIT_L(n) asm volatile("s_waitcnt lgkmcnt(" #n ")" ::: "memory")
#define PG8_BAR __builtin_amdgcn_s_barrier()
#define PG8_SCHED __builtin_amdgcn_sched_barrier(0)
    Unit cur, nxt; int ui = 0;
    if (!S.next(0, cur)) return;
    f32x4 acc[2][2][4][2];
#pragma unroll
    for (int a = 0; a < 2; ++a)
#pragma unroll
        for (int b = 0; b < 2; ++b)
#pragma unroll
            for (int m = 0; m < 4; ++m)
#pragma unroll
                for (int n = 0; n < 2; ++n) acc[a][b][m][n] = (f32x4){0.f, 0.f, 0.f, 0.f};
    bf16x8 At[4][2], B0[2][2], B1[2][2]; pg8_v8i At8[4], B08[2], B18[2];
    const char* cA = (const char*)g.A + (size_t)cur.pm * tstepA; const char* cB = (const char*)g.Bt + (size_t)cur.pn * tstep;
    S.a_ready(cur);
    if constexpr (SP2) {
        PG8_STAGE(PG8_SB(0, 0), cB, voffB); PG8_STAGE(PG8_SB(0, 1), cB + hstep, voffB); PG8_STAGE(PG8_SA(0, 0), cA, voffA); PG8_STAGE(PG8_SA(0, 1), cA + hstepA, voffA);
        if (wr == 1) PG8_BAR;
        PG8_WAIT_V(2); PG8_BAR;
        PG8_STAGE(PG8_SB(1, 0), cB + kstep, voffB); PG8_STAGE(PG8_SA(1, 0), cA + kstep, voffA); PG8_STAGE(PG8_SB(1, 1), cB + hstep + kstep, voffB);
        PG8_WAIT_V(6); PG8_BAR;
    } else {
        PG8_STAGE(PG8_SB(0, 0), cB, voffB); PG8_STAGE(PG8_SA(0, 0), cA, voffA); PG8_STAGE(PG8_SB(0, 1), cB + hstep, voffB); PG8_STAGE(PG8_SA(0, 1), cA + hstepA, voffA);
        if (wr == 1) PG8_BAR;
        PG8_WAIT_V(4); PG8_BAR;
        PG8_STAGE(PG8_SB(1, 0), cB + kstep, voffB); PG8_STAGE(PG8_SA(1, 0), cA + kstep, voffA); PG8_STAGE(PG8_SB(1, 1), cB + hstep + kstep, voffB);
        PG8_WAIT_V(6); PG8_BAR;
    }
    for (;;) {
        const bool has_next = S.next(ui + 1, nxt);
        const char* nA = has_next ? (const char*)g.A + (size_t)nxt.pm * tstepA : cA; const char* nB = has_next ? (const char*)g.Bt + (size_t)nxt.pn * tstep : cB;
        for (int t = 0; t < nt; t += 2) {
            const bool last = (t == nt - 2);
            const char* a1 = cA + (size_t)(t + 1) * kstep;
            const char* a2 = last ? nA : cA + (size_t)(t + 2) * kstep; const char* b2 = last ? nB : cB + (size_t)(t + 2) * kstep;
            const char* a3 = a2 + kstep; const char* b3 = b2 + kstep;
            if (last && has_next) S.a_ready(nxt);
            if constexpr (SP2) {
            PG8_LDB(B0, 0, 0); PG8_LDB(B1, 0, 1); PG8_SCHED; PG8_LDA(At, 0, 0); PG8_STAGE(PG8_SA(1, 1), a1 + hstepA, voffA);
            PG8_WAIT_V(8); PG8_WAIT_L(0); PG8_BAR; PG8_MMA(0, 0, At, B0); PG8_MMA(0, 1, At, B1); PG8_BAR; PG8_SCHED;
            PG8_LDA(At, 0, 1); PG8_STAGE(PG8_SB(0, 0), b2, voffB); PG8_STAGE(PG8_SB(0, 1), b2 + hstep, voffB); PG8_STAGE(PG8_SA(0, 0), a2, voffA);
            PG8_WAIT_V(8); PG8_WAIT_L(0); PG8_BAR; PG8_MMA(1, 0, At, B0); PG8_MMA(1, 1, At, B1); PG8_BAR; PG8_SCHED;
            PG8_LDB(B0, 1, 0); PG8_LDB(B1, 1, 1); PG8_SCHED; PG8_LDA(At, 1, 0); PG8_STAGE(PG8_SA(0, 1), a2 + hstepA, voffA);
            PG8_WAIT_V(8); PG8_WAIT_L(0); PG8_BAR; PG8_MMA(0, 0, At, B0); PG8_MMA(0, 1, At, B1); PG8_BAR; PG8_SCHED;
            PG8_LDA(At, 1, 1); PG8_STAGE(PG8_SB(1, 0), b3, voffB); PG8_STAGE(PG8_SB(1, 1), b3 + hstep, voffB); PG8_STAGE(PG8_SA(1, 0), a3, voffA);
            PG8_WAIT_V(8); PG8_WAIT_L(0); PG8_BAR; PG8_MMA(1, 0, At, B0); PG8_MMA(1, 1, At, B1); PG8_BAR; PG8_SCHED;
            } else {
            PG8_LDB(B0, 0, 0); PG8_SCHED; PG8_LDA(At, 0, 0); PG8_STAGE(PG8_SA(1, 1), a1 + hstepA, voffA);
            PG8_WAIT_L(8); PG8_BAR; PG8_WAIT_L(0); PG8_MMA(0, 0, At, B0); PG8_BAR; PG8_SCHED;
            PG8_LDB(B1, 0, 1); PG8_STAGE(PG8_SB(0, 0), b2, voffB);
            PG8_BAR; PG8_WAIT_L(0); PG8_MMA(0, 1, At, B1); PG8_BAR;
            PG8_LDA(At, 0, 1); PG8_STAGE(PG8_SA(0, 0), a2, voffA);
            PG8_BAR; PG8_WAIT_L(0); PG8_MMA(1, 0, At, B0); PG8_BAR; PG8_SCHED;
            PG8_STAGE(PG8_SB(0, 1), b2 + hstep, voffB);
            PG8_WAIT_V(6); PG8_BAR; PG8_MMA(1, 1, At, B1); PG8_BAR;
            PG8_LDB(B0, 1, 0); PG8_SCHED; PG8_LDA(At, 1, 0); PG8_STAGE(PG8_SA(0, 1), a2 + hstepA, voffA);
            PG8_WAIT_L(8); PG8_BAR; PG8_WAIT_L(0); PG8_MMA(0, 0, At, B0); PG8_BAR; PG8_SCHED;
            PG8_LDB(B1, 1, 1); PG8_STAGE(PG8_SB(1, 0), b3, voffB);
            PG8_BAR; PG8_WAIT_L(0); PG8_MMA(0, 1, At, B1); PG8_BAR;
            PG8_LDA(At, 1, 1); PG8_STAGE(PG8_SA(1, 0), a3, voffA);
            PG8_BAR; PG8_WAIT_L(0); PG8_MMA(1, 0, At, B0); PG8_BAR; PG8_SCHED;
            PG8_STAGE(PG8_SB(1, 1), b3 + hstep, voffB);
            PG8_WAIT_V(6); PG8_BAR; PG8_MMA(1, 1, At, B1); PG8_BAR;
            }
        }
        if constexpr (ALIGN_EPI) { if (wr == 0) PG8_BAR; }
        if constexpr (!Epi::AFTER_DRAIN) { E(acc, cur, wr, wc, fr, fq); S.done(cur); }
        if (!has_next) break;
#pragma unroll
        for (int a = 0; a < 2; ++a)
#pragma unroll
            for (int b = 0; b < 2; ++b)
#pragma unroll
                for (int m = 0; m < 4; ++m)
#pragma unroll
                    for (int n = 0; n < 2; ++n) acc[a][b][m][n] = (f32x4){0.f, 0.f, 0.f, 0.f};
        cur = nxt; cA = nA; cB = nB; ++ui;
        if constexpr (ALIGN_EPI) { if (wr == 1) PG8_BAR; }
    }
    PG8_WAIT_V(0);
    if constexpr (!ALIGN_EPI) { if (wr == 0) PG8_BAR; }
    PG8_BAR;
    if constexpr (Epi::AFTER_DRAIN) { E.fused(acc, cur, wr, wc, fr, fq, lds, wid, lane); S.done(cur); }
#undef PG8_SA
#undef PG8_SB
#undef PG8_STAGE
#undef PG8_LDA
#undef PG8_LDB
#undef PG8_MMA
#undef PG8_CAT8
#undef PG8_WAIT_V
#undef PG8_WAIT_L
#undef PG8_BAR
#undef PG8_SCHED
}
}
#include <hip/hip_bf16.h>
#include <cmath>
namespace attn_body {
using bf16=__hip_bfloat16;
using bf16x8=__attribute__((ext_vector_type(8)))short;
using s16x4=__attribute__((ext_vector_type(4)))short;
using f32x16=__attribute__((ext_vector_type(16)))float;
using u32x4=__attribute__((ext_vector_type(4)))unsigned;
constexpr int BATCH=8,NHEAD=16,SEQ=4096,D=64,PQ=3072,OP=2048;
constexpr int NW=8,QBLK=32,QB=QBLK*NW,KVBLK=64,NQB=SEQ/QB;
constexpr int ATTN_UNIT_ROWS=QB;
__device__ __forceinline__ int crow(int r,int hi){return (r&3)+8*(r>>2)+4*hi;}
#define SBAR() __builtin_amdgcn_sched_barrier(0)
__device__ __forceinline__ void cmask(f32x16&p0,f32x16&p1,int jb,int qrel,int hi){
  const float NEG=-INFINITY; int kb=64*jb+4*hi;
  #pragma unroll
  for(int r=0;r<16;++r){int kv=kb+(r&3)+8*(r>>2); if(kv>qrel)p0[r]=NEG; if(kv+32>qrel)p1[r]=NEG;}
}

constexpr int NSLOT=3, SLOTB=8192, VSLOTB=16384;
constexpr int LDS_K=0, LDS_V=NSLOT*SLOTB, LDS_WS=LDS_V+NSLOT*VSLOTB, LDS_Q=LDS_WS+NW*64*4, LDS_OST=LDS_Q+NW*4096, LDS_BYTES=LDS_OST+NW*4096;
constexpr float C2=0.125f*1.4426950408889634f;
__device__ __forceinline__ void glds16(const void*sbase,unsigned voff,unsigned lds_dst){unsigned keep;
  asm volatile("s_mov_b32 %0, m0\n\ts_mov_b32 m0, %3\n\ts_nop 4\n\tglobal_load_lds_dwordx4 %1, %2\n\ts_mov_b32 m0, %0":"=&s"(keep):"v"(voff),"s"(sbase),"s"(lds_dst):"memory");}
__device__ __forceinline__ float max3f(float a,float b,float c){float r;asm("v_max3_f32 %0, %1, %2, %3":"=v"(r):"v"(a),"v"(b),"v"(c));return r;}
__device__ __forceinline__ float max2f(float a,float b){float r;asm("v_max_f32_e32 %0, %1, %2":"=v"(r):"v"(a),"v"(b));return r;}
__device__ __forceinline__ float fadd_s(float a,float b){float r;asm("v_add_f32_e32 %0, %1, %2":"=v"(r):"v"(a),"v"(b));return r;}
__device__ __forceinline__ float fsub_s(float a,float b){float r;asm("v_sub_f32_e32 %0, %1, %2":"=v"(r):"v"(a),"v"(b));return r;}
typedef float f32x2_t __attribute__((ext_vector_type(2))); typedef __bf16 bf16x2_t __attribute__((ext_vector_type(2)));
__device__ __forceinline__ unsigned cvtpk_s(float lo,float hi){f32x2_t v={lo,hi};bf16x2_t b=__builtin_convertvector(v,bf16x2_t);return __builtin_bit_cast(unsigned,b);}
#define WAIT_BAR(N) asm volatile("s_waitcnt vmcnt(" #N ") lgkmcnt(0)\n\ts_barrier":::"memory")

typedef __attribute__((address_space(3))) const char* lds_cptr0;
__device__ __forceinline__ void qkt(f32x16&p0,f32x16&p1,const char*Kslot,lds_cptr0 qs,const f32x16&negm,int r32,int hi){
  const char*kb=Kslot+hi*1024+r32*16;
  #pragma unroll
  for(int d0=0;d0<4;++d0){
    const bf16x8 b0=*reinterpret_cast<const bf16x8*>(kb+d0*2048);
    const bf16x8 b1=*reinterpret_cast<const bf16x8*>(kb+d0*2048+512);
    const bf16x8 qd=*(const __attribute__((address_space(3))) bf16x8*)(qs+d0*1024);
    if(d0==0){p0=__builtin_amdgcn_mfma_f32_32x32x16_bf16(b0,qd,negm,0,0,0);p1=__builtin_amdgcn_mfma_f32_32x32x16_bf16(b1,qd,negm,0,0,0);}
    else{p0=__builtin_amdgcn_mfma_f32_32x32x16_bf16(b0,qd,p0,0,0,0);p1=__builtin_amdgcn_mfma_f32_32x32x16_bf16(b1,qd,p1,0,0,0);}}
}
typedef __attribute__((address_space(3))) const char* lds_cptr;
typedef short v4i16_t __attribute__((ext_vector_type(4)));
__device__ __forceinline__ void kload8(bf16x8*kf,lds_cptr kp){
  kf[0]=*(const __attribute__((address_space(3))) bf16x8*)(kp);      kf[1]=*(const __attribute__((address_space(3))) bf16x8*)(kp+512);
  kf[2]=*(const __attribute__((address_space(3))) bf16x8*)(kp+2048); kf[3]=*(const __attribute__((address_space(3))) bf16x8*)(kp+2560);
  kf[4]=*(const __attribute__((address_space(3))) bf16x8*)(kp+4096); kf[5]=*(const __attribute__((address_space(3))) bf16x8*)(kp+4608);
  kf[6]=*(const __attribute__((address_space(3))) bf16x8*)(kp+6144); kf[7]=*(const __attribute__((address_space(3))) bf16x8*)(kp+6656);
}
__device__ __forceinline__ void kload2(bf16x8*kf,lds_cptr kp,int j){ kf[2*j]=*(const __attribute__((address_space(3))) bf16x8*)(kp+j*2048); kf[2*j+1]=*(const __attribute__((address_space(3))) bf16x8*)(kp+j*2048+512); }
__device__ __forceinline__ s16x4 vtr(lds_cptr p){ return __builtin_bit_cast(s16x4,__builtin_amdgcn_ds_read_tr16_b64_v4i16((__attribute__((address_space(3))) v4i16_t*)p)); }
__device__ __forceinline__ float rowmax(const f32x16&p0,const f32x16&p1){
  float a=max3f(p0[0],p0[1],p1[0]),b=max3f(p0[2],p0[3],p1[1]);a=max3f(a,p1[2],p1[3]);
  #pragma unroll
  for(int r=4;r<16;r+=4){a=max3f(a,p0[r],p0[r+1]);b=max3f(b,p0[r+2],p0[r+3]);a=max3f(a,p1[r],p1[r+1]);b=max3f(b,p1[r+2],p1[r+3]);}
  const float m=max2f(a,b);
  auto rr=__builtin_amdgcn_permlane32_swap(__float_as_uint(m),__float_as_uint(m),false,false);
  return max2f(__uint_as_float(rr[0]),__uint_as_float(rr[1]));
}
__device__ __forceinline__ void pv(f32x16*o,int vb,bf16x8 pa0,bf16x8 pa1,bf16x8 pa2,bf16x8 pa3){
  #pragma unroll
  for(int d0=0;d0<4;++d0){s16x4 lo[4],hi[4];
    #pragma unroll
    for(int ks=0;ks<4;++ks){
      asm volatile("ds_read_b64_tr_b16 %0,%1 offset:%c2":"=&v"(lo[ks]):"v"(vb),"i"(d0*4096+ks*1024):"memory");
      asm volatile("ds_read_b64_tr_b16 %0,%1 offset:%c2":"=&v"(hi[ks]):"v"(vb),"i"(d0*4096+ks*1024+512):"memory");}
    asm volatile("s_waitcnt lgkmcnt(0)":::"memory");SBAR();
    #define PK(k) (bf16x8){lo[k][0],lo[k][1],lo[k][2],lo[k][3],hi[k][0],hi[k][1],hi[k][2],hi[k][3]}
    o[d0]=__builtin_amdgcn_mfma_f32_32x32x16_bf16(pa0,PK(0),o[d0],0,0,0);
    o[d0]=__builtin_amdgcn_mfma_f32_32x32x16_bf16(pa1,PK(1),o[d0],0,0,0);
    o[d0]=__builtin_amdgcn_mfma_f32_32x32x16_bf16(pa2,PK(2),o[d0],0,0,0);
    o[d0]=__builtin_amdgcn_mfma_f32_32x32x16_bf16(pa3,PK(3),o[d0],0,0,0);
    #undef PK
  }
}

#ifndef ATTN_STORE16
#define ATTN_STORE16(p,v) (*(u32x4*)(p)=(v))
#endif
template<int THRL,int VAR> __device__ __forceinline__ void attn_unit(int wave_s,int b,int hq,int qb,const bf16*Q,const bf16*__restrict__ K,const bf16*__restrict__ V,bf16*O,char*shm){
  const int lane=mk_lane(),r32=lane&31,hi=lane>>5; const int wid=wave_s; const int tid=wid*64+lane;
  const long rowbase=(long)b*SEQ; const int q0=qb*QB;
  const bf16*Qw=Q+(rowbase+q0+wid*QBLK)*PQ+hq*D;
  const bf16*Kh=K+rowbase*PQ+hq*D,*Vh=V+rowbase*PQ+(hq>>1)*128;
  const unsigned lds0=(unsigned)(uintptr_t)shm;
  float*wsf=(float*)(shm+LDS_WS)+wid*64;
  const unsigned koff=(unsigned)(lane*PQ+wid*8)*2u;
  const unsigned voff=(unsigned)((16*(wid&3)+(lane>>2))*PQ+(wid>>2)*32+(lane&3)*8)*2u;
  const unsigned kdst=lds0+LDS_K+wid*1024, vdst=lds0+LDS_V+wid*1024;
  #define DMA_K(t,slot) glds16(Kh+(long)(t)*KVBLK*PQ,koff,(unsigned)__builtin_amdgcn_readfirstlane(kdst+(slot)))
  #define DMA_V(t,slot) do{ if(VAR==1)break; glds16(Vh+(long)(t)*KVBLK*PQ,voff,(unsigned)__builtin_amdgcn_readfirstlane(vdst+2*(slot))); glds16(Vh+(long)(t)*KVBLK*PQ,voff+128u,(unsigned)__builtin_amdgcn_readfirstlane(vdst+8192+2*(slot))); }while(0)
  const int vb0=(int)(lds0+LDS_V)+((lane>>4)&1)*32+(lane&3)*8+(4*hi+((lane&15)>>2))*64;
  const char*Kbase=shm+LDS_K; bf16x8 kf[8];
  const lds_cptr shm3=(lds_cptr)shm; const lds_cptr kp0=shm3+LDS_K+hi*1024+r32*16; const lds_cptr vp0=shm3+LDS_V+((lane>>4)&1)*32+(lane&3)*8+(4*hi+((lane&15)>>2))*64;
  const int NT=(q0+QB)/KVBLK;
  DMA_K(0,0);DMA_V(0,0);DMA_K(1,SLOTB);
  const lds_cptr qs=shm3+LDS_Q+wid*4096+lane*16;
  #pragma unroll
  for(int d0=0;d0<4;++d0)*(__attribute__((address_space(3))) bf16x8*)(const_cast<__attribute__((address_space(3))) char*>(qs)+d0*1024)=*reinterpret_cast<const bf16x8*>(&Qw[(long)r32*PQ+d0*16+hi*8]);
  #define LDQ(d0) (*(const __attribute__((address_space(3))) bf16x8*)(qs+(d0)*1024))
  float mhat=0.f,l_reg=0.f;f32x16 o[4];o[0]=f32x16{};o[1]=f32x16{};o[2]=f32x16{};o[3]=f32x16{};const f32x16 negm=f32x16{};
  const int qrel=wid*QBLK+r32;
  #define CMASK(P0,P1,t) do{int jb_=(t)-(NT-4); if(jb_>=0)cmask(P0,P1,jb_,qrel,hi);}while(0)
  bool resc=false;
  #define START(P0,P1) do{ const float rm=rowmax(P0,P1); resc=false; \
    { const float dl=rm; mhat=fadd_s(mhat,dl); \
      _Pragma("unroll") for(int r=0;r<16;++r){P0[r]=fsub_s(P0[r],dl);P1[r]=fsub_s(P1[r],dl);} \
      } \
    _Pragma("unroll") for(int r=0;r<16;++r)P0[r]=__builtin_amdgcn_exp2f(P0[r]); }while(0)
  #define RESC() do{ if(resc){ asm volatile("s_waitcnt lgkmcnt(0)":::"memory"); \
      _Pragma("unroll") for(int d_=0;d_<4;++d_) _Pragma("unroll") for(int r=0;r<16;++r)o[d_][r]*=wsf[crow(r,hi)]; } }while(0)
  f32x16 pA0,pA1,pB0,pB1;
  int sl_prev=0,sl_cur=0,sl_next=SLOTB;
  #define ROT() do{sl_prev=sl_cur;sl_cur=sl_next;sl_next=(sl_next==(NSLOT-1)*SLOTB)?0:sl_next+SLOTB;}while(0)
  DMA_K(2,2*SLOTB);
  WAIT_BAR(4);
  qkt(pA0,pA1,Kbase,qs,negm,r32,hi);asm volatile("s_nop 15\n\ts_nop 7":"+v"(pA0),"+v"(pA1));CMASK(pA0,pA1,0);
  START(pA0,pA1);
  _Pragma("unroll") for(int r=0;r<16;++r)pA1[r]=__builtin_amdgcn_exp2f(pA1[r]);
  WAIT_BAR(0);
  DMA_K(3,0);DMA_V(1,SLOTB);
  ROT();
  kload8(kf,kp0+sl_cur);
  WAIT_BAR(3);
  s16x4 vlo[8],vhi[8]; u32x4 pw0=u32x4{},pw1=u32x4{},pw2=u32x4{},pw3=u32x4{};
  if(VAR==3){_Pragma("unroll") for(int i_=0;i_<8;++i_){vlo[i_]=s16x4{};vhi[i_]=s16x4{};}}
  #define PKW(P,B) cvtpk_s(P[B],P[B+1])
  #define PAF(k) __builtin_bit_cast(bf16x8,pw##k)
  #define VFR(i) (bf16x8){vlo[i][0],vlo[i][1],vlo[i][2],vlo[i][3],vhi[i][0],vhi[i][1],vhi[i][2],vhi[i][3]}
  #define PIN(x) asm volatile("":"+v"(x))
  #define MX3(a,b,c) __builtin_fmaxf(__builtin_fmaxf((a),(b)),(c))
  #define GAPA(MF,A0,A1,A2,A3,W0,W1,PW) do{ MF; if(VAR!=5){sacc+=A0; sacc+=A1; sacc+=A2; sacc+=A3; PIN(sacc); W0; W1; PIN(PW);} SBAR(); }while(0)
  #define EX(v) (VAR==2?(v)*0.5f:__builtin_amdgcn_exp2f(v))
  #define GAPB(MF,X,B) do{ if(VAR!=4){MF;} X[B]=EX(X[B]); X[B+1]=EX(X[B+1]); PIN(X); SBAR(); }while(0)
  #define VRD2(i) do{ if(VAR==3)break; vlo[i]=vtr(vp_+((((i)>>2)+2)*4096+((i)&3)*1024)); vhi[i]=vtr(vp_+((((i)>>2)+2)*4096+((i)&3)*1024+512)); }while(0)
  #define VRD(i) do{ if(VAR==3)break; vlo[i]=vtr(vp_+(((i)>>2)*4096+((i)&3)*1024)); vhi[i]=vtr(vp_+(((i)>>2)*4096+((i)&3)*1024+512)); }while(0)
  #define KRD(G,j) do{ if(G){ kload2(kf,kp0+sl_next,j); SBAR(); } }while(0)
  #define STEP(C0,C1,P0,P1,t,GK,GV,GL) do{ SBAR(); \
    const lds_cptr vp_=vp0+2*sl_prev; \
    bf16x8 qa_=LDQ(0),qb_=LDQ(1); VRD(0); SBAR(); float sacc=(P0[0]+P0[1]); \
    GAPA(C0=__builtin_amdgcn_mfma_f32_32x32x16_bf16(kf[0],qa_,negm,0,0,0), P0[2],P0[3],P0[4],P0[5],     pw0[0]=PKW(P0,0), pw0[1]=PKW(P0,2), pw0); \
    VRD(4); SBAR(); GAPA(C1=__builtin_amdgcn_mfma_f32_32x32x16_bf16(kf[1],qa_,negm,0,0,0), P0[6],P0[7],P0[8],P0[9],     pw0[2]=PKW(P0,4), pw0[3]=PKW(P0,6), pw0); \
    VRD(1); qa_=LDQ(2); SBAR(); GAPA(C0=__builtin_amdgcn_mfma_f32_32x32x16_bf16(kf[2],qb_,C0,0,0,0),   P0[10],P0[11],P0[12],P0[13], pw1[0]=PKW(P0,8), pw1[1]=PKW(P0,10), pw1); \
    VRD(5); SBAR(); GAPA(C1=__builtin_amdgcn_mfma_f32_32x32x16_bf16(kf[3],qb_,C1,0,0,0),   P0[14],P0[15],P1[0],P1[1],   pw1[2]=PKW(P0,12),pw1[3]=PKW(P0,14), pw1); \
    VRD(2); qb_=LDQ(3); SBAR(); GAPA(C0=__builtin_amdgcn_mfma_f32_32x32x16_bf16(kf[4],qa_,C0,0,0,0),   P1[2],P1[3],P1[4],P1[5],     pw2[0]=PKW(P1,0), pw2[1]=PKW(P1,2), pw2); \
    VRD(6); SBAR(); GAPA(C1=__builtin_amdgcn_mfma_f32_32x32x16_bf16(kf[5],qa_,C1,0,0,0),   P1[6],P1[7],P1[8],P1[9],     pw2[2]=PKW(P1,4), pw2[3]=PKW(P1,6), pw2); \
    VRD(3); SBAR(); GAPA(C0=__builtin_amdgcn_mfma_f32_32x32x16_bf16(kf[6],qb_,C0,0,0,0),   P1[10],P1[11],P1[12],P1[13], pw3[0]=PKW(P1,8), pw3[1]=PKW(P1,10), pw3); \
    VRD(7); SBAR(); GAPA(C1=__builtin_amdgcn_mfma_f32_32x32x16_bf16(kf[7],qb_,C1,0,0,0),   P1[14],P1[15],0.f,0.f,       pw3[2]=PKW(P1,12),pw3[3]=PKW(P1,14), pw3); \
    l_reg+=sacc; \
    if(GK){DMA_K((t)+3,sl_cur);} if(GV){DMA_V((t)+1,sl_next);} \
    CMASK(C0,C1,t); \
    _Pragma("unroll") for(int r=0;r<16;++r){C0[r]-=mhat;C1[r]-=mhat;} \
    if(VAR!=6){ float a=MX3(C0[0],C0[1],C1[0]),b=MX3(C0[2],C0[3],C1[1]); a=MX3(a,C1[2],C1[3]); \
      _Pragma("unroll") for(int r=4;r<16;r+=4){a=MX3(a,C0[r],C0[r+1]);b=MX3(b,C0[r+2],C0[r+3]);a=MX3(a,C1[r],C1[r+1]);b=MX3(b,C1[r+2],C1[r+3]);} \
      float rm=__builtin_fmaxf(a,b); { auto rr=__builtin_amdgcn_permlane32_swap(__float_as_uint(rm),__float_as_uint(rm),false,false); rm=__builtin_fmaxf(__uint_as_float(rr[0]),__uint_as_float(rr[1])); } \
      resc=false; \
      if(__builtin_expect(__any(rm>(float)THRL),0)){ const float dl=__builtin_fmaxf(rm,0.f); mhat+=dl; \
        _Pragma("unroll") for(int r=0;r<16;++r){C0[r]-=dl;C1[r]-=dl;} \
        const float f=__builtin_amdgcn_exp2f(-dl); l_reg*=f; if(hi==0)wsf[r32]=f; resc=true; } } \
    SBAR(); \
    GAPB(o[0]=__builtin_amdgcn_mfma_f32_32x32x16_bf16(PAF(0),VFR(0),o[0],0,0,0), C0,0);  VRD2(0); SBAR(); \
    GAPB(o[1]=__builtin_amdgcn_mfma_f32_32x32x16_bf16(PAF(0),VFR(4),o[1],0,0,0), C0,2);  VRD2(4); SBAR(); \
    KRD(GL,0); GAPB(o[0]=__builtin_amdgcn_mfma_f32_32x32x16_bf16(PAF(1),VFR(1),o[0],0,0,0), C0,4);  VRD2(1); SBAR(); \
    KRD(GL,1); GAPB(o[1]=__builtin_amdgcn_mfma_f32_32x32x16_bf16(PAF(1),VFR(5),o[1],0,0,0), C0,6);  VRD2(5); SBAR(); \
    KRD(GL,2); GAPB(o[0]=__builtin_amdgcn_mfma_f32_32x32x16_bf16(PAF(2),VFR(2),o[0],0,0,0), C0,8);  VRD2(2); SBAR(); \
    KRD(GL,3); GAPB(o[1]=__builtin_amdgcn_mfma_f32_32x32x16_bf16(PAF(2),VFR(6),o[1],0,0,0), C0,10); VRD2(6); SBAR(); \
    GAPB(o[0]=__builtin_amdgcn_mfma_f32_32x32x16_bf16(PAF(3),VFR(3),o[0],0,0,0), C0,12); VRD2(3); SBAR(); \
    GAPB(o[1]=__builtin_amdgcn_mfma_f32_32x32x16_bf16(PAF(3),VFR(7),o[1],0,0,0), C0,14); VRD2(7); SBAR(); \
    GAPB(o[2]=__builtin_amdgcn_mfma_f32_32x32x16_bf16(PAF(0),VFR(0),o[2],0,0,0), C1,0); \
    GAPB(o[3]=__builtin_amdgcn_mfma_f32_32x32x16_bf16(PAF(0),VFR(4),o[3],0,0,0), C1,2); \
    GAPB(o[2]=__builtin_amdgcn_mfma_f32_32x32x16_bf16(PAF(1),VFR(1),o[2],0,0,0), C1,4); \
    GAPB(o[3]=__builtin_amdgcn_mfma_f32_32x32x16_bf16(PAF(1),VFR(5),o[3],0,0,0), C1,6); \
    GAPB(o[2]=__builtin_amdgcn_mfma_f32_32x32x16_bf16(PAF(2),VFR(2),o[2],0,0,0), C1,8); \
    GAPB(o[3]=__builtin_amdgcn_mfma_f32_32x32x16_bf16(PAF(2),VFR(6),o[3],0,0,0), C1,10); \
    GAPB(o[2]=__builtin_amdgcn_mfma_f32_32x32x16_bf16(PAF(3),VFR(3),o[2],0,0,0), C1,12); \
    GAPB(o[3]=__builtin_amdgcn_mfma_f32_32x32x16_bf16(PAF(3),VFR(7),o[3],0,0,0), C1,14); \
    }while(0)
  int t=1;
  #undef CMASK
  #define CMASK(P0,P1,t) do{}while(0)
  for(;t+5<NT;t+=2){
    STEP(pB0,pB1,pA0,pA1,t,true,true,true);     WAIT_BAR(3); RESC(); ROT();
    STEP(pA0,pA1,pB0,pB1,t+1,true,true,true);   WAIT_BAR(3); RESC(); ROT();
  }
  #undef CMASK
  #define CMASK(P0,P1,t) do{int jb_=(t)-(NT-4); if(jb_>=0)cmask(P0,P1,jb_,qrel,hi);}while(0)
  #define ENDW(tt) do{ if((tt)+3<NT){WAIT_BAR(3);} else if((tt)+2<NT){WAIT_BAR(2);} else {WAIT_BAR(0);} }while(0)
  for(;t+1<NT;t+=2){
    STEP(pB0,pB1,pA0,pA1,t,(t+3<NT),(t+1<NT),(t+1<NT));       ENDW(t);   RESC(); ROT();
    STEP(pA0,pA1,pB0,pB1,t+1,(t+4<NT),(t+2<NT),(t+2<NT));     ENDW(t+1); RESC(); ROT();
  }
  STEP(pB0,pB1,pA0,pA1,NT-1,false,false,false); RESC();
  { float sacc=pB0[0]+pB0[1]; _Pragma("unroll") for(int r=2;r<16;++r)sacc+=pB0[r]; _Pragma("unroll") for(int r=0;r<16;++r)sacc+=pB1[r]; l_reg+=sacc;
    pw0=(u32x4){PKW(pB0,0),PKW(pB0,2),PKW(pB0,4),PKW(pB0,6)};pw1=(u32x4){PKW(pB0,8),PKW(pB0,10),PKW(pB0,12),PKW(pB0,14)};pw2=(u32x4){PKW(pB1,0),PKW(pB1,2),PKW(pB1,4),PKW(pB1,6)};pw3=(u32x4){PKW(pB1,8),PKW(pB1,10),PKW(pB1,12),PKW(pB1,14)};
    SBAR(); pv(o,vb0+2*sl_cur,PAF(0),PAF(1),PAF(2),PAF(3)); }
  #undef PKW
  #undef PAF
  #undef VFR
  #undef PIN
  #undef MX3
  #undef GAPA
  #undef GAPB
  #undef EX
  #undef VRD
  #undef VRD2
  #undef KRD
  #undef STEP
  #undef ENDW
  {auto rr=__builtin_amdgcn_permlane32_swap(__float_as_uint(l_reg),__float_as_uint(l_reg),false,false);l_reg=__uint_as_float(rr[0])+__uint_as_float(rr[1]);}
  if(hi==0)wsf[32+r32]=l_reg;asm volatile("s_waitcnt lgkmcnt(0)":::"memory");
  float rli[16];
  #pragma unroll
  for(int r=0;r<16;++r)rli[r]=__builtin_amdgcn_rcpf(wsf[32+crow(r,hi)]);
  const int lane_e=mk_lane();
  bf16*Ow=O+(rowbase+q0+wid*QBLK)*OP+hq*128;
  { bf16*stg=(bf16*)(shm+LDS_OST)+wid*2048;
    #pragma unroll
    for(int h2=0;h2<2;++h2){
      #pragma unroll
      for(int r=0;r<16;++r){const int orow=crow(r,hi);
        #pragma unroll
        for(int d0=0;d0<2;++d0)stg[orow*64+d0*32+r32]=__float2bfloat16(o[2*h2+d0][r]*rli[r]);}
      asm volatile("s_waitcnt lgkmcnt(0)":::"memory");
      #pragma unroll
      for(int i=0;i<4;++i){const int row=i*8+(lane_e>>3),ch=lane_e&7; const u32x4 v=*(const u32x4*)(stg+row*64+ch*8); ATTN_STORE16(Ow+(long)row*OP+h2*64+ch*8,v);}
      asm volatile("s_waitcnt lgkmcnt(0)":::"memory"); } }
  asm volatile("s_waitcnt lgkmcnt(0)\n\ts_barrier":::"memory");
  #undef DMA_K
  #undef DMA_V
  #undef CMASK
  #undef START
  #undef RESC
  #undef ROT
  #undef LDQ
}
constexpr int ATTN_LDS_BYTES=LDS_BYTES;
struct AttnTensors { const bf16* Q; const bf16* K; const bf16* V; bf16* O; };
template<int VAR> __device__ __forceinline__ void attn_phase(char*lds,const AttnTensors&T,int vcu,int G,int wave_s){
  for(int c=vcu;c<BATCH*NHEAD*2;c+=G){ const int combo=c>>1,half=c&1,b=combo>>4,hq=combo&15;
    for(int p=7;p>=0;--p){ const int qb=2*p+((p^half)&1); attn_unit<8,VAR>(wave_s,b,hq,qb,T.Q,T.K,T.V,T.O,lds); } }
}
#undef SBAR
#undef WAIT_BAR
}
constexpr int NWAVES = 8;
constexpr int NB = 8, SEQ = 4096, DMODEL = 1024, M = NB * SEQ, DEPTH = 4;
constexpr float RMS_EPS = 1e-6f;
constexpr size_t MiB = 1u << 20;
constexpr size_t WS_CTL = 0, CTL_ZERO_BYTES = 1 * MiB;
constexpr size_t WS_MOD = 1 * MiB;
constexpr size_t WS_ROPE = 2 * MiB;
constexpr size_t WS_WINE = 10 * MiB;
constexpr size_t WS_WOUTE = 16 * MiB;
constexpr size_t WS_WINO = 20 * MiB;
constexpr size_t WS_WOUTO = 32 * MiB;
constexpr size_t WS_WQ = 36 * MiB;
constexpr size_t WS_WSG = 52 * MiB;
constexpr size_t WS_WPT = 52 * MiB + 512 * 1024;
constexpr size_t WS_SUBK = 53 * MiB;
constexpr size_t WS_UV = 56 * MiB;
constexpr int PEER_REC = 1024;
constexpr size_t WS_U = 56 * MiB;
constexpr size_t WS_V = 120 * MiB;
constexpr size_t WS_SU = 184 * MiB;
constexpr size_t WS_SV = 184 * MiB + 512 * 1024;
constexpr size_t WS_SSQ = 185 * MiB;
constexpr size_t WS_SHW = 188 * MiB;
constexpr size_t WS_XRES = 312 * MiB;
constexpr size_t WS_HB = 440 * MiB;
constexpr size_t WS_MIX = 504 * MiB;
constexpr size_t WS_PROJ = 568 * MiB;
constexpr size_t WS_XS = WS_PROJ + 128 * MiB;
constexpr size_t WS_EIDX = 760 * MiB;
constexpr size_t WS_GATE = 768 * MiB;
constexpr size_t WS_END = 784 * MiB;
constexpr int CW_BAR = 4096;
constexpr int RING_OFF = 0, RING_BYTES = 131072;
constexpr int LDS_BYTES = 163840;
constexpr int LDSCTL_OFF = LDS_BYTES - 1024, MISC_OFF = LDSCTL_OFF + 320;
constexpr int PEER_LDS_LIMIT = LDSCTL_OFF;

#define GAS __attribute__((address_space(1)))
#define LAS __attribute__((address_space(3)))
typedef unsigned short bf16;
typedef unsigned v4u __attribute__((ext_vector_type(4)));
typedef unsigned v2u __attribute__((ext_vector_type(2)));
typedef int v4i __attribute__((ext_vector_type(4)));
typedef int v8i __attribute__((ext_vector_type(8)));
typedef float f32x4 __attribute__((ext_vector_type(4)));
typedef float f32x2 __attribute__((ext_vector_type(2)));
typedef float f32x16 __attribute__((ext_vector_type(16)));
typedef short bf16x8 __attribute__((ext_vector_type(8)));
typedef short s16x4 __attribute__((ext_vector_type(4)));
typedef __bf16 bf16x2_t __attribute__((ext_vector_type(2)));
typedef GAS unsigned gu32;
#define RLX_AGENT __ATOMIC_RELAXED, __HIP_MEMORY_SCOPE_AGENT
#define LDS_WAIT() asm volatile("s_waitcnt lgkmcnt(0)" ::: "memory")
#define VM_WAIT() asm volatile("s_waitcnt vmcnt(0)" ::: "memory")
__device__ __forceinline__ unsigned f2bf(float f) { unsigned u = __builtin_bit_cast(unsigned, f); return (u + 0x7fffu + ((u >> 16) & 1u)) >> 16; }
__device__ __forceinline__ unsigned pk2(float lo, float hi) { const f32x2 v = {lo, hi}; return __builtin_bit_cast(unsigned, __builtin_convertvector(v, bf16x2_t)); }
#ifndef FP8_EVEN
#define FP8_EVEN 0
#endif
#ifndef FP8_ODD
#define FP8_ODD 1
#endif
__device__ __forceinline__ unsigned pk4_fp8x8(float a, float b, float c, float d) {
    int pk = 0; pk = __builtin_amdgcn_cvt_pk_fp8_f32(__builtin_amdgcn_fmed3f(a * 8.0f, -448.f, 448.f), __builtin_amdgcn_fmed3f(b * 8.0f, -448.f, 448.f), pk, false);
    pk = __builtin_amdgcn_cvt_pk_fp8_f32(__builtin_amdgcn_fmed3f(c * 8.0f, -448.f, 448.f), __builtin_amdgcn_fmed3f(d * 8.0f, -448.f, 448.f), pk, true); return (unsigned)pk; }
__device__ __forceinline__ float bflo(unsigned w) { return __builtin_bit_cast(float, w << 16); }
__device__ __forceinline__ float bfhi(unsigned w) { return __builtin_bit_cast(float, w & 0xffff0000u); }
__device__ __forceinline__ float asf(unsigned u) { return __builtin_bit_cast(float, u); }
__device__ __forceinline__ unsigned asu(float f) { return __builtin_bit_cast(unsigned, f); }
__device__ __forceinline__ float dot2bf(unsigned a, unsigned b, float c) { return __builtin_amdgcn_fdot2_f32_bf16(__builtin_bit_cast(bf16x2_t, a), __builtin_bit_cast(bf16x2_t, b), c, false); }
#define XB_TMO      128
#define XB_XCNT(j)  (256  + 64 * (j))
#define XB_XSUB(j)  (1280 + 64 * (j))
#define XB_XGEN(j)  (2304 + 64 * (j))
#define XB_TOP      3328
#define XB_TOPGEN   3392
#define XCD_BAR_WORDS 3456
#define XB_SPIN_CAP (1u << 18)

__device__ __forceinline__ unsigned xb_ld(unsigned* p)              { return __hip_atomic_load(p, __ATOMIC_RELAXED, __HIP_MEMORY_SCOPE_AGENT); }
__device__ __forceinline__ unsigned xb_add(unsigned* p, unsigned v) { return __hip_atomic_fetch_add(p, v, __ATOMIC_RELAXED, __HIP_MEMORY_SCOPE_AGENT); }
__device__ __forceinline__ unsigned xb_xcc_id() { return (unsigned)__builtin_amdgcn_s_getreg((3 << 11) | 20) & 0xFu; }
#define XB_SPIN(cond, bar) do { unsigned _sp = 0; while (cond) { __builtin_amdgcn_s_sleep(1); \
    if ((++_sp & 255u) == 0u) { if (xb_ld(&(bar)[XB_TMO])) break; if (_sp > XB_SPIN_CAP) { atomicAdd(&(bar)[XB_TMO], 1u); break; } } } } while (0)

struct XcdBarrier {
    unsigned* bar; unsigned x;
    volatile LAS unsigned* st;
};

__device__ __forceinline__ XcdBarrier xcd_barrier_post(unsigned* bar, volatile LAS unsigned* st, bool leader) {
    XcdBarrier b; b.bar = bar; b.x = xb_xcc_id(); b.st = st;
    if (leader) (void)xb_add(&bar[XB_XCNT(b.x)], 1u);
    return b;
}
__device__ __forceinline__ void xcd_barrier_complete(unsigned* bar, unsigned x, unsigned& nloc, unsigned& nx) {
    const unsigned G = gridDim.x * gridDim.y * gridDim.z;
    unsigned sum, cnt, mine, sp = 0u;
    for (;;) {
        sum = 0u; cnt = 0u; mine = 0u;
#pragma unroll
        for (unsigned j = 0; j < 16; ++j) { const unsigned c = xb_ld(&bar[XB_XCNT(j)]); sum += c; cnt += (c > 0u) ? 1u : 0u; }
        mine = xb_ld(&bar[XB_XCNT(x)]);
        if (sum == G) break;
        __builtin_amdgcn_s_sleep(1);
        if ((++sp & 255u) == 0u) { if (xb_ld(&bar[XB_TMO])) break; if (sp > XB_SPIN_CAP) { atomicAdd(&bar[XB_TMO], 1u); break; } }
    }
    nloc = mine > 0u ? mine : 1u; nx = cnt > 0u ? cnt : 1u;
}

__device__ __forceinline__ void xcd_barrier(const XcdBarrier& b, bool leader) {
    asm volatile("s_waitcnt vmcnt(0)" ::: "memory");
    __syncthreads();
    if (leader) {
        unsigned* bar = b.bar;
        __builtin_amdgcn_s_waitcnt(0);
        unsigned nloc = b.st[0], nx = b.st[1];
        if (nloc == 0u) { xcd_barrier_complete(bar, b.x, nloc, nx); b.st[0] = nloc; b.st[1] = nx; }
        const unsigned old = xb_add(&bar[XB_XSUB(b.x)], 1u);
        const unsigned gen = old / nloc;
        if (old + 1u == (gen + 1u) * nloc) {
            __builtin_amdgcn_fence(__ATOMIC_RELEASE, "agent");
            asm volatile("s_waitcnt vmcnt(0)" ::: "memory");
            const unsigned og = xb_add(&bar[XB_TOP], 1u);
            const unsigned tg = og / nx;
            if (og + 1u == (tg + 1u) * nx) xb_add(&bar[XB_TOPGEN], 1u);
            else XB_SPIN(xb_ld(&bar[XB_TOPGEN]) == tg, bar);
            __builtin_amdgcn_fence(__ATOMIC_ACQUIRE, "agent");
            xb_add(&bar[XB_XGEN(b.x)], 1u);
            asm volatile("s_waitcnt vmcnt(0)" ::: "memory");
        } else {
            XB_SPIN(xb_ld(&bar[XB_XGEN(b.x)]) == gen, bar);
            __builtin_amdgcn_fence(__ATOMIC_ACQUIRE, "agent");
            asm volatile("s_waitcnt vmcnt(0)" ::: "memory");
        }
    }
    __syncthreads();
}
struct Args { const float* in[26]; float* out; unsigned char* ws; int ph_lo, ph_hi; };
typedef const unsigned char __attribute__((address_space(4)))* kptr_t;
struct KA { kptr_t kp;
    __device__ __forceinline__ const float* in(int k) const { return *(const float* const __attribute__((address_space(4)))*)(kp + 8 * k); }
    __device__ __forceinline__ float* out() const { return *(float* const __attribute__((address_space(4)))*)(kp + 208); }
    __device__ __forceinline__ unsigned char* ws() const { return *(unsigned char* const __attribute__((address_space(4)))*)(kp + 216); } };
struct Frame {
    LAS unsigned char* lds;
    volatile LAS unsigned* MISC;
    gu32* ctl;
    int tid, lane, wave;
    int vcu, G, bx;
    float* out; unsigned char* ws;
};
__device__ __forceinline__ float wave_sum(float v) {
    const int lane = mk_lane();
#pragma unroll
    for (int o = 1; o < 64; o <<= 1) v += lshfl(v, lane ^ o);
    return v;
}
template <bool ROPEPERM, bool F8 = false>
__device__ __forceinline__ void p0_transpose_item(const float* W, int K, int N, bf16* WT, LAS float* scr, int item, int lane) {
    const int nblk = N / 32, kb = item / nblk, nb = item % nblk, k0 = 64 * kb, n0 = 32 * nb;
    int ncol = n0 + (lane & 31);
    if (ROPEPERM && ncol < 2048) { const int pc = ncol & 63; ncol = (ncol & ~63) + (pc >> 1) + 32 * (pc & 1); }
#pragma unroll 8
    for (int i = 0; i < 32; ++i) { const int kk = 2 * i + (lane >> 5); scr[kk * 33 + (lane & 31)] = W[(size_t)(k0 + kk) * N + ncol]; }
    LDS_WAIT(); asm volatile("" ::: "memory");
    const int c = lane & 7;
#pragma unroll
    for (int j = 0; j < 4; ++j) { const int n = (lane >> 3) + 8 * j; const LAS float* s = scr + (8 * c) * 33 + n;
        if (F8) { v2u o; o.x = pk4_fp8x8(s[0 * 33] * 32.0f, s[1 * 33] * 32.0f, s[2 * 33] * 32.0f, s[3 * 33] * 32.0f); o.y = pk4_fp8x8(s[4 * 33] * 32.0f, s[5 * 33] * 32.0f, s[6 * 33] * 32.0f, s[7 * 33] * 32.0f);
            *(GAS v2u*)((unsigned char*)WT + (size_t)(n0 + n) * K + k0 + 8 * c) = o; continue; }
        v4u o; o.x = pk2(s[0 * 33], s[1 * 33]); o.y = pk2(s[2 * 33], s[3 * 33]); o.z = pk2(s[4 * 33], s[5 * 33]); o.w = pk2(s[6 * 33], s[7 * 33]);
        *(GAS v4u*)(WT + (size_t)(n0 + n) * K + k0 + 8 * c) = o; }
    LDS_WAIT(); asm volatile("" ::: "memory");
}
template <bool MASK>
__device__ __forceinline__ void cvt_row(const float* src, bf16* dst, int lane, int flat0) {
    const GAS f32x4* s4 = (const GAS f32x4*)src + lane; GAS v2u* d2 = (GAS v2u*)dst + lane;
#pragma unroll
    for (int j = 0; j < 4; ++j) { f32x4 v = s4[64 * j];
        if (MASK) { const int idx = flat0 + j * 256 + lane * 4; const int t = (idx >> 7) & 127, s = idx & 127;
            if (s + 0 > t) v.x = 0.f; if (s + 1 > t) v.y = 0.f; if (s + 2 > t) v.z = 0.f; if (s + 3 > t) v.w = 0.f; }
        v2u o; o.x = pk2(v.x, v.y); o.y = pk2(v.z, v.w); d2[64 * j] = o; }
}
template <int OFFS>
__device__ __forceinline__ void quant_rows4(const float* src, unsigned char* dst, int dpitch, float* scale, int lane) {
    f32x4 v[4][4];
#pragma unroll
    for (int r = 0; r < 4; ++r)
#pragma unroll
        for (int j = 0; j < 4; ++j) v[r][j] = *((const GAS f32x4*)(src + (size_t)r * 1024) + lane + 64 * j);
#pragma unroll
    for (int r = 0; r < 4; ++r) { float am = 0.f;
#pragma unroll
        for (int j = 0; j < 4; ++j) am = __builtin_fmaxf(am, __builtin_fmaxf(__builtin_fmaxf(__builtin_fabsf(v[r][j].x), __builtin_fabsf(v[r][j].y)), __builtin_fmaxf(__builtin_fabsf(v[r][j].z), __builtin_fabsf(v[r][j].w))));
#pragma unroll
        for (int o = 1; o < 64; o <<= 1) am = __builtin_fmaxf(am, lshfl(am, lane ^ o));
        const float sc = am > 0.f ? am * (OFFS == -8 ? 1.0f / 448.0f : 1.0f / 127.0f) : 1.0f, inv = 1.0f / sc; GAS unsigned* d1 = (GAS unsigned*)(dst + (size_t)r * dpitch) + lane;
#pragma unroll
        for (int j = 0; j < 4; ++j) { if (OFFS == -8) {
                int pk = 0; pk = __builtin_amdgcn_cvt_pk_fp8_f32(v[r][j].x * inv, v[r][j].y * inv, pk, false); pk = __builtin_amdgcn_cvt_pk_fp8_f32(v[r][j].z * inv, v[r][j].w * inv, pk, true); d1[64 * j] = (unsigned)pk; continue; } const int a = (int)__builtin_rintf(v[r][j].x * inv) + OFFS, b = (int)__builtin_rintf(v[r][j].y * inv) + OFFS, c = (int)__builtin_rintf(v[r][j].z * inv) + OFFS, d = (int)__builtin_rintf(v[r][j].w * inv) + OFFS;
            d1[64 * j] = (unsigned)(a & 255) | ((unsigned)(b & 255) << 8) | ((unsigned)(c & 255) << 16) | ((unsigned)(d & 255) << 24); }
        if (lane == 0) scale[r] = sc; }
}
__device__ __forceinline__ void quant_rows4_u4(const float* src, unsigned char* dst, int dpitch, float* scale, int lane) {
    f32x4 v[4][4];
#pragma unroll
    for (int r = 0; r < 4; ++r)
#pragma unroll
        for (int j = 0; j < 4; ++j) v[r][j] = *((const GAS f32x4*)(src + (size_t)r * 1024) + lane + 64 * j);
#pragma unroll
    for (int r = 0; r < 4; ++r) { float s2 = 0.f;
#pragma unroll
        for (int j = 0; j < 4; ++j) s2 += (v[r][j].x * v[r][j].x + v[r][j].y * v[r][j].y) + (v[r][j].z * v[r][j].z + v[r][j].w * v[r][j].w);
        s2 = wave_sum(s2);
        const float sc = s2 > 0.f ? 0.3352f * sqrtf(s2 * (1.0f / 1024.0f)) : 1.0f, inv = 1.0f / sc; GAS unsigned short* d1 = (GAS unsigned short*)(dst + (size_t)r * dpitch) + lane;
#pragma unroll
        for (int j = 0; j < 4; ++j) { const float c0 = __builtin_fminf(__builtin_fmaxf(__builtin_rintf(v[r][j].x * inv + 7.5f), 0.f), 15.f), c1 = __builtin_fminf(__builtin_fmaxf(__builtin_rintf(v[r][j].y * inv + 7.5f), 0.f), 15.f),
                c2 = __builtin_fminf(__builtin_fmaxf(__builtin_rintf(v[r][j].z * inv + 7.5f), 0.f), 15.f), c3 = __builtin_fminf(__builtin_fmaxf(__builtin_rintf(v[r][j].w * inv + 7.5f), 0.f), 15.f);
            d1[64 * j] = (unsigned short)((unsigned)c0 | ((unsigned)c1 << 4) | ((unsigned)c2 << 8) | ((unsigned)c3 << 12)); }
        if (lane == 0) scale[r] = sc; }
}
__device__ __forceinline__ void quant_rows4_fp4(const float* src, unsigned char* dst, int dpitch, float* scale, int lane) {
    f32x4 v[4][4];
#pragma unroll
    for (int r = 0; r < 4; ++r)
#pragma unroll
        for (int j = 0; j < 4; ++j) v[r][j] = *((const GAS f32x4*)(src + (size_t)r * 1024) + lane + 64 * j);
#pragma unroll
    for (int r = 0; r < 4; ++r) { float s2 = 0.f;
#pragma unroll
        for (int j = 0; j < 4; ++j) s2 += (v[r][j].x * v[r][j].x + v[r][j].y * v[r][j].y) + (v[r][j].z * v[r][j].z + v[r][j].w * v[r][j].w);
        s2 = wave_sum(s2);
        const float sc = s2 > 0.f ? 0.5f * sqrtf(s2 * (1.0f / 1024.0f)) : 1.0f, inv = 1.0f / sc; GAS unsigned short* d1 = (GAS unsigned short*)(dst + (size_t)r * dpitch) + lane;
#pragma unroll
        for (int j = 0; j < 4; ++j) { const float c0 = __builtin_fminf(__builtin_fmaxf(v[r][j].x * inv, -6.f), 6.f), c1 = __builtin_fminf(__builtin_fmaxf(v[r][j].y * inv, -6.f), 6.f),
                c2 = __builtin_fminf(__builtin_fmaxf(v[r][j].z * inv, -6.f), 6.f), c3 = __builtin_fminf(__builtin_fmaxf(v[r][j].w * inv, -6.f), 6.f);
            unsigned pk = 0u; pk = __builtin_amdgcn_cvt_scalef32_pk_fp4_f32(pk, c0, c1, 1.0f, 0); pk = __builtin_amdgcn_cvt_scalef32_pk_fp4_f32(pk, c2, c3, 1.0f, 1);
            d1[64 * j] = (unsigned short)pk; }
        if (lane == 0) scale[r] = sc; }
}
constexpr int I_WINE = 2 * 16 * 48, I_WOUTE = 2 * 16 * 32, I_WINO = 2 * 16 * 96, I_WOUTO = 2 * 16 * 32, I_WQ = 4 * 16 * 64, I_WPT = 8 * 8;
constexpr int I_RU = 16384, I_RV = 16384  , I_RSK = 1024, I_RWS = 128, I_ROPE = M * 32 / 64;
constexpr int NITEMS = I_WINE + I_WOUTE + I_WINO + I_WOUTO + I_WQ + I_WPT + I_RU + I_RV + I_RSK + I_RWS + I_ROPE;
__device__ __forceinline__ void p0_prologue(Frame& F, const KA& A) {
    unsigned char* ws = F.ws; const int lane = mk_lane();
    for (int item = F.vcu; item < 4 * 48 + ((F.G - (4 * 48) % F.G) % F.G); item += F.G) {
        float acc[8][2];
#pragma unroll
        for (int b = 0; b < 8; ++b) { acc[b][0] = 0.f; acc[b][1] = 0.f; }
        const bool live = item < 4 * 48; const int l = live ? item / 48 : 0, nb = live ? item % 48 : 0;
        if (live) { const float* W = A.in(3) + (size_t)l * 1024 * 6144 + nb * 128 + 2 * lane; const float* c = A.in(1);
#pragma unroll 1
            for (int kb = 0; kb < 2; ++kb) { const int k0 = F.wave * 128 + kb * 64;
                float cv[8];
#pragma unroll
                for (int b = 0; b < 8; ++b) { const float x = c[b * 1024 + k0 + lane]; cv[b] = x / (1.0f + __expf(-x)); }
#pragma unroll 16
                for (int kk = 0; kk < 64; ++kk) { const f32x2 w = *(const GAS f32x2*)(W + (size_t)(k0 + kk) * 6144);
#pragma unroll
                    for (int b = 0; b < 8; ++b) { const float cb = asf(__builtin_amdgcn_readlane(asu(cv[b]), kk)); acc[b][0] += cb * w.x; acc[b][1] += cb * w.y; } } } }
        LAS float* red = (LAS float*)(F.lds + RING_OFF);
#pragma unroll
        for (int b = 0; b < 8; ++b) *(LAS f32x2*)(red + (F.wave * 8 + b) * 128 + 2 * lane) = (f32x2){acc[b][0], acc[b][1]};
        LDS_WAIT(); __syncthreads();
        if (live) { const int t = F.wave * 64 + lane;
#pragma unroll
            for (int q = 0; q < 2; ++q) { const int o = t + 512 * q, b = o >> 7, col = o & 127; float sum = 0.f;
#pragma unroll
                for (int w = 0; w < 8; ++w) sum += red[(w * 8 + b) * 128 + col];
                ((float*)(ws + WS_MOD))[((size_t)l * 8 + b) * 6144 + nb * 128 + col] = sum + A.in(4)[l * 6144 + nb * 128 + col]; } }
        LDS_WAIT(); __syncthreads();
    }
    LAS float* scr = (LAS float*)(F.lds + RING_OFF + F.wave * 16384);
    const int gw = F.vcu * NWAVES + F.wave, NGW = F.G * NWAVES;
    for (int it = gw; it < NITEMS; it += NGW) {
        int r = it;
        if (r < I_WINE) { const int e = r / 768; p0_transpose_item<false, FP8_EVEN != 0>(A.in(7) + (size_t)e * 1024 * 1536, 1024, 1536, (bf16*)(ws + WS_WINE + (size_t)e * 1536 * 1024 * (FP8_EVEN ? 1 : 2)), scr, r % 768, lane); continue; } r -= I_WINE;
        if (r < I_WOUTE) { const int e = r / 512; p0_transpose_item<false>(A.in(13) + (size_t)e * 1024 * 1024, 1024, 1024, (bf16*)(ws + WS_WOUTE) + (size_t)e * 1024 * 1024, scr, r % 512, lane); continue; } r -= I_WOUTE;
        if (r < I_WINO) { const int e = r / 1536; p0_transpose_item<true, FP8_ODD != 0>(A.in(14) + (size_t)e * 1024 * 3072, 1024, 3072, (bf16*)(ws + WS_WINO + (size_t)e * 3072 * 1024 * (FP8_ODD ? 1 : 2)), scr, r % 1536, lane); continue; } r -= I_WINO;
        if (r < I_WOUTO) { const int e = r / 512; p0_transpose_item<false>(A.in(20) + (size_t)e * 1024 * 1024, 1024, 1024, (bf16*)(ws + WS_WOUTO) + (size_t)e * 1024 * 1024, scr, r % 512, lane); continue; } r -= I_WOUTO;
        if (r < I_WQ) { const int e = r / 1024; p0_transpose_item<false>(A.in(21) + (size_t)e * 1024 * 2048, 1024, 2048, (bf16*)(ws + WS_WQ) + (size_t)e * 2048 * 1024, scr, r % 1024, lane); continue; } r -= I_WQ;
        if (r < I_WPT) { const int e = r / 8; p0_transpose_item<false>(A.in(11) + (size_t)e * 128 * 128, 128, 128, (bf16*)(ws + WS_WPT) + (size_t)e * 128 * 128, scr, r % 8, lane); continue; } r -= I_WPT;
        if (r < I_RU) { quant_rows4_fp4(A.in(23) + (size_t)r * 4096, ws + WS_UV + (size_t)r * (4 * PEER_REC), PEER_REC, (float*)(ws + WS_SU) + 4 * r, lane); continue; } r -= I_RU;
        if (r < I_RV) { quant_rows4_fp4(A.in(24) + (size_t)r * 4096, ws + WS_UV + 512 + (size_t)r * (4 * PEER_REC), PEER_REC, (float*)(ws + WS_SV) + 4 * r, lane); continue; } r -= I_RV;
        if (r < I_RSK) { cvt_row<false>(A.in(22) + (size_t)r * 1024, (bf16*)(ws + WS_SUBK) + (size_t)r * 1024, lane, 0); continue; } r -= I_RSK;
        if (r < I_RWS) { cvt_row<true>(A.in(9) + (size_t)r * 1024, (bf16*)(ws + WS_WSG) + (size_t)r * 1024, lane, r * 1024); continue; } r -= I_RWS;
        {
            const int idx = r * 64 + lane, row = idx >> 5, i = idx & 31;
            const int pos = ((const int*)A.in(2))[row];
            const float g = __builtin_amdgcn_exp2f(-0.41524101186092029f * (float)i) * 0.15915494309189535f, fp = (float)pos;
            const float fr = __builtin_fmaf(fp, g, -__builtin_rintf(fp * g));
            const float s = __builtin_amdgcn_sinf(fr), c = __builtin_amdgcn_cosf(fr);
            ((GAS f32x2*)(ws + WS_ROPE))[idx] = (f32x2){c, s};
        }
    }
}

__device__ __forceinline__ void norm_phase(Frame& F, const float* src, const float* gain, const float* sh, const float* sc, bf16* dst) {
    const int gw = F.vcu * NWAVES + F.wave, NGW = F.G * NWAVES, lane = mk_lane();
    const GAS f32x4* g4 = (const GAS f32x4*)gain + lane;
    for (int m = gw; m < M; m += NGW) {
        const int b = m >> 12;
        const GAS f32x4* xr = (const GAS f32x4*)(src + (size_t)m * 1024) + lane;
        const GAS f32x4* s4 = (const GAS f32x4*)(sh + (size_t)b * 6144) + lane; const GAS f32x4* c4 = (const GAS f32x4*)(sc + (size_t)b * 6144) + lane;
        f32x4 v[4]; float s2 = 0.f;
#pragma unroll
        for (int j = 0; j < 4; ++j) { v[j] = xr[64 * j]; s2 += (v[j].x * v[j].x + v[j].y * v[j].y) + (v[j].z * v[j].z + v[j].w * v[j].w); }
        const float rstd = 1.0f / sqrtf(wave_sum(s2) * (1.0f / 1024.0f) + RMS_EPS);
        GAS unsigned* o1 = (GAS unsigned*)((unsigned char*)dst + (size_t)m * 1024) + lane;
        GAS v2u* o2 = (GAS v2u*)(dst + (size_t)m * 1024) + lane;
#pragma unroll
        for (int j = 0; j < 4; ++j) { const f32x4 g = g4[64 * j], a = s4[64 * j], c = c4[64 * j];
            const f32x4 o = v[j] * rstd * g * (c + 1.0f) + a; if (FP8_EVEN) o1[64 * j] = pk4_fp8x8(o.x, o.y, o.z, o.w); else { v2u w; w.x = pk2(o.x, o.y); w.y = pk2(o.z, o.w); o2[64 * j] = w; } }
    }
}
__device__ __forceinline__ void shw_items(Frame& F) {
    const int gw = F.vcu * NWAVES + F.wave, NGW = F.G * NWAVES, lane = mk_lane();
    const bf16* WQ = (const bf16*)(F.ws + WS_WQ); const float* mod = (const float*)(F.ws + WS_MOD); float* shw = (float*)(F.ws + WS_SHW);
    for (int it = gw; it < 4 * 2048; it += NGW) { const int l = it >> 11, n = it & 2047;
        const v4u wa = *(const GAS v4u*)(WQ + ((size_t)l * 2048 + n) * 1024 + lane * 16), wb = *(const GAS v4u*)(WQ + ((size_t)l * 2048 + n) * 1024 + lane * 16 + 8);
        const unsigned ww[8] = {wa.x, wa.y, wa.z, wa.w, wb.x, wb.y, wb.z, wb.w}; float wf[16];
#pragma unroll
        for (int j = 0; j < 8; ++j) { wf[2 * j] = bflo(ww[j]); wf[2 * j + 1] = bfhi(ww[j]); }
        float res = 0.f;
#pragma unroll
        for (int b = 0; b < 8; ++b) { const float* sh = mod + ((size_t)l * 8 + b) * 6144 + 3072 + lane * 16; float d = 0.f;
#pragma unroll
            for (int q = 0; q < 4; ++q) { const f32x4 s4 = *(const GAS f32x4*)(sh + 4 * q); d += (s4.x * wf[4 * q] + s4.y * wf[4 * q + 1]) + (s4.z * wf[4 * q + 2] + s4.w * wf[4 * q + 3]); }
            d = wave_sum(d); res = (lane == b) ? d : res; }
        if (lane < 8) shw[((size_t)l * 8 + lane) * 2048 + n] = res; }
}
__device__ __forceinline__ void final_norm_phase(Frame& F, const float* src, const float* gain, float* dst) {
    const int gw = F.vcu * NWAVES + F.wave, NGW = F.G * NWAVES, lane = mk_lane();
    const GAS f32x4* g4 = (const GAS f32x4*)gain + lane;
    for (int m = gw; m < M; m += NGW) {
        const GAS f32x4* xr = (const GAS f32x4*)(src + (size_t)m * 1024) + lane;
        f32x4 v[4]; float s2 = 0.f;
#pragma unroll
        for (int j = 0; j < 4; ++j) { v[j] = xr[64 * j]; s2 += (v[j].x * v[j].x + v[j].y * v[j].y) + (v[j].z * v[j].z + v[j].w * v[j].w); }
        const float rstd = 1.0f / sqrtf(wave_sum(s2) * (1.0f / 1024.0f) + RMS_EPS);
        GAS f32x4* o4 = (GAS f32x4*)(dst + (size_t)m * 1024) + lane;
#pragma unroll
        for (int j = 0; j < 4; ++j) o4[64 * j] = v[j] * rstd * g4[64 * j];
#ifdef PROBE_TIME
        { const float cval = (float)(((const unsigned*)(F.ws + WS_CTL) + 2048)[PROBE_TIME]) * 0.00025f;
#pragma unroll
          for (int j = 0; j < 4; ++j) o4[64 * j] = (f32x4){cval, cval, cval, cval}; }
#endif
    }
}

__device__ __forceinline__ s16x4 tr16(LAS const unsigned char* p) { typedef short v4i16_t __attribute__((ext_vector_type(4))); return __builtin_bit_cast(s16x4, __builtin_amdgcn_ds_read_tr16_b64_v4i16((LAS v4i16_t*)p)); }
__device__ __forceinline__ void e2_phase(Frame& F, const KA& A, int e) {
    const int lane = mk_lane(), wave = F.wave, r32 = lane & 31, hi = lane >> 5;
    const bf16* PROJ = (const bf16*)(F.ws + WS_PROJ); bf16* MIX = (bf16*)(F.ws + WS_MIX);
    const bf16* WSG = (const bf16*)(F.ws + WS_WSG) + (size_t)e * 4 * 128 * 128; const bf16* WPT = (const bf16*)(F.ws + WS_WPT) + (size_t)e * 4 * 128 * 128;
    const float* gv = A.in(8) + e * 512; const float* bs = A.in(10) + e * 512; const float* ls = A.in(12) + e * 512;
    LAS unsigned char* lds = F.lds;
    for (int unit = F.vcu; unit < M / 128; unit += F.G) {
        const int row0 = unit * 128, pos0 = (unit & 31) * 128;
        {
            const f32x4 ga = *(const GAS f32x4*)(gv + lane * 8), gb = *(const GAS f32x4*)(gv + lane * 8 + 4);
            v4u raw[16];
#pragma unroll
            for (int tt = 0; tt < 16; ++tt) raw[tt] = *(const GAS v4u*)(PROJ + (size_t)(row0 + wave * 16 + tt) * 1536 + 512 + lane * 8);
#pragma unroll
            for (int hf = 0; hf < 2; ++hf) { float x[8][8], sm[8], q[8];
#pragma unroll
                for (int tt = 0; tt < 8; ++tt) { const v4u r = raw[hf * 8 + tt];
                    x[tt][0] = bflo(r.x); x[tt][1] = bfhi(r.x); x[tt][2] = bflo(r.y); x[tt][3] = bfhi(r.y); x[tt][4] = bflo(r.z); x[tt][5] = bfhi(r.z); x[tt][6] = bflo(r.w); x[tt][7] = bfhi(r.w);
                    float t = 0.f;
#pragma unroll
                    for (int j = 0; j < 8; ++j) t += x[tt][j];
                    sm[tt] = t; }
#pragma unroll
                for (int o = 1; o < 64; o <<= 1) {
#pragma unroll
                    for (int tt = 0; tt < 8; ++tt) sm[tt] += lshfl(sm[tt], lane ^ o); }
#pragma unroll
                for (int tt = 0; tt < 8; ++tt) { const float mu = sm[tt] * (1.0f / 512.0f); float t = 0.f;
#pragma unroll
                    for (int j = 0; j < 8; ++j) { x[tt][j] -= mu; t += x[tt][j] * x[tt][j]; }
                    q[tt] = t; }
#pragma unroll
                for (int o = 1; o < 64; o <<= 1) {
#pragma unroll
                    for (int tt = 0; tt < 8; ++tt) q[tt] += lshfl(q[tt], lane ^ o); }
#pragma unroll
                for (int tt = 0; tt < 8; ++tt) { const int s = wave * 16 + hf * 8 + tt;
                    const float rstd = 1.0f / sqrtf(q[tt] * (1.0f / 512.0f) + RMS_EPS);
                    v4u o; o.x = pk2(x[tt][0] * rstd * ga.x, x[tt][1] * rstd * ga.y); o.y = pk2(x[tt][2] * rstd * ga.z, x[tt][3] * rstd * ga.w);
                    o.z = pk2(x[tt][4] * rstd * gb.x, x[tt][5] * rstd * gb.y); o.w = pk2(x[tt][6] * rstd * gb.z, x[tt][7] * rstd * gb.w);
                    const int g = lane >> 4, c = (lane & 15) * 8;
                    *(LAS v4u*)(lds + g * 32768 + (c >> 5) * 8192 + s * 64 + (c & 31) * 2) = o; } }
        }
        LDS_WAIT(); __syncthreads();
        const int tt2 = wave >> 1, ch = wave & 1;
        const int t = 32 * tt2 + r32, row = row0 + t;
        bf16x8 wf[2][8];
#pragma unroll
        for (int ks = 0; ks < 8; ++ks) wf[0][ks] = *(const GAS bf16x8*)(WSG + (size_t)t * 128 + 8 * hi + 16 * ks);
#pragma unroll
        for (int g = 0; g < 4; ++g) {
            f32x16 acc[2]; acc[0] = f32x16{}; acc[1] = f32x16{};
            if (g + 1 < 4) {
#pragma unroll
                for (int ks = 0; ks < 8; ++ks) wf[(g + 1) & 1][ks] = *(const GAS bf16x8*)(WSG + (size_t)((g + 1) * 128 + t) * 128 + 8 * hi + 16 * ks); }
            v2u uu[2][4];
#pragma unroll
            for (int cc = 0; cc < 2; ++cc)
#pragma unroll
                for (int q = 0; q < 4; ++q) uu[cc][q] = *(const GAS v2u*)(PROJ + (size_t)row * 1536 + g * 128 + 32 * (2 * ch + cc) + 8 * q + 4 * hi);
            const float bsv = bs[g * 128 + t];
#pragma unroll
            for (int ks = 0; ks < 8; ++ks) { const bf16x8 bfrag = wf[g & 1][ks];
#pragma unroll
                for (int cc = 0; cc < 2; ++cc) { const int ct = 2 * ch + cc;
                    LAS const unsigned char* ap = lds + g * 32768 + ct * 8192 + (16 * ks) * 64 + ((lane >> 4) & 1) * 32 + (lane & 3) * 8 + (8 * hi + ((lane & 15) >> 2)) * 64;
                    const s16x4 lo = tr16(ap), h4 = tr16(ap + 256);
                    const bf16x8 afrag = (bf16x8){lo[0], lo[1], lo[2], lo[3], h4[0], h4[1], h4[2], h4[3]};
                    acc[cc] = __builtin_amdgcn_mfma_f32_32x32x16_bf16(afrag, bfrag, acc[cc], 0, 0, 0); } }
#pragma unroll
            for (int cc = 0; cc < 2; ++cc)
#pragma unroll
                for (int q = 0; q < 4; ++q) { const int c0 = 32 * (2 * ch + cc) + 8 * q + 4 * hi; const v2u u2 = uu[cc][q];
                    v2u o; o.x = pk2(bflo(u2.x) * (acc[cc][4 * q] + bsv), bfhi(u2.x) * (acc[cc][4 * q + 1] + bsv)); o.y = pk2(bflo(u2.y) * (acc[cc][4 * q + 2] + bsv), bfhi(u2.y) * (acc[cc][4 * q + 3] + bsv));
                    *(GAS v2u*)(MIX + (size_t)row * 1024 + g * 128 + c0) = o; }
        }
        LDS_WAIT(); __syncthreads();
        {
            v4u st[18];
#pragma unroll
            for (int i = 0; i < 18; ++i) { const int c = F.wave * 64 + lane + 512 * i; const int rr = c >> 6, c16 = c & 63, tt = rr - 15;
                st[i] = (v4u){0u, 0u, 0u, 0u}; if (c < 143 * 64 && pos0 + tt >= 0) st[i] = *(const GAS v4u*)(PROJ + (size_t)(row0 + tt) * 1536 + 1024 + c16 * 8); }
#pragma unroll
            for (int i = 0; i < 18; ++i) { const int c = F.wave * 64 + lane + 512 * i; const int rr = c >> 6, c16 = c & 63;
                if (c < 143 * 64) *(LAS v4u*)(lds + rr * 1040 + c16 * 16) = st[i]; }
        }
        LDS_WAIT(); __syncthreads();
        const int pos = pos0 + t;
#pragma unroll 1
        for (int g = 0; g < 4; ++g) { const int w = 2 << g;
            f32x16 acc[2]; acc[0] = f32x16{}; acc[1] = f32x16{};
            const int cnt = (pos + 1 < w) ? pos + 1 : w; const float rc = 1.0f / (float)cnt;
            bf16x8 af[8][2];
#pragma unroll
            for (int ks = 0; ks < 8; ++ks)
#pragma unroll
                for (int cc = 0; cc < 2; ++cc) af[ks][cc] = *(const GAS bf16x8*)(WPT + (size_t)(g * 128 + 32 * (2 * ch + cc) + r32) * 128 + 16 * ks + 8 * hi);
#pragma unroll
            for (int ks = 0; ks < 8; ++ks) {
                LAS const unsigned char* pp = lds + (t + 15) * 1040 + (g * 128 + 16 * ks + 8 * hi) * 2;
                float sum[8], own[8];
                { const v4u raw = *(const LAS v4u*)pp; own[0] = bflo(raw.x); own[1] = bfhi(raw.x); own[2] = bflo(raw.y); own[3] = bfhi(raw.y); own[4] = bflo(raw.z); own[5] = bfhi(raw.z); own[6] = bflo(raw.w); own[7] = bfhi(raw.w); }
#pragma unroll
                for (int j = 0; j < 8; ++j) sum[j] = own[j];
#pragma unroll 2
                for (int j2 = 1; j2 < w; ++j2) { const v4u raw = *(const LAS v4u*)(pp - j2 * 1040);
                    sum[0] += bflo(raw.x); sum[1] += bfhi(raw.x); sum[2] += bflo(raw.y); sum[3] += bfhi(raw.y); sum[4] += bflo(raw.z); sum[5] += bfhi(raw.z); sum[6] += bflo(raw.w); sum[7] += bfhi(raw.w); }
                v4u pk; pk.x = pk2(sum[0] * rc - own[0], sum[1] * rc - own[1]); pk.y = pk2(sum[2] * rc - own[2], sum[3] * rc - own[3]); pk.z = pk2(sum[4] * rc - own[4], sum[5] * rc - own[5]); pk.w = pk2(sum[6] * rc - own[6], sum[7] * rc - own[7]);
                const bf16x8 bfrag = __builtin_bit_cast(bf16x8, pk);
#pragma unroll
                for (int cc = 0; cc < 2; ++cc) acc[cc] = __builtin_amdgcn_mfma_f32_32x32x16_bf16(af[ks][cc], bfrag, acc[cc], 0, 0, 0); }
#pragma unroll
            for (int cc = 0; cc < 2; ++cc)
#pragma unroll
                for (int q = 0; q < 4; ++q) { const int d0 = 32 * (2 * ch + cc) + 8 * q + 4 * hi; const f32x4 lq = *(const GAS f32x4*)(ls + g * 128 + d0);
                    v2u o; o.x = pk2(acc[cc][4 * q] * lq.x, acc[cc][4 * q + 1] * lq.y); o.y = pk2(acc[cc][4 * q + 2] * lq.z, acc[cc][4 * q + 3] * lq.w);
                    *(GAS v2u*)(MIX + (size_t)row * 1024 + 512 + g * 128 + d0) = o; }
        }
        LDS_WAIT(); __syncthreads();
    }
}

__device__ __forceinline__ void combine_phase(Frame& F, const KA& A, int o, float lam_init) {
    const int gw = F.vcu * NWAVES + F.wave, NGW = F.G * NWAVES, lane = mk_lane();
    const float s1 = wave_sum(A.in(15)[o * 64 + lane] * A.in(16)[o * 64 + lane]), s2 = wave_sum(A.in(17)[o * 64 + lane] * A.in(18)[o * 64 + lane]);
    const float lam = __expf(s1) - __expf(s2) + lam_init, post = 1.0f - lam_init;
    const int h = lane >> 3, dv0 = (lane & 7) * 16;
    float gs[16];
#pragma unroll
    for (int j = 0; j < 16; ++j) gs[j] = A.in(19)[o * 128 + dv0 + j] * post;
    bf16* OATT = (bf16*)(F.ws + WS_HB);
    for (int m = gw; m < M; m += NGW) {
        bf16* rowp = OATT + (size_t)m * 2048;
        const v4u a0 = *(const GAS v4u*)(rowp + (2 * h) * 128 + dv0), a1 = *(const GAS v4u*)(rowp + (2 * h) * 128 + dv0 + 8);
        const v4u b0 = *(const GAS v4u*)(rowp + (2 * h + 1) * 128 + dv0), b1 = *(const GAS v4u*)(rowp + (2 * h + 1) * 128 + dv0 + 8);
        const unsigned aw[8] = {a0.x, a0.y, a0.z, a0.w, a1.x, a1.y, a1.z, a1.w}, bw[8] = {b0.x, b0.y, b0.z, b0.w, b1.x, b1.y, b1.z, b1.w};
        float ov[16]; float q = 0.f;
#pragma unroll
        for (int j = 0; j < 8; ++j) { ov[2 * j] = bflo(aw[j]) - lam * bflo(bw[j]); ov[2 * j + 1] = bfhi(aw[j]) - lam * bfhi(bw[j]); q += ov[2 * j] * ov[2 * j] + ov[2 * j + 1] * ov[2 * j + 1]; }
        q += lshfl(q, lane ^ 1); q += lshfl(q, lane ^ 2); q += lshfl(q, lane ^ 4);
        const float rstd = 1.0f / sqrtf(q * (1.0f / 128.0f) + RMS_EPS);
        v4u o0, o1;
        o0.x = pk2(ov[0] * rstd * gs[0], ov[1] * rstd * gs[1]); o0.y = pk2(ov[2] * rstd * gs[2], ov[3] * rstd * gs[3]); o0.z = pk2(ov[4] * rstd * gs[4], ov[5] * rstd * gs[5]); o0.w = pk2(ov[6] * rstd * gs[6], ov[7] * rstd * gs[7]);
        o1.x = pk2(ov[8] * rstd * gs[8], ov[9] * rstd * gs[9]); o1.y = pk2(ov[10] * rstd * gs[10], ov[11] * rstd * gs[11]); o1.z = pk2(ov[12] * rstd * gs[12], ov[13] * rstd * gs[13]); o1.w = pk2(ov[14] * rstd * gs[14], ov[15] * rstd * gs[15]);
        asm volatile("" ::: "memory");
        *(GAS v4u*)(rowp + h * 128 + dv0) = o0; *(GAS v4u*)(rowp + h * 128 + dv0 + 8) = o1;
    }
}
__device__ __forceinline__ float med3f(float a, float b, float c) { return __builtin_amdgcn_fmed3f(a, b, c); }
#define INS16(L, x) do { _Pragma("unroll") for (int i_ = 15; i_ >= 1; --i_) L[i_] = med3f(L[i_ - 1], L[i_], (x)); L[0] = __builtin_fmaxf(L[0], (x)); } while (0)
__device__ __forceinline__ void topk128_sorted(const bf16x8 (&bq)[8], LAS const unsigned char* skl, int hi, int r32, float (&S)[16]) {
    f32x16 acc[4]; acc[0] = f32x16{}; acc[1] = f32x16{}; acc[2] = f32x16{}; acc[3] = f32x16{};
    LAS const unsigned char* sp = skl + r32 * 272 + 16 * hi;
#pragma unroll
    for (int kc = 0; kc < 8; ++kc) {
#pragma unroll
        for (int kt = 0; kt < 4; ++kt) { const bf16x8 a = *(const LAS bf16x8*)(sp + kt * 32 * 272 + 32 * kc);
            acc[kt] = __builtin_amdgcn_mfma_f32_32x32x16_bf16(a, bq[kc], acc[kt], 0, 0, 0); } }
    const unsigned hi4 = 4u * (unsigned)hi;
    float G[4][16];
#pragma unroll
    for (int kt = 0; kt < 4; ++kt) {
#pragma unroll
        for (int r = 0; r < 16; ++r) { const unsigned n = (unsigned)(32 * kt + (r & 3) + 8 * (r >> 2)) | hi4; G[kt][r] = asf((asu(acc[kt][r]) & ~127u) | n); }
#define CE(i, j) do { const float a_ = G[kt][i], b_ = G[kt][j]; G[kt][i] = __builtin_fmaxf(a_, b_); G[kt][j] = __builtin_fminf(a_, b_); } while (0);
        CE(0,1) CE(2,3) CE(0,2) CE(1,3) CE(1,2) CE(4,5) CE(6,7) CE(4,6) CE(5,7) CE(5,6) CE(0,4) CE(2,6) CE(2,4) CE(1,5) CE(3,7) CE(3,5) CE(1,2) CE(3,4) CE(5,6) CE(8,9) CE(10,11) CE(8,10) CE(9,11) CE(9,10) CE(12,13) CE(14,15) CE(12,14) CE(13,15) CE(13,14) CE(8,12) CE(10,14) CE(10,12) CE(9,13) CE(11,15) CE(11,13) CE(9,10) CE(11,12) CE(13,14) CE(0,8) CE(4,12) CE(4,8) CE(2,10) CE(6,14) CE(6,10) CE(2,4) CE(6,8) CE(10,12) CE(1,9) CE(5,13) CE(5,9) CE(3,11) CE(7,15) CE(7,11) CE(3,5) CE(7,9) CE(11,13) CE(1,2) CE(3,4) CE(5,6) CE(7,8) CE(9,10) CE(11,12) CE(13,14)
#undef CE
    }
#define MERGE16(X, Y, O) do { _Pragma("unroll") for (int i_ = 0; i_ < 16; ++i_) O[i_] = __builtin_fmaxf(X[i_], Y[15 - i_]); \
        _Pragma("unroll") for (int st_ = 8; st_ >= 1; st_ >>= 1) _Pragma("unroll") for (int i_ = 0; i_ < 16; ++i_) if (!(i_ & st_)) { const float a_ = O[i_], b_ = O[i_ + st_]; O[i_] = __builtin_fmaxf(a_, b_); O[i_ + st_] = __builtin_fminf(a_, b_); } } while (0)
    float MA[16], MB[16], L[16];
    MERGE16(G[0], G[1], MA); MERGE16(G[2], G[3], MB); MERGE16(MA, MB, L);
#undef MERGE16
#pragma unroll
    for (int i = 0; i < 8; ++i) { const int j = 15 - i;
        auto ri = __builtin_amdgcn_permlane32_swap(asu(L[i]), asu(L[i]), false, false); auto rj = __builtin_amdgcn_permlane32_swap(asu(L[j]), asu(L[j]), false, false);
        S[i] = __builtin_fmaxf(asf(ri[0]), asf(rj[1])); S[j] = __builtin_fmaxf(asf(rj[0]), asf(ri[1])); }
#pragma unroll
    for (int st = 8; st >= 1; st >>= 1)
#pragma unroll
        for (int i = 0; i < 16; ++i) if (!(i & st)) { const float a = S[i], b = S[i + st]; S[i] = __builtin_fmaxf(a, b); S[i + st] = __builtin_fminf(a, b); }
}
__device__ __forceinline__ void topk_phase(Frame& F, int l) {
    const int gw = F.vcu * NWAVES + F.wave, NGW = F.G * NWAVES, lane = mk_lane(), r32 = lane & 31, hi = lane >> 5;
    const bf16* QP = (const bf16*)(F.ws + WS_PROJ); const bf16* SUBK = (const bf16*)(F.ws + WS_SUBK) + (size_t)l * 8 * 2 * 128 * 128;
    unsigned short* EIDX = (unsigned short*)(F.ws + WS_EIDX); float* GATE = (float*)(F.ws + WS_GATE);
    LAS unsigned char* myl = F.lds + F.wave * 2048 + lane * 32;
    LAS unsigned char* skl = F.lds + 16384;
    const int wpg = (F.G >= 8 && F.G % 8 == 0) ? F.G / 8 : 0;
    const int h_fix = wpg ? F.vcu / wpg : 0;
    if (wpg) { const bf16* sk = SUBK + (size_t)h_fix * 2 * 128 * 128;
#pragma unroll
        for (int j = 0; j < 8; ++j) { const int c = F.wave * 64 + lane + 512 * j, pp = c >> 11, row = (c >> 4) & 127, c16 = c & 15;
            *(LAS v4u*)(skl + pp * 34816 + row * 272 + c16 * 16) = *(const GAS v4u*)(sk + (size_t)pp * 128 * 128 + row * 128 + c16 * 8); }
        LDS_WAIT(); __syncthreads(); }
    const int it0 = wpg ? (F.vcu % wpg) * NWAVES + F.wave : gw, itstep = wpg ? wpg * NWAVES : NGW, itend = wpg ? M / 32 : 8 * (M / 32);
    for (int item = it0; item < itend; item += itstep) {
        const int h = wpg ? h_fix : item / (M / 32), tg = wpg ? item : item % (M / 32), tok = tg * 32 + r32;
        bf16x8 bq0[8], bq1[8]; const bf16* qp = QP + (size_t)tok * 2048 + h * 256 + 8 * hi;
#pragma unroll
        for (int kc = 0; kc < 8; ++kc) bq0[kc] = *(const GAS bf16x8*)(qp + 16 * kc);
        if (!wpg) { __syncthreads();
            const bf16* sk = SUBK + (size_t)h * 2 * 128 * 128;
#pragma unroll
            for (int j = 0; j < 8; ++j) { const int c = F.wave * 64 + lane + 512 * j, pp = c >> 11, row = (c >> 4) & 127, c16 = c & 15;
                *(LAS v4u*)(skl + pp * 34816 + row * 272 + c16 * 16) = *(const GAS v4u*)(sk + (size_t)pp * 128 * 128 + row * 128 + c16 * 8); }
            LDS_WAIT(); __syncthreads(); }
        float S0[16], S1[16];
        topk128_sorted(bq0, skl, hi, r32, S0);
#pragma unroll
        for (int kc = 0; kc < 8; ++kc) bq1[kc] = *(const GAS bf16x8*)(qp + 128 + 16 * kc);
        topk128_sorted(bq1, skl + 34816, hi, r32, S1);
        float T[16];
#pragma unroll
        for (int i = 0; i < 16; ++i) T[i] = -3.0e38f;
#pragma unroll
        for (int i = 0; i < 16; ++i)
#pragma unroll
            for (int j = 0; j < 16; ++j) if ((i + 1) * (j + 1) <= 16) { const float s = S0[i] + S1[j]; const float key = asf((asu(s) & ~255u) | (unsigned)(i * 16 + j)); INS16(T, key); }
#pragma unroll
        for (int i = 0; i < 16; ++i) { myl[i] = (unsigned char)(asu(S0[i]) & 127u); myl[16 + i] = (unsigned char)(asu(S1[i]) & 127u); }
        LDS_WAIT();
        float gt[16]; float Z = 0.f; unsigned ee[16];
#pragma unroll
        for (int k = 0; k < 16; ++k) { gt[k] = __expf(T[k] - T[0]); Z += gt[k];
            const unsigned pos = asu(T[k]) & 255u; const unsigned n0 = myl[pos >> 4], n1 = myl[16 + (pos & 15u)]; ee[k] = n0 * 128u + n1; }
        const float rz = 1.0f / Z;
        LDS_WAIT();
        if (hi == 0) {
            GAS v4u* ep = (GAS v4u*)(EIDX + (size_t)tok * 128 + h * 16);
            v4u e0, e1; e0.x = ee[0] | (ee[1] << 16); e0.y = ee[2] | (ee[3] << 16); e0.z = ee[4] | (ee[5] << 16); e0.w = ee[6] | (ee[7] << 16);
            e1.x = ee[8] | (ee[9] << 16); e1.y = ee[10] | (ee[11] << 16); e1.z = ee[12] | (ee[13] << 16); e1.w = ee[14] | (ee[15] << 16);
            ep[0] = e0; ep[1] = e1;
            GAS f32x4* gp = (GAS f32x4*)(GATE + (size_t)tok * 128 + h * 16);
            gp[0] = (f32x4){gt[0] * rz, gt[1] * rz, gt[2] * rz, gt[3] * rz}; gp[1] = (f32x4){gt[4] * rz, gt[5] * rz, gt[6] * rz, gt[7] * rz};
            gp[2] = (f32x4){gt[8] * rz, gt[9] * rz, gt[10] * rz, gt[11] * rz}; gp[3] = (f32x4){gt[12] * rz, gt[13] * rz, gt[14] * rz, gt[15] * rz};
        }
    }
}

__device__ __forceinline__ float gelu1(float v) { const f32x2 r = pg8::gelu_pk((f32x2){v, v}); return r.x; }
#ifndef PEER_SSH
#define PEER_SSH 11
#endif
#define PEER_SMASK ((16384u >> PEER_SSH) - 1u)
constexpr int PEER_WLDS = 17424, PEER_N = 512;
constexpr int PEER_O_SU = 1024, PEER_O_GS = 3072, PEER_O_HQ = 5120, PEER_O_ACC = 9216;
static_assert(8 * PEER_WLDS <= PEER_LDS_LIMIT, "gather LDS map");
template <int VAR>
__device__ __forceinline__ void gather_phase(Frame& F, int l, const float* ngain, float* nout, const XcdBarrier& gbar, bool dry = false) {
    const int lane = mk_lane();
#ifdef PROBE_HOT
    const unsigned emask = dry ? 0xffu : 0x3fffu;
#else
    const unsigned emask = 0x3fffu;
#endif
    const unsigned char* U8 = F.ws + WS_UV + (size_t)l * 16384 * PEER_REC; const unsigned char* V8 = U8 + 512;
    const float* SU = (const float*)(F.ws + WS_SU) + (size_t)l * 16384; const float* SV = (const float*)(F.ws + WS_SV) + (size_t)l * 16384;
    const bf16* HB = (const bf16*)(F.ws + WS_HB); bf16* XRES = (bf16*)(F.ws + WS_XRES); const bf16* XS = (const bf16*)(F.ws + WS_XS); const float* SSQ = (const float*)(F.ws + WS_SSQ);
    const float* sh2 = (const float*)(F.ws + WS_MOD) + (size_t)l * 8 * 6144 + 3 * 1024;
    const unsigned short* EIDX = (const unsigned short*)(F.ws + WS_EIDX); const float* GATE = (const float*)(F.ws + WS_GATE);
    const float* g2 = (const float*)(F.ws + WS_MOD) + (size_t)l * 8 * 6144 + 5 * 1024;
    LAS unsigned char* wl = F.lds + F.wave * PEER_WLDS;
    LAS unsigned short* elist = (LAS unsigned short*)wl; LAS float* sul = (LAS float*)(wl + PEER_O_SU); LAS float* gsl = (LAS float*)(wl + PEER_O_GS);
    LAS unsigned char* hql = wl + PEER_O_HQ; LAS unsigned char* accl = wl + PEER_O_ACC; LAS unsigned* cnt = (LAS unsigned*)(wl + PEER_O_ACC);
#ifdef PEER_ROTX
    const unsigned srot = 2u * xb_xcc_id();
#else
    const unsigned srot = 0u;
#endif
    unsigned ev0[4], ev1[4]; float gt0[4], gt1[4]; v4u ha[4], hb[4]; float ssq1, su0[4], su1[4], sv0[4], sv1[4];
    auto BPRE2 = [&]() __attribute__((always_inline)) {
#pragma unroll
        for (int tk = 0; tk < 4; ++tk) { su0[tk] = SU[ev0[tk]]; su1[tk] = SU[ev1[tk]]; sv0[tk] = SV[ev0[tk]]; sv1[tk] = SV[ev1[tk]]; } };
    auto BPRE = [&](int t0) __attribute__((always_inline)) {
        ssq1 = SSQ[(size_t)(t0 + (lane >> 4)) * 16 + (lane & 15)];
#pragma unroll
        for (int tk = 0; tk < 4; ++tk) { const size_t tok = (size_t)(t0 + tk);
            ev0[tk] = EIDX[tok * 128 + lane]; ev1[tk] = EIDX[tok * 128 + 64 + lane]; gt0[tk] = GATE[tok * 128 + lane]; gt1[tk] = GATE[tok * 128 + 64 + lane];
            ha[tk] = *(const GAS v4u*)(XS + tok * 1024 + lane * 16); hb[tk] = *(const GAS v4u*)(XS + tok * 1024 + lane * 16 + 8); } };
    if (F.vcu < M / 32) { BPRE(F.vcu * 32 + F.wave * 4); BPRE2(); }
    for (int blk = F.vcu; blk < M / 32; blk += F.G) {
        const int tok0 = blk * 32 + F.wave * 4;
#pragma unroll
        for (int j = 0; j < 4; ++j) cnt[64 * j + lane] = 0u;
        float fa0[4], fa1[4], fb0[4], fb1[4]; int rk0[4], rk1[4];
        {
            f32x4 s4[4]; { const float* shp = sh2 + (size_t)(tok0 >> 12) * 6144 + lane * 16;
#pragma unroll
                for (int j = 0; j < 4; ++j) s4[j] = *(const GAS f32x4*)(shp + 4 * j); }
            float sqs = ssq1; sqs += lshfl(sqs, lane ^ 1); sqs += lshfl(sqs, lane ^ 2); sqs += lshfl(sqs, lane ^ 4); sqs += lshfl(sqs, lane ^ 8);
            float hv[4][16], am[4], sc[4];
#pragma unroll
            for (int tk = 0; tk < 4; ++tk) { const unsigned hw[8] = {ha[tk].x, ha[tk].y, ha[tk].z, ha[tk].w, hb[tk].x, hb[tk].y, hb[tk].z, hb[tk].w};
                const float sq = asf((unsigned)__builtin_amdgcn_readlane((int)asu(sqs), 16 * tk));
                const float rs2 = 1.0f / sqrtf(sq * (1.0f / 1024.0f) + RMS_EPS);
                float m = 0.f;
#pragma unroll
                for (int j = 0; j < 4; ++j) { hv[tk][4 * j] = bflo(hw[2 * j]) * rs2 + s4[j].x; hv[tk][4 * j + 1] = bfhi(hw[2 * j]) * rs2 + s4[j].y; hv[tk][4 * j + 2] = bflo(hw[2 * j + 1]) * rs2 + s4[j].z; hv[tk][4 * j + 3] = bfhi(hw[2 * j + 1]) * rs2 + s4[j].w; }
#pragma unroll
                for (int j = 0; j < 16; ++j) m = __builtin_fmaxf(m, __builtin_fabsf(hv[tk][j]));
                am[tk] = m; }
#pragma unroll
            for (int o = 1; o < 64; o <<= 1) {
#pragma unroll
                for (int tk = 0; tk < 4; ++tk) am[tk] = __builtin_fmaxf(am[tk], lshfl(am[tk], lane ^ o)); }
#pragma unroll
            for (int tk = 0; tk < 4; ++tk) { sc[tk] = am[tk] > 0.f ? am[tk] * (1.0f / 448.0f) : 1.0f; const float inv = 1.0f / sc[tk];
                int qd[4];
#pragma unroll
                for (int g = 0; g < 4; ++g) { int pk = 0; pk = __builtin_amdgcn_cvt_pk_fp8_f32(hv[tk][4 * g] * inv, hv[tk][4 * g + 1] * inv, pk, false); pk = __builtin_amdgcn_cvt_pk_fp8_f32(hv[tk][4 * g + 2] * inv, hv[tk][4 * g + 3] * inv, pk, true); qd[g] = pk; }
                *(LAS v4i*)(hql + tk * 1024 + lane * 16) = (v4i){qd[0], qd[1], qd[2], qd[3]}; }
#pragma unroll
            for (int tk = 0; tk < 4; ++tk) {
                fa0[tk] = su0[tk] * sc[tk]; fa1[tk] = su1[tk] * sc[tk]; fb0[tk] = gt0[tk] * sv0[tk]; fb1[tk] = gt1[tk] * sv1[tk];
                rk0[tk] = (int)__hip_atomic_fetch_add(cnt + ((((ev0[tk] >> PEER_SSH) + srot) & PEER_SMASK) * 4 + tk), 1u, __ATOMIC_RELAXED, __HIP_MEMORY_SCOPE_WORKGROUP);
                rk1[tk] = (int)__hip_atomic_fetch_add(cnt + ((((ev1[tk] >> PEER_SSH) + srot) & PEER_SMASK) * 4 + tk), 1u, __ATOMIC_RELAXED, __HIP_MEMORY_SCOPE_WORKGROUP); } }
        LDS_WAIT();
        { int inc[4], mine[4];
#pragma unroll
            for (int j = 0; j < 4; ++j) { inc[j] = (int)cnt[64 * j + lane]; mine[j] = inc[j]; }
#pragma unroll
            for (int o = 1; o < 64; o <<= 1) {
#pragma unroll
                for (int j = 0; j < 4; ++j) { const int t = lshfl(inc[j], lane - o); inc[j] += (lane >= o) ? t : 0; } }
            int base = 0; LDS_WAIT();
#pragma unroll
            for (int j = 0; j < 4; ++j) { cnt[64 * j + lane] = (unsigned)(base + inc[j] - mine[j]); base += __builtin_amdgcn_readlane(inc[j], 63); } }
        LDS_WAIT();
#pragma unroll
        for (int tk = 0; tk < 4; ++tk) { const int p0 = (int)cnt[(((ev0[tk] >> PEER_SSH) + srot) & PEER_SMASK) * 4 + tk] + rk0[tk], p1 = (int)cnt[(((ev1[tk] >> PEER_SSH) + srot) & PEER_SMASK) * 4 + tk] + rk1[tk];
            elist[p0] = (unsigned short)(ev0[tk] | ((unsigned)tk << 14)); elist[p1] = (unsigned short)(ev1[tk] | ((unsigned)tk << 14));
            sul[p0] = fa0[tk]; sul[p1] = fa1[tk]; gsl[p0] = fb0[tk]; gsl[p1] = fb1[tk]; }
        LDS_WAIT();
#pragma unroll
        for (int tk = 0; tk < 4; ++tk) { *(LAS v4u*)(accl + tk * 2048 + lane * 32) = (v4u){0u, 0u, 0u, 0u}; *(LAS v4u*)(accl + tk * 2048 + lane * 32 + 16) = (v4u){0u, 0u, 0u, 0u}; }
        LDS_WAIT();
        float acc[16]; float csum = 0.f; int cur = -1;
#pragma unroll
        for (int j = 0; j < 16; ++j) acc[j] = 0.f;
        v8i Af[8];
#pragma unroll
        for (int s = 0; s < 8; ++s) { const v4i lo = *(const LAS v4i*)(hql + (lane & 3) * 1024 + 128 * s + 16 * (lane >> 4)), hi4 = *(const LAS v4i*)(hql + (lane & 3) * 1024 + 128 * s + 64 + 16 * (lane >> 4));
            Af[s] = (v8i){lo.x, lo.y, lo.z, lo.w, hi4.x, hi4.y, hi4.z, hi4.w}; }
        LDS_WAIT();
#pragma unroll 1
        for (int b = 0; b < PEER_N / 16; ++b) {
            const unsigned EV = elist[16 * b + (lane & 15)];
            v4u RU[8]; v2u RV[16];
            { const unsigned char* up = U8 + (size_t)((EV & emask) * (unsigned)PEER_REC) + (unsigned)(lane >> 4) * 16u;
#pragma unroll
                for (int s = 0; s < 8; ++s) { if (VAR == 4) RU[s] = (v4u){EV, EV, EV, EV}; else RU[s] = *(const GAS v4u*)(up + 64 * s); } }
#pragma unroll
            for (int k = 0; k < 16; ++k) { const unsigned eb = ((unsigned)__builtin_amdgcn_readlane((int)EV, k) & emask) * (unsigned)PEER_REC; if (VAR == 4) RV[k] = (v2u){eb, eb}; else RV[k] = *(const GAS v2u*)(V8 + eb + (unsigned)lane * 8u); }
            asm volatile("" ::: "memory");
            f32x4 D = (f32x4){0.f, 0.f, 0.f, 0.f};
            if (VAR == 2) D = (f32x4){asf(RU[0].x), asf(RU[1].x), asf(RU[2].x), asf(RU[3].x)}; else {
#pragma unroll
                for (int s = 0; s < 8; ++s) D = __builtin_amdgcn_mfma_scale_f32_16x16x128_f8f6f4(Af[s], (v8i){(int)RU[s].x, (int)RU[s].y, (int)RU[s].z, (int)RU[s].w, 0, 0, 0, 0}, D, 0, 4, 0, 0, 0, 0); }
            const unsigned tkn = EV >> 14; const float z = tkn == 0u ? D[0] : tkn == 1u ? D[1] : tkn == 2u ? D[2] : D[3];
            const int pi = 16 * b + (lane & 15);
            const float wgt = gsl[pi] * gelu1(z * sul[pi]);
#pragma unroll
            for (int k = 0; k < 16; ++k) { const int tk = (int)((unsigned)__builtin_amdgcn_readlane((int)EV, k) >> 14);
                if (VAR != 1 && tk != cur) {
                    if (cur >= 0) { const float corr = 0.f; v4u o0, o1;
                        o0.x = pk2(acc[0] - corr, acc[1] - corr); o0.y = pk2(acc[2] - corr, acc[3] - corr); o0.z = pk2(acc[4] - corr, acc[5] - corr); o0.w = pk2(acc[6] - corr, acc[7] - corr);
                        o1.x = pk2(acc[8] - corr, acc[9] - corr); o1.y = pk2(acc[10] - corr, acc[11] - corr); o1.z = pk2(acc[12] - corr, acc[13] - corr); o1.w = pk2(acc[14] - corr, acc[15] - corr);
                        *(LAS v4u*)(accl + cur * 2048 + lane * 32) = o0; *(LAS v4u*)(accl + cur * 2048 + lane * 32 + 16) = o1; }
                    const v4u i0 = *(const LAS v4u*)(accl + tk * 2048 + lane * 32), i1 = *(const LAS v4u*)(accl + tk * 2048 + lane * 32 + 16);
                    acc[0] = bflo(i0.x); acc[1] = bfhi(i0.x); acc[2] = bflo(i0.y); acc[3] = bfhi(i0.y); acc[4] = bflo(i0.z); acc[5] = bfhi(i0.z); acc[6] = bflo(i0.w); acc[7] = bfhi(i0.w);
                    acc[8] = bflo(i1.x); acc[9] = bfhi(i1.x); acc[10] = bflo(i1.y); acc[11] = bfhi(i1.y); acc[12] = bflo(i1.z); acc[13] = bfhi(i1.z); acc[14] = bflo(i1.w); acc[15] = bfhi(i1.w);
                    csum = 0.f; cur = tk; }
                const float wk = asf((unsigned)__builtin_amdgcn_readlane((int)asu(wgt), k)); const unsigned rw[2] = {RV[k].x, RV[k].y};
                if (VAR == 3) { acc[k & 15] += wk * asf(rw[0] ^ rw[1]); continue; }
#pragma unroll
                for (int d = 0; d < 2; ++d) {
                    const f32x2 p0 = __builtin_amdgcn_cvt_scalef32_pk_f32_fp4(rw[d], 1.0f, 0), p1 = __builtin_amdgcn_cvt_scalef32_pk_f32_fp4(rw[d], 1.0f, 1),
                                p2 = __builtin_amdgcn_cvt_scalef32_pk_f32_fp4(rw[d], 1.0f, 2), p3 = __builtin_amdgcn_cvt_scalef32_pk_f32_fp4(rw[d], 1.0f, 3);
                    acc[8 * d] += wk * p0.x; acc[8 * d + 1] += wk * p0.y; acc[8 * d + 2] += wk * p1.x; acc[8 * d + 3] += wk * p1.y;
                    acc[8 * d + 4] += wk * p2.x; acc[8 * d + 5] += wk * p2.y; acc[8 * d + 6] += wk * p3.x; acc[8 * d + 7] += wk * p3.y; } }
#ifdef PEER_SYNC
            if ((b & (PEER_SYNC - 1)) == PEER_SYNC - 1) __builtin_amdgcn_s_barrier();
#endif
        }
        { const float corr = 0.f; v4u o0, o1;
            o0.x = pk2(acc[0] - corr, acc[1] - corr); o0.y = pk2(acc[2] - corr, acc[3] - corr); o0.z = pk2(acc[4] - corr, acc[5] - corr); o0.w = pk2(acc[6] - corr, acc[7] - corr);
            o1.x = pk2(acc[8] - corr, acc[9] - corr); o1.y = pk2(acc[10] - corr, acc[11] - corr); o1.z = pk2(acc[12] - corr, acc[13] - corr); o1.w = pk2(acc[14] - corr, acc[15] - corr);
            *(LAS v4u*)(accl + cur * 2048 + lane * 32) = o0; *(LAS v4u*)(accl + cur * 2048 + lane * 32 + 16) = o1; }
        LDS_WAIT();
        {
            const int bb = tok0 >> 12; const float* gp = g2 + (size_t)bb * 6144 + lane * 16;
            f32x4 xn[4][4], gq[4]; float s2[4], rstd[4];
#pragma unroll
            for (int tk = 0; tk < 4; ++tk)
#pragma unroll
                for (int q = 0; q < 2; ++q) { const v4u r = *(const GAS v4u*)(XRES + (size_t)(tok0 + tk) * 1024 + lane * 16 + q * 8);
                    xn[tk][2 * q] = (f32x4){bflo(r.x), bfhi(r.x), bflo(r.y), bfhi(r.y)}; xn[tk][2 * q + 1] = (f32x4){bflo(r.z), bfhi(r.z), bflo(r.w), bfhi(r.w)}; }
#pragma unroll
            for (int q = 0; q < 4; ++q) gq[q] = *(const GAS f32x4*)(gp + q * 4);
            if (blk + F.G < M / 32) BPRE((blk + F.G) * 32 + F.wave * 4);
#pragma unroll
            for (int tk = 0; tk < 4; ++tk) {
                const v4u i0 = *(const LAS v4u*)(accl + tk * 2048 + lane * 32), i1 = *(const LAS v4u*)(accl + tk * 2048 + lane * 32 + 16);
                const unsigned iw[8] = {i0.x, i0.y, i0.z, i0.w, i1.x, i1.y, i1.z, i1.w}; float s = 0.f;
#pragma unroll
                for (int q = 0; q < 4; ++q) { const f32x4 o = (f32x4){bflo(iw[2 * q]), bfhi(iw[2 * q]), bflo(iw[2 * q + 1]), bfhi(iw[2 * q + 1])};
                    const f32x4 t = xn[tk][q] + gq[q] * o; xn[tk][q] = t; s += (t.x * t.x + t.y * t.y) + (t.z * t.z + t.w * t.w); }
                s2[tk] = s; }
#pragma unroll
            for (int o = 1; o < 64; o <<= 1) {
#pragma unroll
                for (int tk = 0; tk < 4; ++tk) s2[tk] += lshfl(s2[tk], lane ^ o); }
#pragma unroll
            for (int tk = 0; tk < 4; ++tk) rstd[tk] = 1.0f / sqrtf(s2[tk] * (1.0f / 1024.0f) + RMS_EPS);
            if (dry) {
#pragma unroll
                for (int tk = 0; tk < 4; ++tk)
#pragma unroll
                    for (int q = 0; q < 4; ++q) *(GAS f32x4*)((float*)(F.ws + WS_PROJ) + (size_t)(tok0 + tk) * 1024 + lane * 16 + q * 4) = xn[tk][q] * rstd[tk];
            } else if (l == DEPTH - 1) {
#pragma unroll
                for (int q = 0; q < 4; ++q) { const f32x4 gn = *(const GAS f32x4*)(ngain + lane * 16 + q * 4);
#pragma unroll
                    for (int tk = 0; tk < 4; ++tk) *(GAS f32x4*)(nout + (size_t)(tok0 + tk) * 1024 + lane * 16 + q * 4) = xn[tk][q] * rstd[tk] * gn; }
            } else {
                const float* nsh = (const float*)(F.ws + WS_MOD) + (size_t)(l + 1) * 8 * 6144 + (size_t)bb * 6144 + lane * 16; const bool f8n = ((l + 1) & 1) ? (FP8_ODD != 0) : (FP8_EVEN != 0);
                f32x4 gm[4], sa[4];
#pragma unroll
                for (int q = 0; q < 4; ++q) { const f32x4 gn = *(const GAS f32x4*)(ngain + lane * 16 + q * 4), c = *(const GAS f32x4*)(nsh + 1024 + q * 4); sa[q] = *(const GAS f32x4*)(nsh + q * 4); gm[q] = gn * (c + 1.0f); }
#pragma unroll
                for (int tk = 0; tk < 4; ++tk) { bf16* xr = XRES + (size_t)(tok0 + tk) * 1024 + lane * 16; unsigned xw[8];
#pragma unroll
                    for (int q = 0; q < 4; ++q) { xw[2 * q] = pk2(xn[tk][q].x, xn[tk][q].y); xw[2 * q + 1] = pk2(xn[tk][q].z, xn[tk][q].w); }
                    *(GAS v4u*)xr = (v4u){xw[0], xw[1], xw[2], xw[3]}; *(GAS v4u*)(xr + 8) = (v4u){xw[4], xw[5], xw[6], xw[7]};
                    if (FP8_EVEN && FP8_ODD) { unsigned hw[4];
#pragma unroll
                        for (int q = 0; q < 4; ++q) { const f32x4 hh = xn[tk][q] * rstd[tk] * gm[q] + sa[q]; hw[q] = pk4_fp8x8(hh.x, hh.y, hh.z, hh.w); }
                        *(GAS v4u*)((unsigned char*)HB + (size_t)(tok0 + tk) * 1024 + lane * 16) = (v4u){hw[0], hw[1], hw[2], hw[3]};
                    } else { unsigned char* hp = (unsigned char*)HB + (size_t)(tok0 + tk) * (f8n ? 1024 : 2048) + lane * (f8n ? 16 : 32);
#pragma unroll
                        for (int hf = 0; hf < 2; ++hf) { unsigned hw[4];
#pragma unroll
                            for (int q = 0; q < 4; ++q) { const f32x4 hh = xn[tk][q] * rstd[tk] * gm[q] + sa[q]; hw[q] = pk4_fp8x8(hh.x, hh.y, hh.z, hh.w); }
                            if (!f8n) {
#pragma unroll
                                for (int q = 0; q < 2; ++q) { const f32x4 hh = xn[tk][2 * hf + q] * rstd[tk] * gm[2 * hf + q] + sa[2 * hf + q]; hw[2 * q] = pk2(hh.x, hh.y); hw[2 * q + 1] = pk2(hh.z, hh.w); } }
                            *(GAS v4u*)(hp + (f8n ? 0 : 16 * hf)) = (v4u){hw[0], hw[1], hw[2], hw[3]}; } } } } }
        if (blk + F.G < M / 32) BPRE2();
        LDS_WAIT();
#ifdef PEER_BLKSYNC
        if (blk + F.G < M / 32) xcd_barrier(gbar, F.wave * 64 + lane == 0);
#endif
    }
}
constexpr int N_PHASES = 38;
#ifndef MK_SINGLE
#define MK_SINGLE 1
#endif
__device__ __forceinline__ bool phase_empty(int p) { if (p < 1 || p > 36) return false; const int l = (p - 1) / 9, k = (p - 1) % 9; return (k == 3 && (l & 1) == 0) || (k == 0 && l > 0) || k == 5; }
__global__ void __launch_bounds__(NWAVES * 64, 2) mk_fwd(Args args) {
    extern __shared__ __attribute__((aligned(16))) unsigned char lds[];
    Frame F;
    F.lds = (LAS unsigned char*)lds;
    F.MISC = (volatile LAS unsigned*)(F.lds + MISC_OFF);
    int wave_s = __builtin_amdgcn_readfirstlane((int)(threadIdx.x >> 6));
    for (int u = MK_TID(wave_s); u < (LDS_BYTES - LDSCTL_OFF) / 4; u += NWAVES * 64) ((LAS unsigned*)(F.lds + LDSCTL_OFF))[u] = 0u;
    __syncthreads();
    const int lo = args.ph_lo, hi = args.ph_hi;
    XcdBarrier bar; bar.bar = (unsigned*)(args.ws + WS_CTL) + CW_BAR; bar.x = 0; bar.st = nullptr;
    if (hi - lo > 1) bar = xcd_barrier_post((unsigned*)(args.ws + WS_CTL) + CW_BAR, F.MISC + 8, MK_TID(wave_s) == 0);
    bool again = false;
    for (int p = lo; p < hi; ++p) {
        if (phase_empty(p) || p == 37) continue;
#ifdef PROBE_K
#ifndef PROBE_PARITY
#define PROBE_PARITY_OK(x) true
#else
#define PROBE_PARITY_OK(x) ((x) == PROBE_PARITY)
#endif
        const bool pmatch = (PROBE_K < 0) ? (p == 0) : (p >= 1 && p <= 36 && (p - 1) % 9 == PROBE_K && PROBE_PARITY_OK(((p - 1) / 9) & 1)); const bool dry = pmatch && !again;
#else
        const bool dry = false;
#endif
        KA A; A.kp = (kptr_t)__builtin_amdgcn_kernarg_segment_ptr(); asm volatile("" : "+s"(A.kp));
        { asm volatile("" : "+s"(wave_s)); F.wave = wave_s; F.lane = mk_lane(); F.tid = wave_s * 64 + F.lane;
          int G = gridDim.x, bx = blockIdx.x; asm volatile("" : "+s"(G), "+s"(bx)); F.G = G; F.bx = bx; F.vcu = (G % 8 == 0) ? (bx % 8) * (G / 8) + bx / 8 : bx; }
        unsigned char* ws = A.ws(); F.ws = ws; F.out = A.out(); F.ctl = (gu32*)(ws + WS_CTL);
        bf16* HB = (bf16*)(ws + WS_HB); bf16* MIX = (bf16*)(ws + WS_MIX); bf16* PROJ = (bf16*)(ws + WS_PROJ); bf16* XRES = (bf16*)(ws + WS_XRES);
        if (p == 0) {
#ifndef NO_P0
            p0_prologue(F, A);
#endif
        }
        else {
            const int l = (p - 1) / 9, k = (p - 1) % 9, e = l >> 1; const bool odd = l & 1;
            const float* mod = (const float*)(ws + WS_MOD) + (size_t)l * 8 * 6144;
            if (k == 0) {
#ifndef NO_NORM
                norm_phase(F, A.in(0), A.in(5) + l * 1024, mod, mod + 1024, HB);
                shw_items(F);
#endif
            }
            else if (k == 1) {
#if !defined(NO_GEMM) && !defined(NO_G1E)
                if (!odd) { pg8::Gemm g{HB, (const bf16*)(ws + WS_WINE + (size_t)e * 1536 * 1024 * (FP8_EVEN ? 1 : 2)), M, 1536, FP8_EVEN ? 512 : 1024, FP8_EVEN ? 512 : 1024}; pg8::StaticOrder S; S.init(M, 1536, F.G, F.bx);
                    pg8::EpiActTiles E{PROJ, 1536, 4}; pg8::gemm_phase<pg8::EpiActTiles, pg8::StaticOrder, true, true, FP8_EVEN != 0>(F.lds + RING_OFF, g, S, E, F.wave); }
#endif
#if !defined(NO_GEMM) && !defined(NO_G1O)
                if (odd) { pg8::Gemm g{HB, (const bf16*)(ws + WS_WINO + (size_t)e * 3072 * 1024 * (FP8_ODD ? 1 : 2)), M, 3072, FP8_ODD ? 512 : 1024, FP8_ODD ? 512 : 1024}; pg8::StaticOrder S; S.init(M, 3072, F.G, F.bx);
                    pg8::EpiRope E{PROJ, 3072, (const float*)(ws + WS_ROPE), attn_body::C2}; pg8::gemm_phase<pg8::EpiRope, pg8::StaticOrder, true, true, FP8_ODD != 0>(F.lds + RING_OFF, g, S, E, F.wave); }
#endif
            }
            else if (k == 2) {
                if (!odd) {
#ifndef NO_E2
                    e2_phase(F, A, e);
#endif
                }
                else {
#ifndef NO_ATTN
                    const attn_body::AttnTensors AT{(const attn_body::bf16*)PROJ, (const attn_body::bf16*)(PROJ + 1024), (const attn_body::bf16*)(PROJ + 2048), (attn_body::bf16*)HB};
#ifdef PROBE_AVAR
                    if (dry) attn_body::attn_phase<PROBE_AVAR>((char*)lds + RING_OFF, AT, F.vcu, F.G, F.wave); else
#endif
                    attn_body::attn_phase<0>((char*)lds + RING_OFF, AT, F.vcu, F.G, F.wave);
#endif
                }
            }
            else if (k == 3) {
#ifndef NO_COMB
                combine_phase(F, A, e, l == 1 ? 0.3555090675909693f : 0.5560582041556405f);
#endif
            }
            else if (k == 4) {
#if !defined(NO_GEMM) && !defined(NO_G2)
                pg8::Gemm g{odd ? HB : MIX, (const bf16*)(ws + (odd ? WS_WOUTO : WS_WOUTE)) + (size_t)e * 1024 * 1024, M, 1024, 1024, odd ? 2048 : 1024}; pg8::StaticOrder S; S.init(M, 1024, F.G, F.bx);
                if (l == 0) { pg8::EpiResid<true> E{A.in(0), dry ? PROJ : XRES, mod + 2048, 6144, A.in(6) + l * 1024, mod + 4096, (bf16*)(ws + WS_XS), (float*)(ws + WS_SSQ)}; pg8::gemm_phase<pg8::EpiResid<true>, pg8::StaticOrder, true, true>(F.lds + RING_OFF, g, S, E, F.wave); }
                else { pg8::EpiResid<false> E{XRES, dry ? PROJ : XRES, mod + 2048, 6144, A.in(6) + l * 1024, mod + 4096, (bf16*)(ws + WS_XS), (float*)(ws + WS_SSQ)}; pg8::gemm_phase<pg8::EpiResid<false>, pg8::StaticOrder, true, true>(F.lds + RING_OFF, g, S, E, F.wave); }
#endif
            }
            else if (k == 6) {
#if !defined(NO_GEMM) && !defined(NO_G3)
                pg8::Gemm g{(const bf16*)(ws + WS_XS), (const bf16*)(ws + WS_WQ) + (size_t)l * 2048 * 1024, M, 2048, 1024, 1024}; pg8::StaticOrder S; S.init(M, 2048, F.G, F.bx);
#ifdef PROBE_PLAIN3
                if (dry) { pg8::EpiBf16<0> E0{PROJ, 2048, nullptr, 0, 0, 1.f}; pg8::gemm_phase<pg8::EpiBf16<0>, pg8::StaticOrder, true, true>(F.lds + RING_OFF, g, S, E0, F.wave); } else
#endif
                {
                pg8::EpiScaleShift E{PROJ, 2048, (const float*)(ws + WS_SSQ), (const float*)(ws + WS_SHW) + (size_t)l * 8 * 2048, 2048, RMS_EPS}; pg8::gemm_phase<pg8::EpiScaleShift, pg8::StaticOrder, true, true>(F.lds + RING_OFF, g, S, E, F.wave);
                }
#endif
            }
            else if (k == 7) {
#ifndef NO_TOPK
                topk_phase(F, l);
#endif
            }
            else {
#ifndef NO_GATHER
#ifdef PROBE_VAR
                if (dry) gather_phase<PROBE_VAR>(F, l, l == DEPTH - 1 ? A.in(25) : A.in(5) + (l + 1) * 1024, F.out, bar, true); else gather_phase<0>(F, l, l == DEPTH - 1 ? A.in(25) : A.in(5) + (l + 1) * 1024, F.out, bar, false);
#else
                gather_phase<0>(F, l, l == DEPTH - 1 ? A.in(25) : A.in(5) + (l + 1) * 1024, F.out, bar, dry);
#endif
#endif
            }
        }
#ifdef PROBE_K
        if (pmatch && !again && PROBE_K != 3) { again = true; xcd_barrier(bar, MK_TID(wave_s) == 0); --p; continue; }
        again = false;
#endif
        if (p + 1 < hi && p < 36) xcd_barrier(bar, MK_TID(wave_s) == 0);
    }
}

extern "C" void kernel_launch(void* const* d_in, const int* in_sizes, int n_in, void* d_out, int out_size, void* d_ws, size_t ws_size, hipStream_t stream) {
    static int grid = 0;
    if (grid == 0) {
        if (n_in != 26 || out_size != M * DMODEL || ws_size < WS_END) { fprintf(stderr, "kernel_launch: unexpected problem (n_in %d, out %d, ws %zu; need ws >= %zu)\n", n_in, out_size, ws_size, (size_t)WS_END); grid = -1; return; }
        int dev = 0, cus = 0, per_cu = 0;
        if (hipGetDevice(&dev) != hipSuccess || hipDeviceGetAttribute(&cus, hipDeviceAttributeMultiprocessorCount, dev) != hipSuccess) { grid = -1; return; }
        if (hipFuncSetAttribute((const void*)mk_fwd, hipFuncAttributeMaxDynamicSharedMemorySize, LDS_BYTES) != hipSuccess) { fprintf(stderr, "kernel_launch: hipFuncSetAttribute failed\n"); grid = -1; return; }
        if (hipOccupancyMaxActiveBlocksPerMultiprocessor(&per_cu, (const void*)mk_fwd, NWAVES * 64, LDS_BYTES) != hipSuccess || per_cu < 1) { fprintf(stderr, "kernel_launch: occupancy query says %d blocks per CU\n", per_cu); }
        (void)hipGetLastError();
        grid = cus;
    }
    if (grid < 0) return;
    if (hipMemsetAsync((char*)d_ws + WS_CTL, 0, CTL_ZERO_BYTES, stream) != hipSuccess) return;
    Args a{};
    for (int i = 0; i < 26; ++i) a.in[i] = (const float*)d_in[i];
    a.out = (float*)d_out; a.ws = (unsigned char*)d_ws;
#if MK_SINGLE
    a.ph_lo = 0; a.ph_hi = N_PHASES;
    hipLaunchKernelGGL(mk_fwd, dim3(grid), dim3(NWAVES * 64), LDS_BYTES, stream, a);
#else
    for (int p = 0; p < N_PHASES; ++p) {
        if (p == 37 || (p >= 1 && p <= 36 && ((((p - 1) % 9) == 3 && ((((p - 1) / 9) & 1) == 0)) || (((p - 1) % 9) == 0 && p > 9) || ((p - 1) % 9) == 5))) continue;
        a.ph_lo = p; a.ph_hi = p + 1;
        hipLaunchKernelGGL(mk_fwd, dim3(grid), dim3(NWAVES * 64), LDS_BYTES, stream, a);
    }
#endif
}
```

```cpp
#include <hip/hip_runtime.h>
__device__ __forceinline__ int mk_lane() { int l = (int)__builtin_amdgcn_mbcnt_hi(~0u, __builtin_amdgcn_mbcnt_lo(~0u, 0u)); asm volatile("" : "+v"(l)); return l; }
#define MK_TID(wave_s) ((wave_s) * 64 + mk_lane())
template <class T> __device__ __forceinline__ T lshfl(T v, int src) { return __builtin_bit_cast(T, __builtin_amdgcn_ds_bpermute(src << 2, __builtin_bit_cast(int, v))); }
#include <hip/hip_runtime.h>
#include <cstdio>
#include <cstdint>
namespace pg8 {
#define PG8_LAS __attribute__((address_space(3)))
typedef unsigned short bf16_t;
typedef short bf16x8 __attribute__((ext_vector_type(8)));
typedef float f32x4 __attribute__((ext_vector_type(4)));
typedef unsigned u32x4 __attribute__((ext_vector_type(4)));
constexpr int BM = 256, BK = 64, HALF = 128, HTB = HALF * BK * 2  , STAGE_BYTES = 8 * HTB, NXCD = 8, WGM = 8;

__host__ __device__ __forceinline__ int lds_byte(int r, int c) { const int st = (r >> 4) * 2 + (c >> 5), rr = r & 15, cc = c & 31, ob = rr * 64 + cc * 2; return st * 1024 + (ob ^ (((ob >> 9) & 1) << 5)); }
__host__ __device__ __forceinline__ void stage_rc(int b, int& R, int& C) { const int st = b / 1024, sb = b % 1024, swz = sb ^ (((sb >> 9) & 1) << 5); R = (st >> 1) * 16 + swz / 64; C = (st & 1) * 32 + (swz % 64) / 2; }
__host__ __device__ __forceinline__ int perm32(int rho) { const int n = rho >> 4, i = rho & 15; return 8 * (i >> 2) + 4 * n + (i & 3); }

struct Unit { int pm, pn; };
typedef int pg8_v4i __attribute__((ext_vector_type(4)));
typedef int pg8_v8i __attribute__((ext_vector_type(8)));
constexpr int FP8_SCALE_A = 0x7c7c7c7c, FP8_SCALE_W = 0x77777777;
struct Gemm { const bf16_t* A; const bf16_t* Bt; int M, N, K, lda; };

struct StaticOrder {
    int nM, nN, nwg, G, c;
    __host__ __device__ void init(int M, int N, int G_, int c_) { nM = M / BM; nN = N / BM; nwg = nM * nN; G = G_; c = c_; }
    __host__ __device__ bool next(int i, Unit& u) const {
        const long L = (long)i * G + c; if (L >= nwg) return false;
        int wgid = (int)L; { const int q = nwg / NXCD, r = nwg % NXCD, xcd = wgid % NXCD, off = wgid / NXCD; wgid = (xcd < r ? xcd * (q + 1) : r * (q + 1) + (xcd - r) * q) + off; }
        const int nig = WGM * nN, gid = wgid / nig, fm = gid * WGM, gsz = (nM - fm) < WGM ? (nM - fm) : WGM;
        u.pm = fm + ((wgid % nig) % gsz); u.pn = (wgid % nig) / gsz; return true;
    }
    __device__ __forceinline__ void a_ready(const Unit&) const {}
    __device__ __forceinline__ void done(const Unit&) const {}
};

__device__ __forceinline__ unsigned cvt_pk_bf16(float lo, float hi) { unsigned r; asm volatile("v_cvt_pk_bf16_f32 %0, %1, %2" : "=v"(r) : "v"(lo), "v"(hi)); return r; }
typedef float f32x2 __attribute__((ext_vector_type(2)));
__device__ __forceinline__ f32x2 gelu_pk(f32x2 v) {
    const f32x2 av = __builtin_elementwise_abs(v), d = av * 0.2316418882f + 1.0f;
    f32x2 t; t.x = __builtin_amdgcn_rcpf(d.x); t.y = __builtin_amdgcn_rcpf(d.y);
    f32x2 q = t * 0.5307027145f + (-0.7265760135f); q = q * t + 0.7107068705f; q = q * t + (-0.142248368f); q = q * t + 0.127414796f; q = q * t;
    const f32x2 s = (v * v) * (-0.72134752044f);
    f32x2 e; e.x = __builtin_amdgcn_exp2f(s.x); e.y = __builtin_amdgcn_exp2f(s.y);
    const f32x2 m = v * (q * e), r = v - m;
    f32x2 o; o.x = v.x < 0.f ? m.x : r.x; o.y = v.y < 0.f ? m.y : r.y; return o;
}

template <int ACT  > struct EpiBf16 {
    static constexpr bool PERM = true, AFTER_DRAIN = false; static_assert(ACT == 0 || ACT == 1, "EpiBf16: ACT is 0 (none) or 1 (gelu_pk)");
    bf16_t* O; int ldc; const float* bias; int split_cols; size_t split_stride; float scale0;
    __device__ __forceinline__ void operator()(const f32x4 (&acc)[2][2][4][2], const Unit& u, int wr, int wc, int fr, int fq) const {
        const int row0 = u.pm * BM + wr * 64 + fr; int colt = u.pn * BM; bf16_t* base = O;
        float sc = 1.f; if (split_cols) { const int t = colt / split_cols; base += (size_t)t * split_stride; colt -= t * split_cols; if (t == 0) sc = scale0; }
        const int col0 = colt + wc * 32 + 8 * fq, bcol0 = u.pn * BM + wc * 32 + 8 * fq;
        f32x4 bv[2][2];
#pragma unroll
        for (int bj = 0; bj < 2; ++bj)
#pragma unroll
            for (int n = 0; n < 2; ++n) bv[bj][n] = bias ? *(const f32x4*)(bias + bcol0 + bj * HALF + 4 * n) : (f32x4){0.f, 0.f, 0.f, 0.f};
#pragma unroll
        for (int ai = 0; ai < 2; ++ai)
#pragma unroll
            for (int m = 0; m < 4; ++m) { bf16_t* rowp = base + (size_t)(row0 + ai * HALF + m * 16) * ldc + col0;
#pragma unroll
                for (int bj = 0; bj < 2; ++bj) { f32x4 v0 = acc[ai][bj][m][0] + bv[bj][0], v1 = acc[ai][bj][m][1] + bv[bj][1];
                    if (ACT == 1) { f32x2 a = gelu_pk((f32x2){v0[0], v0[1]}), b = gelu_pk((f32x2){v0[2], v0[3]}), c = gelu_pk((f32x2){v1[0], v1[1]}), d = gelu_pk((f32x2){v1[2], v1[3]});
                        v0 = (f32x4){a.x, a.y, b.x, b.y}; v1 = (f32x4){c.x, c.y, d.x, d.y}; }
                    v0 = v0 * sc; v1 = v1 * sc; u32x4 w; w.x = cvt_pk_bf16(v0[0], v0[1]); w.y = cvt_pk_bf16(v0[2], v0[3]); w.z = cvt_pk_bf16(v1[0], v1[1]); w.w = cvt_pk_bf16(v1[2], v1[3]);
                    *(u32x4*)(rowp + bj * HALF) = w; } }
    }
};

struct EpiActTiles {
    static constexpr bool PERM = true, AFTER_DRAIN = false;
    bf16_t* O; int ldc; int gelu_tiles;
    __device__ __forceinline__ void operator()(const f32x4 (&acc)[2][2][4][2], const Unit& u, int wr, int wc, int fr, int fq) const {
        const int row0 = u.pm * BM + wr * 64 + fr; const int col0 = u.pn * BM + wc * 32 + 8 * fq; const bool act = u.pn < gelu_tiles;
#pragma unroll
        for (int ai = 0; ai < 2; ++ai)
#pragma unroll
            for (int m = 0; m < 4; ++m) { bf16_t* rowp = O + (size_t)(row0 + ai * HALF + m * 16) * ldc + col0;
#pragma unroll
                for (int bj = 0; bj < 2; ++bj) { f32x4 v0 = acc[ai][bj][m][0], v1 = acc[ai][bj][m][1];
                    if (act) { f32x2 a = gelu_pk((f32x2){v0[0], v0[1]}), b = gelu_pk((f32x2){v0[2], v0[3]}), c = gelu_pk((f32x2){v1[0], v1[1]}), d = gelu_pk((f32x2){v1[2], v1[3]});
                        v0 = (f32x4){a.x, a.y, b.x, b.y}; v1 = (f32x4){c.x, c.y, d.x, d.y}; }
                    u32x4 w; w.x = cvt_pk_bf16(v0[0], v0[1]); w.y = cvt_pk_bf16(v0[2], v0[3]); w.z = cvt_pk_bf16(v1[0], v1[1]); w.w = cvt_pk_bf16(v1[2], v1[3]);
                    *(u32x4*)(rowp + bj * HALF) = w; } }
    }
};
struct EpiRope {
    static constexpr bool PERM = true, AFTER_DRAIN = false;
    bf16_t* O; int ldc; const float* rope; float qscale;
    __device__ __forceinline__ void operator()(const f32x4 (&acc)[2][2][4][2], const Unit& u, int wr, int wc, int fr, int fq) const {
        const int row0 = u.pm * BM + wr * 64 + fr; const int col0 = u.pn * BM + wc * 32 + 8 * fq; const int kind = u.pn >> 2;
        const int i0 = 16 * (wc & 1) + 4 * fq;
#pragma unroll
        for (int ai = 0; ai < 2; ++ai)
#pragma unroll
            for (int m = 0; m < 4; ++m) { const int row = row0 + ai * HALF + m * 16; bf16_t* rowp = O + (size_t)row * ldc + col0;
                f32x4 cs0 = (f32x4){1.f, 0.f, 1.f, 0.f}, cs1 = cs0;
                if (kind < 2) { const float* rp = rope + ((size_t)row * 32 + i0) * 2; cs0 = *(const f32x4*)rp; cs1 = *(const f32x4*)(rp + 4); }
#pragma unroll
                for (int bj = 0; bj < 2; ++bj) { f32x4 v0 = acc[ai][bj][m][0], v1 = acc[ai][bj][m][1];
                    if (kind < 2) {
                        f32x4 r0, r1;
                        r0[0] = v0[0] * cs0[0] - v0[1] * cs0[1]; r0[1] = v0[1] * cs0[0] + v0[0] * cs0[1]; r0[2] = v0[2] * cs0[2] - v0[3] * cs0[3]; r0[3] = v0[3] * cs0[2] + v0[2] * cs0[3];
                        r1[0] = v1[0] * cs1[0] - v1[1] * cs1[1]; r1[1] = v1[1] * cs1[0] + v1[0] * cs1[1]; r1[2] = v1[2] * cs1[2] - v1[3] * cs1[3]; r1[3] = v1[3] * cs1[2] + v1[2] * cs1[3];
                        v0 = r0; v1 = r1;
                        if (kind == 0) { v0 = v0 * qscale; v1 = v1 * qscale; } }
                    u32x4 w; w.x = cvt_pk_bf16(v0[0], v0[1]); w.y = cvt_pk_bf16(v0[2], v0[3]); w.z = cvt_pk_bf16(v1[0], v1[1]); w.w = cvt_pk_bf16(v1[2], v1[3]);
                    *(u32x4*)(rowp + bj * HALF) = w; } }
    }
};
template <bool BASE_F32>
struct EpiResid {
    static constexpr bool PERM = false, AFTER_DRAIN = false;
    const void* base; bf16_t* out; const float* gate; int gpitch; const float* gain2; const float* sc2; bf16_t* xs; float* ssq;
    typedef unsigned u32x2v __attribute__((ext_vector_type(2)));
    __device__ __forceinline__ f32x4 ldbase(size_t off) const {
        if constexpr (BASE_F32) return *(const f32x4*)((const float*)base + off);
        else { const u32x2v r = *(const u32x2v*)((const bf16_t*)base + off); return (f32x4){__builtin_bit_cast(float, r.x << 16), __builtin_bit_cast(float, r.x & 0xffff0000u), __builtin_bit_cast(float, r.y << 16), __builtin_bit_cast(float, r.y & 0xffff0000u)}; } }
    __device__ __forceinline__ void operator()(const f32x4 (&acc)[2][2][4][2], const Unit& u, int wr, int wc, int fr, int fq) const {
        const int row0 = u.pm * BM + wr * 64 + fr; const int col0 = u.pn * BM + wc * 32 + 4 * fq; const int b = (u.pm * BM) >> 12;
        f32x4 gv[2][2], gs[2][2];
#pragma unroll
        for (int bj = 0; bj < 2; ++bj)
#pragma unroll
            for (int n = 0; n < 2; ++n) { gv[bj][n] = *(const f32x4*)(gate + (size_t)b * gpitch + col0 + bj * HALF + n * 16);
                gs[bj][n] = *(const f32x4*)(gain2 + col0 + bj * HALF + n * 16) * (*(const f32x4*)(sc2 + (size_t)b * gpitch + col0 + bj * HALF + n * 16) + 1.0f); }
        f32x4 xb[2][2][2];
#pragma unroll
        for (int bj = 0; bj < 2; ++bj)
#pragma unroll
            for (int n = 0; n < 2; ++n) xb[0][bj][n] = ldbase((size_t)row0 * 1024 + col0 + bj * HALF + n * 16);
#pragma unroll
        for (int rg = 0; rg < 8; ++rg) { const int ai = rg >> 2, m = rg & 3; const int row = row0 + ai * HALF + m * 16; const size_t off = (size_t)row * 1024 + col0; float s2 = 0.f;
            if (rg + 1 < 8) { const int ai2 = (rg + 1) >> 2, m2 = (rg + 1) & 3; const size_t off2 = (size_t)(row0 + ai2 * HALF + m2 * 16) * 1024 + col0;
#pragma unroll
                for (int bj = 0; bj < 2; ++bj)
#pragma unroll
                    for (int n = 0; n < 2; ++n) xb[(rg + 1) & 1][bj][n] = ldbase(off2 + bj * HALF + n * 16); }
#pragma unroll
            for (int bj = 0; bj < 2; ++bj)
#pragma unroll
                for (int n = 0; n < 2; ++n) { const f32x4 x = xb[rg & 1][bj][n];
                    const f32x4 o = x + gv[bj][n] * acc[ai][bj][m][n];
                    s2 += (o[0] * o[0] + o[1] * o[1]) + (o[2] * o[2] + o[3] * o[3]);
                    const f32x4 t = o * gs[bj][n]; u32x2v w; w.x = cvt_pk_bf16(t[0], t[1]); w.y = cvt_pk_bf16(t[2], t[3]);
                    *(u32x2v*)(xs + off + bj * HALF + n * 16) = w; }
            { const int ln = fr + 16 * fq; s2 += lshfl(s2, ln ^ 16); s2 += lshfl(s2, ln ^ 32); }
            if (fq == 0) ssq[(size_t)row * 16 + u.pn * 4 + wc] = s2; }
    }
};
struct EpiScaleShift {
    static constexpr bool PERM = true, AFTER_DRAIN = false;
    bf16_t* O; int ldc; const float* ssq; const float* shift; int spitch; float eps;
    __device__ __forceinline__ void operator()(const f32x4 (&acc)[2][2][4][2], const Unit& u, int wr, int wc, int fr, int fq) const {
        const int row0 = u.pm * BM + wr * 64 + fr; const int col0 = u.pn * BM + wc * 32 + 8 * fq; const int b = (u.pm * BM) >> 12;
        f32x4 sv[2][2];
#pragma unroll
        for (int bj = 0; bj < 2; ++bj)
#pragma unroll
            for (int n = 0; n < 2; ++n) sv[bj][n] = *(const f32x4*)(shift + (size_t)b * spitch + col0 + bj * HALF + 4 * n);
#pragma unroll
        for (int ai = 0; ai < 2; ++ai)
#pragma unroll
            for (int m = 0; m < 4; ++m) { const int row = row0 + ai * HALF + m * 16; bf16_t* rowp = O + (size_t)row * ldc + col0;
                float sq; { const f32x4 a = *(const f32x4*)(ssq + (size_t)row * 16), b2 = *(const f32x4*)(ssq + (size_t)row * 16 + 4), c = *(const f32x4*)(ssq + (size_t)row * 16 + 8), d = *(const f32x4*)(ssq + (size_t)row * 16 + 12);
                    sq = (((a[0] + a[1]) + (a[2] + a[3])) + ((b2[0] + b2[1]) + (b2[2] + b2[3]))) + (((c[0] + c[1]) + (c[2] + c[3])) + ((d[0] + d[1]) + (d[2] + d[3]))); }
                const float rstd = 1.0f / sqrtf(sq * (1.0f / 1024.0f) + eps);
#pragma unroll
                for (int bj = 0; bj < 2; ++bj) { const f32x4 v0 = acc[ai][bj][m][0] * rstd + sv[bj][0], v1 = acc[ai][bj][m][1] * rstd + sv[bj][1];
                    u32x4 w; w.x = cvt_pk_bf16(v0[0], v0[1]); w.y = cvt_pk_bf16(v0[2], v0[3]); w.z = cvt_pk_bf16(v1[0], v1[1]); w.w = cvt_pk_bf16(v1[2], v1[3]);
                    *(u32x4*)(rowp + bj * HALF) = w; } }
    }
};

template <class Epi, class Sched, bool ALIGN_EPI = false, bool SP2 = false, bool FP8 = false>
__device__ __forceinline__ void gemm_phase(PG8_LAS unsigned char* lds, const Gemm g, const Sched& S, const Epi& E, int wave_s) {
    const int wid = wave_s, lane = mk_lane(), tid = wid * 64 + lane;
    const int wr = wid >> 2, wc = wid & 3, fr = lane & 15, fq = lane >> 4;
    const int K = g.K, nt = K / BK;
    unsigned voffA[2], voffB[2];
#pragma unroll
    for (int i = 0; i < 2; ++i) { int R, C; stage_rc(tid * 16 + i * 8192, R, C); const int Rb = Epi::PERM ? ((R & ~31) + perm32(R & 31)) : R;
        voffA[i] = (unsigned)(R * g.lda + C) * 2u; voffB[i] = (unsigned)(Rb * K + C) * 2u; }
    const size_t kstep = (size_t)(BK * 2);
    const size_t hstep = (size_t)HALF * K * 2;
    const size_t tstep = 2 * hstep;
    const size_t hstepA = (size_t)HALF * g.lda * 2, tstepA = 2 * hstepA;
    const unsigned ldsw = (unsigned)wid * 1024u;
    const int aoff = lds_byte(wr * 64 + fr, fq * 8), boff = lds_byte(wc * 32 + fr, fq * 8);
#define PG8_SA(b, h) (((b) * 2 + (h)) * HTB)
#define PG8_SB(b, h) ((4 + (b) * 2 + (h)) * HTB)
#define PG8_STAGE(bufoff, gbase, voff) do { _Pragma("unroll") for (int _i = 0; _i < 2; ++_i) \
        __builtin_amdgcn_global_load_lds((const unsigned*)((const char*)(gbase) + (voff)[_i]), (PG8_LAS unsigned*)(lds + (bufoff) + ldsw + _i * 8192), 16, 0, 0); } while (0)
#define PG8_LDA(dst, b, h) do { _Pragma("unroll") for (int m = 0; m < 4; ++m) { if constexpr (FP8) dst##8[m] = PG8_CAT8(*(const PG8_LAS bf16x8*)(lds + PG8_SA(b, h) + aoff + m * 2048), *(const PG8_LAS bf16x8*)(lds + PG8_SA(b, h) + aoff + m * 2048 + 1024)); \
        else { _Pragma("unroll") for (int k = 0; k < 2; ++k) dst[m][k] = *(const PG8_LAS bf16x8*)(lds + PG8_SA(b, h) + aoff + m * 2048 + k * 1024); } } } while (0)
#define PG8_LDB(dst, b, h) do { _Pragma("unroll") for (int n = 0; n < 2; ++n) { if constexpr (FP8) dst##8[n] = PG8_CAT8(*(const PG8_LAS bf16x8*)(lds + PG8_SB(b, h) + boff + n * 2048), *(const PG8_LAS bf16x8*)(lds + PG8_SB(b, h) + boff + n * 2048 + 1024)); \
        else { _Pragma("unroll") for (int k = 0; k < 2; ++k) dst[n][k] = *(const PG8_LAS bf16x8*)(lds + PG8_SB(b, h) + boff + n * 2048 + k * 1024); } } } while (0)
#define PG8_CAT8(x, y) __builtin_shufflevector(__builtin_bit_cast(pg8_v4i, x), __builtin_bit_cast(pg8_v4i, y), 0, 1, 2, 3, 4, 5, 6, 7)
#define PG8_MMA(ai, bj, At, Bt) do { __builtin_amdgcn_s_setprio(1); _Pragma("unroll") for (int m = 0; m < 4; ++m) _Pragma("unroll") for (int n = 0; n < 2; ++n) { \
        if constexpr (FP8) { acc[ai][bj][m][n] = __builtin_amdgcn_mfma_scale_f32_16x16x128_f8f6f4(Bt##8[n], At##8[m], acc[ai][bj][m][n], 0, 0, 0, FP8_SCALE_W, 0, FP8_SCALE_A); asm volatile("" : "+v"(acc[ai][bj][m][n])); }   \
        else { _Pragma("unroll") for (int k = 0; k < 2; ++k) acc[ai][bj][m][n] = __builtin_amdgcn_mfma_f32_16x16x32_bf16(Bt[n][k], At[m][k], acc[ai][bj][m][n], 0, 0, 0); } } __builtin_amdgcn_s_setprio(0); } while (0)
#define PG8_WAIT_V(n) asm volatile("s_waitcnt vmcnt(" #n ")" ::: "memory")
#define PG8_WAIT_L(n) asm volatile("s_waitcnt lgkmcnt(" #n ")" ::: "memory")
#define PG8_BAR __builtin_amdgcn_s_barrier()
#define PG8_SCHED __builtin_amdgcn_sched_barrier(0)
    Unit cur, nxt; int ui = 0;
    if (!S.next(0, cur)) return;
    f32x4 acc[2][2][4][2];
#pragma unroll
    for (int a = 0; a < 2; ++a)
#pragma unroll
        for (int b = 0; b < 2; ++b)
#pragma unroll
            for (int m = 0; m < 4; ++m)
#pragma unroll
                for (int n = 0; n < 2; ++n) acc[a][b][m][n] = (f32x4){0.f, 0.f, 0.f, 0.f};
    bf16x8 At[4][2], B0[2][2], B1[2][2]; pg8_v8i At8[4], B08[2], B18[2];
    const char* cA = (const char*)g.A + (size_t)cur.pm * tstepA; const char* cB = (const char*)g.Bt + (size_t)cur.pn * tstep;
    S.a_ready(cur);
    if constexpr (SP2) {
        PG8_STAGE(PG8_SB(0, 0), cB, voffB); PG8_STAGE(PG8_SB(0, 1), cB + hstep, voffB); PG8_STAGE(PG8_SA(0, 0), cA, voffA); PG8_STAGE(PG8_SA(0, 1), cA + hstepA, voffA);
        if (wr == 1) PG8_BAR;
        PG8_WAIT_V(2); PG8_BAR;
        PG8_STAGE(PG8_SB(1, 0), cB + kstep, voffB); PG8_STAGE(PG8_SA(1, 0), cA + kstep, voffA); PG8_STAGE(PG8_SB(1, 1), cB + hstep + kstep, voffB);
        PG8_WAIT_V(6); PG8_BAR;
    } else {
        PG8_STAGE(PG8_SB(0, 0), cB, voffB); PG8_STAGE(PG8_SA(0, 0), cA, voffA); PG8_STAGE(PG8_SB(0, 1), cB + hstep, voffB); PG8_STAGE(PG8_SA(0, 1), cA + hstepA, voffA);
        if (wr == 1) PG8_BAR;
        PG8_WAIT_V(4); PG8_BAR;
        PG8_STAGE(PG8_SB(1, 0), cB + kstep, voffB); PG8_STAGE(PG8_SA(1, 0), cA + kstep, voffA); PG8_STAGE(PG8_SB(1, 1), cB + hstep + kstep, voffB);
        PG8_WAIT_V(6); PG8_BAR;
    }
    for (;;) {
        const bool has_next = S.next(ui + 1, nxt);
        const char* nA = has_next ? (const char*)g.A + (size_t)nxt.pm * tstepA : cA; const char* nB = has_next ? (const char*)g.Bt + (size_t)nxt.pn * tstep : cB;
        for (int t = 0; t < nt; t += 2) {
            const bool last = (t == nt - 2);
            const char* a1 = cA + (size_t)(t + 1) * kstep;
            const char* a2 = last ? nA : cA + (size_t)(t + 2) * kstep; const char* b2 = last ? nB : cB + (size_t)(t + 2) * kstep;
            const char* a3 = a2 + kstep; const char* b3 = b2 + kstep;
            if (last && has_next) S.a_ready(nxt);
            if constexpr (SP2) {
            PG8_LDB(B0, 0, 0); PG8_LDB(B1, 0, 1); PG8_SCHED; PG8_LDA(At, 0, 0); PG8_STAGE(PG8_SA(1, 1), a1 + hstepA, voffA);
            PG8_WAIT_V(8); PG8_WAIT_L(0); PG8_BAR; PG8_MMA(0, 0, At, B0); PG8_MMA(0, 1, At, B1); PG8_BAR; PG8_SCHED;
            PG8_LDA(At, 0, 1); PG8_STAGE(PG8_SB(0, 0), b2, voffB); PG8_STAGE(PG8_SB(0, 1), b2 + hstep, voffB); PG8_STAGE(PG8_SA(0, 0), a2, voffA);
            PG8_WAIT_V(8); PG8_WAIT_L(0); PG8_BAR; PG8_MMA(1, 0, At, B0); PG8_MMA(1, 1, At, B1); PG8_BAR; PG8_SCHED;
            PG8_LDB(B0, 1, 0); PG8_LDB(B1, 1, 1); PG8_SCHED; PG8_LDA(At, 1, 0); PG8_STAGE(PG8_SA(0, 1), a2 + hstepA, voffA);
            PG8_WAIT_V(8); PG8_WAIT_L(0); PG8_BAR; PG8_MMA(0, 0, At, B0); PG8_MMA(0, 1, At, B1); PG8_BAR; PG8_SCHED;
            PG8_LDA(At, 1, 1); PG8_STAGE(PG8_SB(1, 0), b3, voffB); PG8_STAGE(PG8_SB(1, 1), b3 + hstep, voffB); PG8_STAGE(PG8_SA(1, 0), a3, voffA);
            PG8_WAIT_V(8); PG8_WAIT_L(0); PG8_BAR; PG8_MMA(1, 0, At, B0); PG8_MMA(1, 1, At, B1); PG8_BAR; PG8_SCHED;
            } else {
            PG8_LDB(B0, 0, 0); PG8_SCHED; PG8_LDA(At, 0, 0); PG8_STAGE(PG8_SA(1, 1), a1 + hstepA, voffA);
            PG8_WAIT_L(8); PG8_BAR; PG8_WAIT_L(0); PG8_MMA(0, 0, At, B0); PG8_BAR; PG8_SCHED;
            PG8_LDB(B1, 0, 1); PG8_STAGE(PG8_SB(0, 0), b2, voffB);
            PG8_BAR; PG8_WAIT_L(0); PG8_MMA(0, 1, At, B1); PG8_BAR;
            PG8_LDA(At, 0, 1); PG8_STAGE(PG8_SA(0, 0), a2, voffA);
            PG8_BAR; PG8_WAIT_L(0); PG8_MMA(1, 0, At, B0); PG8_BAR; PG8_SCHED;
            PG8_STAGE(PG8_SB(0, 1), b2 + hstep, voffB);
            PG8_WAIT_V(6); PG8_BAR; PG8_MMA(1, 1, At, B1); PG8_BAR;
            PG8_LDB(B0, 1, 0); PG8_SCHED; PG8_LDA(At, 1, 0); PG8_STAGE(PG8_SA(0, 1), a2 + hstepA, voffA);
            PG8_WAIT_L(8); PG8_BAR; PG8_WAIT_L(0); PG8_MMA(0, 0, At, B0); PG8_BAR; PG8_SCHED;
            PG8_LDB(B1, 1, 1); PG8_STAGE(PG8_SB(1, 0), b3, voffB);
            PG8_BAR; PG8_WAIT_L(0); PG8_MMA(0, 1, At, B1); PG8_BAR;
            PG8_LDA(At, 1, 1); PG8_STAGE(PG8_SA(1, 0), a3, voffA);
            PG8_BAR; PG8_WAIT_L(0); PG8_MMA(1, 0, At, B0); PG8_BAR; PG8_SCHED;
            PG8_STAGE(PG8_SB(1, 1), b3 + hstep, voffB);
            PG8_WAIT_V(6); PG8_BAR; PG8_MMA(1, 1, At, B1); PG8_BAR;
            }
        }
        if constexpr (ALIGN_EPI) { if (wr == 0) PG8_BAR; }
        if constexpr (!Epi::AFTER_DRAIN) { E(acc, cur, wr, wc, fr, fq); S.done(cur); }
        if (!has_next) break;
#pragma unroll
        for (int a = 0; a < 2; ++a)
#pragma unroll
            for (int b = 0; b < 2; ++b)
#pragma unroll
                for (int m = 0; m < 4; ++m)
#pragma unroll
                    for (int n = 0; n < 2; ++n) acc[a][b][m][n] = (f32x4){0.f, 0.f, 0.f, 0.f};
        cur = nxt; cA = nA; cB = nB; ++ui;
        if constexpr (ALIGN_EPI) { if (wr == 1) PG8_BAR; }
    }
    PG8_WAIT_V(0);
    if constexpr (!ALIGN_EPI) { if (wr == 0) PG8_BAR; }
    PG8_BAR;
    if constexpr (Epi::AFTER_DRAIN) { E.fused(acc, cur, wr, wc, fr, fq, lds, wid, lane); S.done(cur); }
#undef PG8_SA
#undef PG8_SB
#undef PG8_STAGE
#undef PG8_LDA
#undef PG8_LDB
#undef PG8_MMA
#undef PG8_CAT8
#undef PG8_WAIT_V
#undef PG8_WAIT_L
#undef PG8_BAR
#undef PG8_SCHED
}
}
#include <hip/hip_bf16.h>
#include <cmath>
namespace attn_body {
using bf16=__hip_bfloat16;
using bf16x8=__attribute__((ext_vector_type(8)))short;
using s16x4=__attribute__((ext_vector_type(4)))short;
using f32x16=__attribute__((ext_vector_type(16)))float;
using u32x4=__attribute__((ext_vector_type(4)))unsigned;
constexpr int BATCH=8,NHEAD=16,SEQ=4096,D=64,PQ=3072,OP=2048;
constexpr int NW=8,QBLK=32,QB=QBLK*NW,KVBLK=64,NQB=SEQ/QB;
constexpr int ATTN_UNIT_ROWS=QB;
__device__ __forceinline__ int crow(int r,int hi){return (r&3)+8*(r>>2)+4*hi;}
#define SBAR() __builtin_amdgcn_sched_barrier(0)
__device__ __forceinline__ void cmask(f32x16&p0,f32x16&p1,int jb,int qrel,int hi){
  const float NEG=-INFINITY; int kb=64*jb+4*hi;
  #pragma unroll
  for(int r=0;r<16;++r){int kv=kb+(r&3)+8*(r>>2); if(kv>qrel)p0[r]=NEG; if(kv+32>qrel)p1[r]=NEG;}
}

constexpr int NSLOT=3, SLOTB=8192, VSLOTB=16384;
constexpr int LDS_K=0, LDS_V=NSLOT*SLOTB, LDS_WS=LDS_V+NSLOT*VSLOTB, LDS_Q=LDS_WS+NW*64*4, LDS_OST=LDS_Q+NW*4096, LDS_BYTES=LDS_OST+NW*4096;
constexpr float C2=0.125f*1.4426950408889634f;
__device__ __forceinline__ void glds16(const void*sbase,unsigned voff,unsigned lds_dst){unsigned keep;
  asm volatile("s_mov_b32 %0, m0\n\ts_mov_b32 m0, %3\n\ts_nop 4\n\tglobal_load_lds_dwordx4 %1, %2\n\ts_mov_b32 m0, %0":"=&s"(keep):"v"(voff),"s"(sbase),"s"(lds_dst):"memory");}
__device__ __forceinline__ float max3f(float a,float b,float c){float r;asm("v_max3_f32 %0, %1, %2, %3":"=v"(r):"v"(a),"v"(b),"v"(c));return r;}
__device__ __forceinline__ float max2f(float a,float b){float r;asm("v_max_f32_e32 %0, %1, %2":"=v"(r):"v"(a),"v"(b));return r;}
__device__ __forceinline__ float fadd_s(float a,float b){float r;asm("v_add_f32_e32 %0, %1, %2":"=v"(r):"v"(a),"v"(b));return r;}
__device__ __forceinline__ float fsub_s(float a,float b){float r;asm("v_sub_f32_e32 %0, %1, %2":"=v"(r):"v"(a),"v"(b));return r;}
typedef float f32x2_t __attribute__((ext_vector_type(2))); typedef __bf16 bf16x2_t __attribute__((ext_vector_type(2)));
__device__ __forceinline__ unsigned cvtpk_s(float lo,float hi){f32x2_t v={lo,hi};bf16x2_t b=__builtin_convertvector(v,bf16x2_t);return __builtin_bit_cast(unsigned,b);}
#define WAIT_BAR(N) asm volatile("s_waitcnt vmcnt(" #N ") lgkmcnt(0)\n\ts_barrier":::"memory")

typedef __attribute__((address_space(3))) const char* lds_cptr0;
__device__ __forceinline__ void qkt(f32x16&p0,f32x16&p1,const char*Kslot,lds_cptr0 qs,const f32x16&negm,int r32,int hi){
  const char*kb=Kslot+hi*1024+r32*16;
  #pragma unroll
  for(int d0=0;d0<4;++d0){
    const bf16x8 b0=*reinterpret_cast<const bf16x8*>(kb+d0*2048);
    const bf16x8 b1=*reinterpret_cast<const bf16x8*>(kb+d0*2048+512);
    const bf16x8 qd=*(const __attribute__((address_space(3))) bf16x8*)(qs+d0*1024);
    if(d0==0){p0=__builtin_amdgcn_mfma_f32_32x32x16_bf16(b0,qd,negm,0,0,0);p1=__builtin_amdgcn_mfma_f32_32x32x16_bf16(b1,qd,negm,0,0,0);}
    else{p0=__builtin_amdgcn_mfma_f32_32x32x16_bf16(b0,qd,p0,0,0,0);p1=__builtin_amdgcn_mfma_f32_32x32x16_bf16(b1,qd,p1,0,0,0);}}
}
typedef __attribute__((address_space(3))) const char* lds_cptr;
typedef short v4i16_t __attribute__((ext_vector_type(4)));
__device__ __forceinline__ void kload8(bf16x8*kf,lds_cptr kp){
  kf[0]=*(const __attribute__((address_space(3))) bf16x8*)(kp);      kf[1]=*(const __attribute__((address_space(3))) bf16x8*)(kp+512);
  kf[2]=*(const __attribute__((address_space(3))) bf16x8*)(kp+2048); kf[3]=*(const __attribute__((address_space(3))) bf16x8*)(kp+2560);
  kf[4]=*(const __attribute__((address_space(3))) bf16x8*)(kp+4096); kf[5]=*(const __attribute__((address_space(3))) bf16x8*)(kp+4608);
  kf[6]=*(const __attribute__((address_space(3))) bf16x8*)(kp+6144); kf[7]=*(const __attribute__((address_space(3))) bf16x8*)(kp+6656);
}
__device__ __forceinline__ void kload2(bf16x8*kf,lds_cptr kp,int j){ kf[2*j]=*(const __attribute__((address_space(3))) bf16x8*)(kp+j*2048); kf[2*j+1]=*(const __attribute__((address_space(3))) bf16x8*)(kp+j*2048+512); }
__device__ __forceinline__ s16x4 vtr(lds_cptr p){ return __builtin_bit_cast(s16x4,__builtin_amdgcn_ds_read_tr16_b64_v4i16((__attribute__((address_space(3))) v4i16_t*)p)); }
__device__ __forceinline__ float rowmax(const f32x16&p0,const f32x16&p1){
  float a=max3f(p0[0],p0[1],p1[0]),b=max3f(p0[2],p0[3],p1[1]);a=max3f(a,p1[2],p1[3]);
  #pragma unroll
  for(int r=4;r<16;r+=4){a=max3f(a,p0[r],p0[r+1]);b=max3f(b,p0[r+2],p0[r+3]);a=max3f(a,p1[r],p1[r+1]);b=max3f(b,p1[r+2],p1[r+3]);}
  const float m=max2f(a,b);
  auto rr=__builtin_amdgcn_permlane32_swap(__float_as_uint(m),__float_as_uint(m),false,false);
  return max2f(__uint_as_float(rr[0]),__uint_as_float(rr[1]));
}
__device__ __forceinline__ void pv(f32x16*o,int vb,bf16x8 pa0,bf16x8 pa1,bf16x8 pa2,bf16x8 pa3){
  #pragma unroll
  for(int d0=0;d0<4;++d0){s16x4 lo[4],hi[4];
    #pragma unroll
    for(int ks=0;ks<4;++ks){
      asm volatile("ds_read_b64_tr_b16 %0,%1 offset:%c2":"=&v"(lo[ks]):"v"(vb),"i"(d0*4096+ks*1024):"memory");
      asm volatile("ds_read_b64_tr_b16 %0,%1 offset:%c2":"=&v"(hi[ks]):"v"(vb),"i"(d0*4096+ks*1024+512):"memory");}
    asm volatile("s_waitcnt lgkmcnt(0)":::"memory");SBAR();
    #define PK(k) (bf16x8){lo[k][0],lo[k][1],lo[k][2],lo[k][3],hi[k][0],hi[k][1],hi[k][2],hi[k][3]}
    o[d0]=__builtin_amdgcn_mfma_f32_32x32x16_bf16(pa0,PK(0),o[d0],0,0,0);
    o[d0]=__builtin_amdgcn_mfma_f32_32x32x16_bf16(pa1,PK(1),o[d0],0,0,0);
    o[d0]=__builtin_amdgcn_mfma_f32_32x32x16_bf16(pa2,PK(2),o[d0],0,0,0);
    o[d0]=__builtin_amdgcn_mfma_f32_32x32x16_bf16(pa3,PK(3),o[d0],0,0,0);
    #undef PK
  }
}

#ifndef ATTN_STORE16
#define ATTN_STORE16(p,v) (*(u32x4*)(p)=(v))
#endif
template<int THRL,int VAR> __device__ __forceinline__ void attn_unit(int wave_s,int b,int hq,int qb,const bf16*Q,const bf16*__restrict__ K,const bf16*__restrict__ V,bf16*O,char*shm){
  const int lane=mk_lane(),r32=lane&31,hi=lane>>5; const int wid=wave_s; const int tid=wid*64+lane;
  const long rowbase=(long)b*SEQ; const int q0=qb*QB;
  const bf16*Qw=Q+(rowbase+q0+wid*QBLK)*PQ+hq*D;
  const bf16*Kh=K+rowbase*PQ+hq*D,*Vh=V+rowbase*PQ+(hq>>1)*128;
  const unsigned lds0=(unsigned)(uintptr_t)shm;
  float*wsf=(float*)(shm+LDS_WS)+wid*64;
  const unsigned koff=(unsigned)(lane*PQ+wid*8)*2u;
  const unsigned voff=(unsigned)((16*(wid&3)+(lane>>2))*PQ+(wid>>2)*32+(lane&3)*8)*2u;
  const unsigned kdst=lds0+LDS_K+wid*1024, vdst=lds0+LDS_V+wid*1024;
  #define DMA_K(t,slot) glds16(Kh+(long)(t)*KVBLK*PQ,koff,(unsigned)__builtin_amdgcn_readfirstlane(kdst+(slot)))
  #define DMA_V(t,slot) do{ if(VAR==1)break; glds16(Vh+(long)(t)*KVBLK*PQ,voff,(unsigned)__builtin_amdgcn_readfirstlane(vdst+2*(slot))); glds16(Vh+(long)(t)*KVBLK*PQ,voff+128u,(unsigned)__builtin_amdgcn_readfirstlane(vdst+8192+2*(slot))); }while(0)
  const int vb0=(int)(lds0+LDS_V)+((lane>>4)&1)*32+(lane&3)*8+(4*hi+((lane&15)>>2))*64;
  const char*Kbase=shm+LDS_K; bf16x8 kf[8];
  const lds_cptr shm3=(lds_cptr)shm; const lds_cptr kp0=shm3+LDS_K+hi*1024+r32*16; const lds_cptr vp0=shm3+LDS_V+((lane>>4)&1)*32+(lane&3)*8+(4*hi+((lane&15)>>2))*64;
  const int NT=(q0+QB)/KVBLK;
  DMA_K(0,0);DMA_V(0,0);DMA_K(1,SLOTB);
  const lds_cptr qs=shm3+LDS_Q+wid*4096+lane*16;
  #pragma unroll
  for(int d0=0;d0<4;++d0)*(__attribute__((address_space(3))) bf16x8*)(const_cast<__attribute__((address_space(3))) char*>(qs)+d0*1024)=*reinterpret_cast<const bf16x8*>(&Qw[(long)r32*PQ+d0*16+hi*8]);
  #define LDQ(d0) (*(const __attribute__((address_space(3))) bf16x8*)(qs+(d0)*1024))
  float mhat=0.f,l_reg=0.f;f32x16 o[4];o[0]=f32x16{};o[1]=f32x16{};o[2]=f32x16{};o[3]=f32x16{};const f32x16 negm=f32x16{};
  const int qrel=wid*QBLK+r32;
  #define CMASK(P0,P1,t) do{int jb_=(t)-(NT-4); if(jb_>=0)cmask(P0,P1,jb_,qrel,hi);}while(0)
  bool resc=false;
  #define START(P0,P1) do{ const float rm=rowmax(P0,P1); resc=false; \
    { const float dl=rm; mhat=fadd_s(mhat,dl); \
      _Pragma("unroll") for(int r=0;r<16;++r){P0[r]=fsub_s(P0[r],dl);P1[r]=fsub_s(P1[r],dl);} \
      } \
    _Pragma("unroll") for(int r=0;r<16;++r)P0[r]=__builtin_amdgcn_exp2f(P0[r]); }while(0)
  #define RESC() do{ if(resc){ asm volatile("s_waitcnt lgkmcnt(0)":::"memory"); \
      _Pragma("unroll") for(int d_=0;d_<4;++d_) _Pragma("unroll") for(int r=0;r<16;++r)o[d_][r]*=wsf[crow(r,hi)]; } }while(0)
  f32x16 pA0,pA1,pB0,pB1;
  int sl_prev=0,sl_cur=0,sl_next=SLOTB;
  #define ROT() do{sl_prev=sl_cur;sl_cur=sl_next;sl_next=(sl_next==(NSLOT-1)*SLOTB)?0:sl_next+SLOTB;}while(0)
  DMA_K(2,2*SLOTB);
  WAIT_BAR(4);
  qkt(pA0,pA1,Kbase,qs,negm,r32,hi);asm volatile("s_nop 15\n\ts_nop 7":"+v"(pA0),"+v"(pA1));CMASK(pA0,pA1,0);
  START(pA0,pA1);
  _Pragma("unroll") for(int r=0;r<16;++r)pA1[r]=__builtin_amdgcn_exp2f(pA1[r]);
  WAIT_BAR(0);
  DMA_K(3,0);DMA_V(1,SLOTB);
  ROT();
  kload8(kf,kp0+sl_cur);
  WAIT_BAR(3);
  s16x4 vlo[8],vhi[8]; u32x4 pw0=u32x4{},pw1=u32x4{},pw2=u32x4{},pw3=u32x4{};
  if(VAR==3){_Pragma("unroll") for(int i_=0;i_<8;++i_){vlo[i_]=s16x4{};vhi[i_]=s16x4{};}}
  #define PKW(P,B) cvtpk_s(P[B],P[B+1])
  #define PAF(k) __builtin_bit_cast(bf16x8,pw##k)
  #define VFR(i) (bf16x8){vlo[i][0],vlo[i][1],vlo[i][2],vlo[i][3],vhi[i][0],vhi[i][1],vhi[i][2],vhi[i][3]}
  #define PIN(x) asm volatile("":"+v"(x))
  #define MX3(a,b,c) __builtin_fmaxf(__builtin_fmaxf((a),(b)),(c))
  #define GAPA(MF,A0,A1,A2,A3,W0,W1,PW) do{ MF; if(VAR!=5){sacc+=A0; sacc+=A1; sacc+=A2; sacc+=A3; PIN(sacc); W0; W1; PIN(PW);} SBAR(); }while(0)
  #define EX(v) (VAR==2?(v)*0.5f:__builtin_amdgcn_exp2f(v))
  #define GAPB(MF,X,B) do{ if(VAR!=4){MF;} X[B]=EX(X[B]); X[B+1]=EX(X[B+1]); PIN(X); SBAR(); }while(0)
  #define VRD2(i) do{ if(VAR==3)break; vlo[i]=vtr(vp_+((((i)>>2)+2)*4096+((i)&3)*1024)); vhi[i]=vtr(vp_+((((i)>>2)+2)*4096+((i)&3)*1024+512)); }while(0)
  #define VRD(i) do{ if(VAR==3)break; vlo[i]=vtr(vp_+(((i)>>2)*4096+((i)&3)*1024)); vhi[i]=vtr(vp_+(((i)>>2)*4096+((i)&3)*1024+512)); }while(0)
  #define KRD(G,j) do{ if(G){ kload2(kf,kp0+sl_next,j); SBAR(); } }while(0)
  #define STEP(C0,C1,P0,P1,t,GK,GV,GL) do{ SBAR(); \
    const lds_cptr vp_=vp0+2*sl_prev; \
    bf16x8 qa_=LDQ(0),qb_=LDQ(1); VRD(0); SBAR(); float sacc=(P0[0]+P0[1]); \
    GAPA(C0=__builtin_amdgcn_mfma_f32_32x32x16_bf16(kf[0],qa_,negm,0,0,0), P0[2],P0[3],P0[4],P0[5],     pw0[0]=PKW(P0,0), pw0[1]=PKW(P0,2), pw0); \
    VRD(4); SBAR(); GAPA(C1=__builtin_amdgcn_mfma_f32_32x32x16_bf16(kf[1],qa_,negm,0,0,0), P0[6],P0[7],P0[8],P0[9],     pw0[2]=PKW(P0,4), pw0[3]=PKW(P0,6), pw0); \
    VRD(1); qa_=LDQ(2); SBAR(); GAPA(C0=__builtin_amdgcn_mfma_f32_32x32x16_bf16(kf[2],qb_,C0,0,0,0),   P0[10],P0[11],P0[12],P0[13], pw1[0]=PKW(P0,8), pw1[1]=PKW(P0,10), pw1); \
    VRD(5); SBAR(); GAPA(C1=__builtin_amdgcn_mfma_f32_32x32x16_bf16(kf[3],qb_,C1,0,0,0),   P0[14],P0[15],P1[0],P1[1],   pw1[2]=PKW(P0,12),pw1[3]=PKW(P0,14), pw1); \
    VRD(2); qb_=LDQ(3); SBAR(); GAPA(C0=__builtin_amdgcn_mfma_f32_32x32x16_bf16(kf[4],qa_,C0,0,0,0),   P1[2],P1[3],P1[4],P1[5],     pw2[0]=PKW(P1,0), pw2[1]=PKW(P1,2), pw2); \
    VRD(6); SBAR(); GAPA(C1=__builtin_amdgcn_mfma_f32_32x32x16_bf16(kf[5],qa_,C1,0,0,0),   P1[6],P1[7],P1[8],P1[9],     pw2[2]=PKW(P1,4), pw2[3]=PKW(P1,6), pw2); \
    VRD(3); SBAR(); GAPA(C0=__builtin_amdgcn_mfma_f32_32x32x16_bf16(kf[6],qb_,C0,0,0,0),   P1[10],P1[11],P1[12],P1[13], pw3[0]=PKW(P1,8), pw3[1]=PKW(P1,10), pw3); \
    VRD(7); SBAR(); GAPA(C1=__builtin_amdgcn_mfma_f32_32x32x16_bf16(kf[7],qb_,C1,0,0,0),   P1[14],P1[15],0.f,0.f,       pw3[2]=PKW(P1,12),pw3[3]=PKW(P1,14), pw3); \
    l_reg+=sacc; \
    if(GK){DMA_K((t)+3,sl_cur);} if(GV){DMA_V((t)+1,sl_next);} \
    CMASK(C0,C1,t); \
    _Pragma("unroll") for(int r=0;r<16;++r){C0[r]-=mhat;C1[r]-=mhat;} \
    if(VAR!=6){ float a=MX3(C0[0],C0[1],C1[0]),b=MX3(C0[2],C0[3],C1[1]); a=MX3(a,C1[2],C1[3]); \
      _Pragma("unroll") for(int r=4;r<16;r+=4){a=MX3(a,C0[r],C0[r+1]);b=MX3(b,C0[r+2],C0[r+3]);a=MX3(a,C1[r],C1[r+1]);b=MX3(b,C1[r+2],C1[r+3]);} \
      float rm=__builtin_fmaxf(a,b); { auto rr=__builtin_amdgcn_permlane32_swap(__float_as_uint(rm),__float_as_uint(rm),false,false); rm=__builtin_fmaxf(__uint_as_float(rr[0]),__uint_as_float(rr[1])); } \
      resc=false; \
      if(__builtin_expect(__any(rm>(float)THRL),0)){ const float dl=__builtin_fmaxf(rm,0.f); mhat+=dl; \
        _Pragma("unroll") for(int r=0;r<16;++r){C0[r]-=dl;C1[r]-=dl;} \
        const float f=__builtin_amdgcn_exp2f(-dl); l_reg*=f; if(hi==0)wsf[r32]=f; resc=true; } } \
    SBAR(); \
    GAPB(o[0]=__builtin_amdgcn_mfma_f32_32x32x16_bf16(PAF(0),VFR(0),o[0],0,0,0), C0,0);  VRD2(0); SBAR(); \
    GAPB(o[1]=__builtin_amdgcn_mfma_f32_32x32x16_bf16(PAF(0),VFR(4),o[1],0,0,0), C0,2);  VRD2(4); SBAR(); \
    KRD(GL,0); GAPB(o[0]=__builtin_amdgcn_mfma_f32_32x32x16_bf16(PAF(1),VFR(1),o[0],0,0,0), C0,4);  VRD2(1); SBAR(); \
    KRD(GL,1); GAPB(o[1]=__builtin_amdgcn_mfma_f32_32x32x16_bf16(PAF(1),VFR(5),o[1],0,0,0), C0,6);  VRD2(5); SBAR(); \
    KRD(GL,2); GAPB(o[0]=__builtin_amdgcn_mfma_f32_32x32x16_bf16(PAF(2),VFR(2),o[0],0,0,0), C0,8);  VRD2(2); SBAR(); \
    KRD(GL,3); GAPB(o[1]=__builtin_amdgcn_mfma_f32_32x32x16_bf16(PAF(2),VFR(6),o[1],0,0,0), C0,10); VRD2(6); SBAR(); \
    GAPB(o[0]=__builtin_amdgcn_mfma_f32_32x32x16_bf16(PAF(3),VFR(3),o[0],0,0,0), C0,12); VRD2(3); SBAR(); \
    GAPB(o[1]=__builtin_amdgcn_mfma_f32_32x32x16_bf16(PAF(3),VFR(7),o[1],0,0,0), C0,14); VRD2(7); SBAR(); \
    GAPB(o[2]=__builtin_amdgcn_mfma_f32_32x32x16_bf16(PAF(0),VFR(0),o[2],0,0,0), C1,0); \
    GAPB(o[3]=__builtin_amdgcn_mfma_f32_32x32x16_bf16(PAF(0),VFR(4),o[3],0,0,0), C1,2); \
    GAPB(o[2]=__builtin_amdgcn_mfma_f32_32x32x16_bf16(PAF(1),VFR(1),o[2],0,0,0), C1,4); \
    GAPB(o[3]=__builtin_amdgcn_mfma_f32_32x32x16_bf16(PAF(1),VFR(5),o[3],0,0,0), C1,6); \
    GAPB(o[2]=__builtin_amdgcn_mfma_f32_32x32x16_bf16(PAF(2),VFR(2),o[2],0,0,0), C1,8); \
    GAPB(o[3]=__builtin_amdgcn_mfma_f32_32x32x16_bf16(PAF(2),VFR(6),o[3],0,0,0), C1,10); \
    GAPB(o[2]=__builtin_amdgcn_mfma_f32_32x32x16_bf16(PAF(3),VFR(3),o[2],0,0,0), C1,12); \
    GAPB(o[3]=__builtin_amdgcn_mfma_f32_32x32x16_bf16(PAF(3),VFR(7),o[3],0,0,0), C1,14); \
    }while(0)
  int t=1;
  #undef CMASK
  #define CMASK(P0,P1,t) do{}while(0)
  for(;t+5<NT;t+=2){
    STEP(pB0,pB1,pA0,pA1,t,true,true,true);     WAIT_BAR(3); RESC(); ROT();
    STEP(pA0,pA1,pB0,pB1,t+1,true,true,true);   WAIT_BAR(3); RESC(); ROT();
  }
  #undef CMASK
  #define CMASK(P0,P1,t) do{int jb_=(t)-(NT-4); if(jb_>=0)cmask(P0,P1,jb_,qrel,hi);}while(0)
  #define ENDW(tt) do{ if((tt)+3<NT){WAIT_BAR(3);} else if((tt)+2<NT){WAIT_BAR(2);} else {WAIT_BAR(0);} }while(0)
  for(;t+1<NT;t+=2){
    STEP(pB0,pB1,pA0,pA1,t,(t+3<NT),(t+1<NT),(t+1<NT));       ENDW(t);   RESC(); ROT();
    STEP(pA0,pA1,pB0,pB1,t+1,(t+4<NT),(t+2<NT),(t+2<NT));     ENDW(t+1); RESC(); ROT();
  }
  STEP(pB0,pB1,pA0,pA1,NT-1,false,false,false); RESC();
  { float sacc=pB0[0]+pB0[1]; _Pragma("unroll") for(int r=2;r<16;++r)sacc+=pB0[r]; _Pragma("unroll") for(int r=0;r<16;++r)sacc+=pB1[r]; l_reg+=sacc;
    pw0=(u32x4){PKW(pB0,0),PKW(pB0,2),PKW(pB0,4),PKW(pB0,6)};pw1=(u32x4){PKW(pB0,8),PKW(pB0,10),PKW(pB0,12),PKW(pB0,14)};pw2=(u32x4){PKW(pB1,0),PKW(pB1,2),PKW(pB1,4),PKW(pB1,6)};pw3=(u32x4){PKW(pB1,8),PKW(pB1,10),PKW(pB1,12),PKW(pB1,14)};
    SBAR(); pv(o,vb0+2*sl_cur,PAF(0),PAF(1),PAF(2),PAF(3)); }
  #undef PKW
  #undef PAF
  #undef VFR
  #undef PIN
  #undef MX3
  #undef GAPA
  #undef GAPB
  #undef EX
  #undef VRD
  #undef VRD2
  #undef KRD
  #undef STEP
  #undef ENDW
  {auto rr=__builtin_amdgcn_permlane32_swap(__float_as_uint(l_reg),__float_as_uint(l_reg),false,false);l_reg=__uint_as_float(rr[0])+__uint_as_float(rr[1]);}
  if(hi==0)wsf[32+r32]=l_reg;asm volatile("s_waitcnt lgkmcnt(0)":::"memory");
  float rli[16];
  #pragma unroll
  for(int r=0;r<16;++r)rli[r]=__builtin_amdgcn_rcpf(wsf[32+crow(r,hi)]);
  const int lane_e=mk_lane();
  bf16*Ow=O+(rowbase+q0+wid*QBLK)*OP+hq*128;
  { bf16*stg=(bf16*)(shm+LDS_OST)+wid*2048;
    #pragma unroll
    for(int h2=0;h2<2;++h2){
      #pragma unroll
      for(int r=0;r<16;++r){const int orow=crow(r,hi);
        #pragma unroll
        for(int d0=0;d0<2;++d0)stg[orow*64+d0*32+r32]=__float2bfloat16(o[2*h2+d0][r]*rli[r]);}
      asm volatile("s_waitcnt lgkmcnt(0)":::"memory");
      #pragma unroll
      for(int i=0;i<4;++i){const int row=i*8+(lane_e>>3),ch=lane_e&7; const u32x4 v=*(const u32x4*)(stg+row*64+ch*8); ATTN_STORE16(Ow+(long)row*OP+h2*64+ch*8,v);}
      asm volatile("s_waitcnt lgkmcnt(0)":::"memory"); } }
  asm volatile("s_waitcnt lgkmcnt(0)\n\ts_barrier":::"memory");
  #undef DMA_K
  #undef DMA_V
  #undef CMASK
  #undef START
  #undef RESC
  #undef ROT
  #undef LDQ
}
constexpr int ATTN_LDS_BYTES=LDS_BYTES;
struct AttnTensors { const bf16* Q; const bf16* K; const bf16* V; bf16* O; };
template<int VAR> __device__ __forceinline__ void attn_phase(char*lds,const AttnTensors&T,int vcu,int G,int wave_s){
  for(int c=vcu;c<BATCH*NHEAD*2;c+=G){ const int combo=c>>1,half=c&1,b=combo>>4,hq=combo&15;
    for(int p=7;p>=0;--p){ const int qb=2*p+((p^half)&1); attn_unit<8,VAR>(wave_s,b,hq,qb,T.Q,T.K,T.V,T.O,lds); } }
}
#undef SBAR
#undef WAIT_BAR
}
constexpr int NWAVES = 8;
constexpr int NB = 8, SEQ = 4096, DMODEL = 1024, M = NB * SEQ, DEPTH = 4;
constexpr float RMS_EPS = 1e-6f;
constexpr size_t MiB = 1u << 20;
constexpr size_t WS_CTL = 0, CTL_ZERO_BYTES = 1 * MiB;
constexpr size_t WS_MOD = 1 * MiB;
constexpr size_t WS_ROPE = 2 * MiB;
constexpr size_t WS_WINE = 10 * MiB;
constexpr size_t WS_WOUTE = 16 * MiB;
constexpr size_t WS_WINO = 20 * MiB;
constexpr size_t WS_WOUTO = 32 * MiB;
constexpr size_t WS_WQ = 36 * MiB;
constexpr size_t WS_WSG = 52 * MiB;
constexpr size_t WS_WPT = 52 * MiB + 512 * 1024;
constexpr size_t WS_SUBK = 53 * MiB;
constexpr size_t WS_UV = 56 * MiB;
constexpr int PEER_REC = 1024;
constexpr size_t WS_U = 56 * MiB;
constexpr size_t WS_V = 120 * MiB;
constexpr size_t WS_SU = 184 * MiB;
constexpr size_t WS_SV = 184 * MiB + 512 * 1024;
constexpr size_t WS_SSQ = 185 * MiB;
constexpr size_t WS_SHW = 188 * MiB;
constexpr size_t WS_XRES = 312 * MiB;
constexpr size_t WS_HB = 440 * MiB;
constexpr size_t WS_MIX = 504 * MiB;
constexpr size_t WS_PROJ = 568 * MiB;
constexpr size_t WS_XS = WS_PROJ + 128 * MiB;
constexpr size_t WS_EIDX = 760 * MiB;
constexpr size_t WS_GATE = 768 * MiB;
constexpr size_t WS_END = 784 * MiB;
constexpr int CW_BAR = 4096;
constexpr int RING_OFF = 0, RING_BYTES = 131072;
constexpr int LDS_BYTES = 163840;
constexpr int LDSCTL_OFF = LDS_BYTES - 1024, MISC_OFF = LDSCTL_OFF + 320;
constexpr int PEER_LDS_LIMIT = LDSCTL_OFF;

#define GAS __attribute__((address_space(1)))
#define LAS __attribute__((address_space(3)))
typedef unsigned short bf16;
typedef unsigned v4u __attribute__((ext_vector_type(4)));
typedef unsigned v2u __attribute__((ext_vector_type(2)));
typedef int v4i __attribute__((ext_vector_type(4)));
typedef int v8i __attribute__((ext_vector_type(8)));
typedef float f32x4 __attribute__((ext_vector_type(4)));
typedef float f32x2 __attribute__((ext_vector_type(2)));
typedef float f32x16 __attribute__((ext_vector_type(16)));
typedef short bf16x8 __attribute__((ext_vector_type(8)));
typedef short s16x4 __attribute__((ext_vector_type(4)));
typedef __bf16 bf16x2_t __attribute__((ext_vector_type(2)));
typedef GAS unsigned gu32;
#define RLX_AGENT __ATOMIC_RELAXED, __HIP_MEMORY_SCOPE_AGENT
#define LDS_WAIT() asm volatile("s_waitcnt lgkmcnt(0)" ::: "memory")
#define VM_WAIT() asm volatile("s_waitcnt vmcnt(0)" ::: "memory")
__device__ __forceinline__ unsigned f2bf(float f) { unsigned u = __builtin_bit_cast(unsigned, f); return (u + 0x7fffu + ((u >> 16) & 1u)) >> 16; }
__device__ __forceinline__ unsigned pk2(float lo, float hi) { const f32x2 v = {lo, hi}; return __builtin_bit_cast(unsigned, __builtin_convertvector(v, bf16x2_t)); }
#ifndef FP8_EVEN
#define FP8_EVEN 0
#endif
#ifndef FP8_ODD
#define FP8_ODD 1
#endif
__device__ __forceinline__ unsigned pk4_fp8x8(float a, float b, float c, float d) {
    int pk = 0; pk = __builtin_amdgcn_cvt_pk_fp8_f32(__builtin_amdgcn_fmed3f(a * 8.0f, -448.f, 448.f), __builtin_amdgcn_fmed3f(b * 8.0f, -448.f, 448.f), pk, false);
    pk = __builtin_amdgcn_cvt_pk_fp8_f32(__builtin_amdgcn_fmed3f(c * 8.0f, -448.f, 448.f), __builtin_amdgcn_fmed3f(d * 8.0f, -448.f, 448.f), pk, true); return (unsigned)pk; }
__device__ __forceinline__ float bflo(unsigned w) { return __builtin_bit_cast(float, w << 16); }
__device__ __forceinline__ float bfhi(unsigned w) { return __builtin_bit_cast(float, w & 0xffff0000u); }
__device__ __forceinline__ float asf(unsigned u) { return __builtin_bit_cast(float, u); }
__device__ __forceinline__ unsigned asu(float f) { return __builtin_bit_cast(unsigned, f); }
__device__ __forceinline__ float dot2bf(unsigned a, unsigned b, float c) { return __builtin_amdgcn_fdot2_f32_bf16(__builtin_bit_cast(bf16x2_t, a), __builtin_bit_cast(bf16x2_t, b), c, false); }
#define XB_TMO      128
#define XB_XCNT(j)  (256  + 64 * (j))
#define XB_XSUB(j)  (1280 + 64 * (j))
#define XB_XGEN(j)  (2304 + 64 * (j))
#define XB_TOP      3328
#define XB_TOPGEN   3392
#define XCD_BAR_WORDS 3456
#define XB_SPIN_CAP (1u << 18)

__device__ __forceinline__ unsigned xb_ld(unsigned* p)              { return __hip_atomic_load(p, __ATOMIC_RELAXED, __HIP_MEMORY_SCOPE_AGENT); }
__device__ __forceinline__ unsigned xb_add(unsigned* p, unsigned v) { return __hip_atomic_fetch_add(p, v, __ATOMIC_RELAXED, __HIP_MEMORY_SCOPE_AGENT); }
__device__ __forceinline__ unsigned xb_xcc_id() { return (unsigned)__builtin_amdgcn_s_getreg((3 << 11) | 20) & 0xFu; }
#define XB_SPIN(cond, bar) do { unsigned _sp = 0; while (cond) { __builtin_amdgcn_s_sleep(1); \
    if ((++_sp & 255u) == 0u) { if (xb_ld(&(bar)[XB_TMO])) break; if (_sp > XB_SPIN_CAP) { atomicAdd(&(bar)[XB_TMO], 1u); break; } } } } while (0)

struct XcdBarrier {
    unsigned* bar; unsigned x;
    volatile LAS unsigned* st;
};

__device__ __forceinline__ XcdBarrier xcd_barrier_post(unsigned* bar, volatile LAS unsigned* st, bool leader) {
    XcdBarrier b; b.bar = bar; b.x = xb_xcc_id(); b.st = st;
    if (leader) (void)xb_add(&bar[XB_XCNT(b.x)], 1u);
    return b;
}
__device__ __forceinline__ void xcd_barrier_complete(unsigned* bar, unsigned x, unsigned& nloc, unsigned& nx) {
    const unsigned G = gridDim.x * gridDim.y * gridDim.z;
    unsigned sum, cnt, mine, sp = 0u;
    for (;;) {
        sum = 0u; cnt = 0u; mine = 0u;
#pragma unroll
        for (unsigned j = 0; j < 16; ++j) { const unsigned c = xb_ld(&bar[XB_XCNT(j)]); sum += c; cnt += (c > 0u) ? 1u : 0u; }
        mine = xb_ld(&bar[XB_XCNT(x)]);
        if (sum == G) break;
        __builtin_amdgcn_s_sleep(1);
        if ((++sp & 255u) == 0u) { if (xb_ld(&bar[XB_TMO])) break; if (sp > XB_SPIN_CAP) { atomicAdd(&bar[XB_TMO], 1u); break; } }
    }
    nloc = mine > 0u ? mine : 1u; nx = cnt > 0u ? cnt : 1u;
}

__device__ __forceinline__ void xcd_barrier(const XcdBarrier& b, bool leader) {
    asm volatile("s_waitcnt vmcnt(0)" ::: "memory");
    __syncthreads();
    if (leader) {
        unsigned* bar = b.bar;
        __builtin_amdgcn_s_waitcnt(0);
        unsigned nloc = b.st[0], nx = b.st[1];
        if (nloc == 0u) { xcd_barrier_complete(bar, b.x, nloc, nx); b.st[0] = nloc; b.st[1] = nx; }
        const unsigned old = xb_add(&bar[XB_XSUB(b.x)], 1u);
        const unsigned gen = old / nloc;
        if (old + 1u == (gen + 1u) * nloc) {
            __builtin_amdgcn_fence(__ATOMIC_RELEASE, "agent");
            asm volatile("s_waitcnt vmcnt(0)" ::: "memory");
            const unsigned og = xb_add(&bar[XB_TOP], 1u);
            const unsigned tg = og / nx;
            if (og + 1u == (tg + 1u) * nx) xb_add(&bar[XB_TOPGEN], 1u);
            else XB_SPIN(xb_ld(&bar[XB_TOPGEN]) == tg, bar);
            __builtin_amdgcn_fence(__ATOMIC_ACQUIRE, "agent");
            xb_add(&bar[XB_XGEN(b.x)], 1u);
            asm volatile("s_waitcnt vmcnt(0)" ::: "memory");
        } else {
            XB_SPIN(xb_ld(&bar[XB_XGEN(b.x)]) == gen, bar);
            __builtin_amdgcn_fence(__ATOMIC_ACQUIRE, "agent");
            asm volatile("s_waitcnt vmcnt(0)" ::: "memory");
        }
    }
    __syncthreads();
}
struct Args { const float* in[26]; float* out; unsigned char* ws; int ph_lo, ph_hi; };
typedef const unsigned char __attribute__((address_space(4)))* kptr_t;
struct KA { kptr_t kp;
    __device__ __forceinline__ const float* in(int k) const { return *(const float* const __attribute__((address_space(4)))*)(kp + 8 * k); }
    __device__ __forceinline__ float* out() const { return *(float* const __attribute__((address_space(4)))*)(kp + 208); }
    __device__ __forceinline__ unsigned char* ws() const { return *(unsigned char* const __attribute__((address_space(4)))*)(kp + 216); } };
struct Frame {
    LAS unsigned char* lds;
    volatile LAS unsigned* MISC;
    gu32* ctl;
    int tid, lane, wave;
    int vcu, G, bx;
    float* out; unsigned char* ws;
};
__device__ __forceinline__ float wave_sum(float v) {
    const int lane = mk_lane();
#pragma unroll
    for (int o = 1; o < 64; o <<= 1) v += lshfl(v, lane ^ o);
    return v;
}
template <bool ROPEPERM, bool F8 = false>
__device__ __forceinline__ void p0_transpose_item(const float* W, int K, int N, bf16* WT, LAS float* scr, int item, int lane) {
    const int nblk = N / 32, kb = item / nblk, nb = item % nblk, k0 = 64 * kb, n0 = 32 * nb;
    int ncol = n0 + (lane & 31);
    if (ROPEPERM && ncol < 2048) { const int pc = ncol & 63; ncol = (ncol & ~63) + (pc >> 1) + 32 * (pc & 1); }
#pragma unroll 8
    for (int i = 0; i < 32; ++i) { const int kk = 2 * i + (lane >> 5); scr[kk * 33 + (lane & 31)] = W[(size_t)(k0 + kk) * N + ncol]; }
    LDS_WAIT(); asm volatile("" ::: "memory");
    const int c = lane & 7;
#pragma unroll
    for (int j = 0; j < 4; ++j) { const int n = (lane >> 3) + 8 * j; const LAS float* s = scr + (8 * c) * 33 + n;
        if (F8) { v2u o; o.x = pk4_fp8x8(s[0 * 33] * 32.0f, s[1 * 33] * 32.0f, s[2 * 33] * 32.0f, s[3 * 33] * 32.0f); o.y = pk4_fp8x8(s[4 * 33] * 32.0f, s[5 * 33] * 32.0f, s[6 * 33] * 32.0f, s[7 * 33] * 32.0f);
            *(GAS v2u*)((unsigned char*)WT + (size_t)(n0 + n) * K + k0 + 8 * c) = o; continue; }
        v4u o; o.x = pk2(s[0 * 33], s[1 * 33]); o.y = pk2(s[2 * 33], s[3 * 33]); o.z = pk2(s[4 * 33], s[5 * 33]); o.w = pk2(s[6 * 33], s[7 * 33]);
        *(GAS v4u*)(WT + (size_t)(n0 + n) * K + k0 + 8 * c) = o; }
    LDS_WAIT(); asm volatile("" ::: "memory");
}
template <bool MASK>
__device__ __forceinline__ void cvt_row(const float* src, bf16* dst, int lane, int flat0) {
    const GAS f32x4* s4 = (const GAS f32x4*)src + lane; GAS v2u* d2 = (GAS v2u*)dst + lane;
#pragma unroll
    for (int j = 0; j < 4; ++j) { f32x4 v = s4[64 * j];
        if (MASK) { const int idx = flat0 + j * 256 + lane * 4; const int t = (idx >> 7) & 127, s = idx & 127;
            if (s + 0 > t) v.x = 0.f; if (s + 1 > t) v.y = 0.f; if (s + 2 > t) v.z = 0.f; if (s + 3 > t) v.w = 0.f; }
        v2u o; o.x = pk2(v.x, v.y); o.y = pk2(v.z, v.w); d2[64 * j] = o; }
}
template <int OFFS>
__device__ __forceinline__ void quant_rows4(const float* src, unsigned char* dst, int dpitch, float* scale, int lane) {
    f32x4 v[4][4];
#pragma unroll
    for (int r = 0; r < 4; ++r)
#pragma unroll
        for (int j = 0; j < 4; ++j) v[r][j] = *((const GAS f32x4*)(src + (size_t)r * 1024) + lane + 64 * j);
#pragma unroll
    for (int r = 0; r < 4; ++r) { float am = 0.f;
#pragma unroll
        for (int j = 0; j < 4; ++j) am = __builtin_fmaxf(am, __builtin_fmaxf(__builtin_fmaxf(__builtin_fabsf(v[r][j].x), __builtin_fabsf(v[r][j].y)), __builtin_fmaxf(__builtin_fabsf(v[r][j].z), __builtin_fabsf(v[r][j].w))));
#pragma unroll
        for (int o = 1; o < 64; o <<= 1) am = __builtin_fmaxf(am, lshfl(am, lane ^ o));
        const float sc = am > 0.f ? am * (OFFS == -8 ? 1.0f / 448.0f : 1.0f / 127.0f) : 1.0f, inv = 1.0f / sc; GAS unsigned* d1 = (GAS unsigned*)(dst + (size_t)r * dpitch) + lane;
#pragma unroll
        for (int j = 0; j < 4; ++j) { if (OFFS == -8) {
                int pk = 0; pk = __builtin_amdgcn_cvt_pk_fp8_f32(v[r][j].x * inv, v[r][j].y * inv, pk, false); pk = __builtin_amdgcn_cvt_pk_fp8_f32(v[r][j].z * inv, v[r][j].w * inv, pk, true); d1[64 * j] = (unsigned)pk; continue; } const int a = (int)__builtin_rintf(v[r][j].x * inv) + OFFS, b = (int)__builtin_rintf(v[r][j].y * inv) + OFFS, c = (int)__builtin_rintf(v[r][j].z * inv) + OFFS, d = (int)__builtin_rintf(v[r][j].w * inv) + OFFS;
            d1[64 * j] = (unsigned)(a & 255) | ((unsigned)(b & 255) << 8) | ((unsigned)(c & 255) << 16) | ((unsigned)(d & 255) << 24); }
        if (lane == 0) scale[r] = sc; }
}
__device__ __forceinline__ void quant_rows4_u4(const float* src, unsigned char* dst, int dpitch, float* scale, int lane) {
    f32x4 v[4][4];
#pragma unroll
    for (int r = 0; r < 4; ++r)
#pragma unroll
        for (int j = 0; j < 4; ++j) v[r][j] = *((const GAS f32x4*)(src + (size_t)r * 1024) + lane + 64 * j);
#pragma unroll
    for (int r = 0; r < 4; ++r) { float s2 = 0.f;
#pragma unroll
        for (int j = 0; j < 4; ++j) s2 += (v[r][j].x * v[r][j].x + v[r][j].y * v[r][j].y) + (v[r][j].z * v[r][j].z + v[r][j].w * v[r][j].w);
        s2 = wave_sum(s2);
        const float sc = s2 > 0.f ? 0.3352f * sqrtf(s2 * (1.0f / 1024.0f)) : 1.0f, inv = 1.0f / sc; GAS unsigned short* d1 = (GAS unsigned short*)(dst + (size_t)r * dpitch) + lane;
#pragma unroll
        for (int j = 0; j < 4; ++j) { const float c0 = __builtin_fminf(__builtin_fmaxf(__builtin_rintf(v[r][j].x * inv + 7.5f), 0.f), 15.f), c1 = __builtin_fminf(__builtin_fmaxf(__builtin_rintf(v[r][j].y * inv + 7.5f), 0.f), 15.f),
                c2 = __builtin_fminf(__builtin_fmaxf(__builtin_rintf(v[r][j].z * inv + 7.5f), 0.f), 15.f), c3 = __builtin_fminf(__builtin_fmaxf(__builtin_rintf(v[r][j].w * inv + 7.5f), 0.f), 15.f);
            d1[64 * j] = (unsigned short)((unsigned)c0 | ((unsigned)c1 << 4) | ((unsigned)c2 << 8) | ((unsigned)c3 << 12)); }
        if (lane == 0) scale[r] = sc; }
}
__device__ __forceinline__ void quant_rows4_fp4(const float* src, unsigned char* dst, int dpitch, float* scale, int lane) {
    f32x4 v[4][4];
#pragma unroll
    for (int r = 0; r < 4; ++r)
#pragma unroll
        for (int j = 0; j < 4; ++j) v[r][j] = *((const GAS f32x4*)(src + (size_t)r * 1024) + lane + 64 * j);
#pragma unroll
    for (int r = 0; r < 4; ++r) { float s2 = 0.f;
#pragma unroll
        for (int j = 0; j < 4; ++j) s2 += (v[r][j].x * v[r][j].x + v[r][j].y * v[r][j].y) + (v[r][j].z * v[r][j].z + v[r][j].w * v[r][j].w);
        s2 = wave_sum(s2);
        const float sc = s2 > 0.f ? 0.5f * sqrtf(s2 * (1.0f / 1024.0f)) : 1.0f, inv = 1.0f / sc; GAS unsigned short* d1 = (GAS unsigned short*)(dst + (size_t)r * dpitch) + lane;
#pragma unroll
        for (int j = 0; j < 4; ++j) { const float c0 = __builtin_fminf(__builtin_fmaxf(v[r][j].x * inv, -6.f), 6.f), c1 = __builtin_fminf(__builtin_fmaxf(v[r][j].y * inv, -6.f), 6.f),
                c2 = __builtin_fminf(__builtin_fmaxf(v[r][j].z * inv, -6.f), 6.f), c3 = __builtin_fminf(__builtin_fmaxf(v[r][j].w * inv, -6.f), 6.f);
            unsigned pk = 0u; pk = __builtin_amdgcn_cvt_scalef32_pk_fp4_f32(pk, c0, c1, 1.0f, 0); pk = __builtin_amdgcn_cvt_scalef32_pk_fp4_f32(pk, c2, c3, 1.0f, 1);
            d1[64 * j] = (unsigned short)pk; }
        if (lane == 0) scale[r] = sc; }
}
constexpr int I_WINE = 2 * 16 * 48, I_WOUTE = 2 * 16 * 32, I_WINO = 2 * 16 * 96, I_WOUTO = 2 * 16 * 32, I_WQ = 4 * 16 * 64, I_WPT = 8 * 8;
constexpr int I_RU = 16384, I_RV = 16384  , I_RSK = 1024, I_RWS = 128, I_ROPE = M * 32 / 64;
constexpr int NITEMS = I_WINE + I_WOUTE + I_WINO + I_WOUTO + I_WQ + I_WPT + I_RU + I_RV + I_RSK + I_RWS + I_ROPE;
__device__ __forceinline__ void p0_prologue(Frame& F, const KA& A) {
    unsigned char* ws = F.ws; const int lane = mk_lane();
    for (int item = F.vcu; item < 4 * 48 + ((F.G - (4 * 48) % F.G) % F.G); item += F.G) {
        float acc[8][2];
#pragma unroll
        for (int b = 0; b < 8; ++b) { acc[b][0] = 0.f; acc[b][1] = 0.f; }
        const bool live = item < 4 * 48; const int l = live ? item / 48 : 0, nb = live ? item % 48 : 0;
        if (live) { const float* W = A.in(3) + (size_t)l * 1024 * 6144 + nb * 128 + 2 * lane; const float* c = A.in(1);
#pragma unroll 1
            for (int kb = 0; kb < 2; ++kb) { const int k0 = F.wave * 128 + kb * 64;
                float cv[8];
#pragma unroll
                for (int b = 0; b < 8; ++b) { const float x = c[b * 1024 + k0 + lane]; cv[b] = x / (1.0f + __expf(-x)); }
#pragma unroll 16
                for (int kk = 0; kk < 64; ++kk) { const f32x2 w = *(const GAS f32x2*)(W + (size_t)(k0 + kk) * 6144);
#pragma unroll
                    for (int b = 0; b < 8; ++b) { const float cb = asf(__builtin_amdgcn_readlane(asu(cv[b]), kk)); acc[b][0] += cb * w.x; acc[b][1] += cb * w.y; } } } }
        LAS float* red = (LAS float*)(F.lds + RING_OFF);
#pragma unroll
        for (int b = 0; b < 8; ++b) *(LAS f32x2*)(red + (F.wave * 8 + b) * 128 + 2 * lane) = (f32x2){acc[b][0], acc[b][1]};
        LDS_WAIT(); __syncthreads();
        if (live) { const int t = F.wave * 64 + lane;
#pragma unroll
            for (int q = 0; q < 2; ++q) { const int o = t + 512 * q, b = o >> 7, col = o & 127; float sum = 0.f;
#pragma unroll
                for (int w = 0; w < 8; ++w) sum += red[(w * 8 + b) * 128 + col];
                ((float*)(ws + WS_MOD))[((size_t)l * 8 + b) * 6144 + nb * 128 + col] = sum + A.in(4)[l * 6144 + nb * 128 + col]; } }
        LDS_WAIT(); __syncthreads();
    }
    LAS float* scr = (LAS float*)(F.lds + RING_OFF + F.wave * 16384);
    const int gw = F.vcu * NWAVES + F.wave, NGW = F.G * NWAVES;
    for (int it = gw; it < NITEMS; it += NGW) {
        int r = it;
        if (r < I_WINE) { const int e = r / 768; p0_transpose_item<false, FP8_EVEN != 0>(A.in(7) + (size_t)e * 1024 * 1536, 1024, 1536, (bf16*)(ws + WS_WINE + (size_t)e * 1536 * 1024 * (FP8_EVEN ? 1 : 2)), scr, r % 768, lane); continue; } r -= I_WINE;
        if (r < I_WOUTE) { const int e = r / 512; p0_transpose_item<false>(A.in(13) + (size_t)e * 1024 * 1024, 1024, 1024, (bf16*)(ws + WS_WOUTE) + (size_t)e * 1024 * 1024, scr, r % 512, lane); continue; } r -= I_WOUTE;
        if (r < I_WINO) { const int e = r / 1536; p0_transpose_item<true, FP8_ODD != 0>(A.in(14) + (size_t)e * 1024 * 3072, 1024, 3072, (bf16*)(ws + WS_WINO + (size_t)e * 3072 * 1024 * (FP8_ODD ? 1 : 2)), scr, r % 1536, lane); continue; } r -= I_WINO;
        if (r < I_WOUTO) { const int e = r / 512; p0_transpose_item<false>(A.in(20) + (size_t)e * 1024 * 1024, 1024, 1024, (bf16*)(ws + WS_WOUTO) + (size_t)e * 1024 * 1024, scr, r % 512, lane); continue; } r -= I_WOUTO;
        if (r < I_WQ) { const int e = r / 1024; p0_transpose_item<false>(A.in(21) + (size_t)e * 1024 * 2048, 1024, 2048, (bf16*)(ws + WS_WQ) + (size_t)e * 2048 * 1024, scr, r % 1024, lane); continue; } r -= I_WQ;
        if (r < I_WPT) { const int e = r / 8; p0_transpose_item<false>(A.in(11) + (size_t)e * 128 * 128, 128, 128, (bf16*)(ws + WS_WPT) + (size_t)e * 128 * 128, scr, r % 8, lane); continue; } r -= I_WPT;
        if (r < I_RU) { quant_rows4_fp4(A.in(23) + (size_t)r * 4096, ws + WS_UV + (size_t)r * (4 * PEER_REC), PEER_REC, (float*)(ws + WS_SU) + 4 * r, lane); continue; } r -= I_RU;
        if (r < I_RV) { quant_rows4_fp4(A.in(24) + (size_t)r * 4096, ws + WS_UV + 512 + (size_t)r * (4 * PEER_REC), PEER_REC, (float*)(ws + WS_SV) + 4 * r, lane); continue; } r -= I_RV;
        if (r < I_RSK) { cvt_row<false>(A.in(22) + (size_t)r * 1024, (bf16*)(ws + WS_SUBK) + (size_t)r * 1024, lane, 0); continue; } r -= I_RSK;
        if (r < I_RWS) { cvt_row<true>(A.in(9) + (size_t)r * 1024, (bf16*)(ws + WS_WSG) + (size_t)r * 1024, lane, r * 1024); continue; } r -= I_RWS;
        {
            const int idx = r * 64 + lane, row = idx >> 5, i = idx & 31;
            const int pos = ((const int*)A.in(2))[row];
            const float g = __builtin_amdgcn_exp2f(-0.41524101186092029f * (float)i) * 0.15915494309189535f, fp = (float)pos;
            const float fr = __builtin_fmaf(fp, g, -__builtin_rintf(fp * g));
            const float s = __builtin_amdgcn_sinf(fr), c = __builtin_amdgcn_cosf(fr);
            ((GAS f32x2*)(ws + WS_ROPE))[idx] = (f32x2){c, s};
        }
    }
}

__device__ __forceinline__ void norm_phase(Frame& F, const float* src, const float* gain, const float* sh, const float* sc, bf16* dst) {
    const int gw = F.vcu * NWAVES + F.wave, NGW = F.G * NWAVES, lane = mk_lane();
    const GAS f32x4* g4 = (const GAS f32x4*)gain + lane;
    for (int m = gw; m < M; m += NGW) {
        const int b = m >> 12;
        const GAS f32x4* xr = (const GAS f32x4*)(src + (size_t)m * 1024) + lane;
        const GAS f32x4* s4 = (const GAS f32x4*)(sh + (size_t)b * 6144) + lane; const GAS f32x4* c4 = (const GAS f32x4*)(sc + (size_t)b * 6144) + lane;
        f32x4 v[4]; float s2 = 0.f;
#pragma unroll
        for (int j = 0; j < 4; ++j) { v[j] = xr[64 * j]; s2 += (v[j].x * v[j].x + v[j].y * v[j].y) + (v[j].z * v[j].z + v[j].w * v[j].w); }
        const float rstd = 1.0f / sqrtf(wave_sum(s2) * (1.0f / 1024.0f) + RMS_EPS);
        GAS unsigned* o1 = (GAS unsigned*)((unsigned char*)dst + (size_t)m * 1024) + lane;
        GAS v2u* o2 = (GAS v2u*)(dst + (size_t)m * 1024) + lane;
#pragma unroll
        for (int j = 0; j < 4; ++j) { const f32x4 g = g4[64 * j], a = s4[64 * j], c = c4[64 * j];
            const f32x4 o = v[j] * rstd * g * (c + 1.0f) + a; if (FP8_EVEN) o1[64 * j] = pk4_fp8x8(o.x, o.y, o.z, o.w); else { v2u w; w.x = pk2(o.x, o.y); w.y = pk2(o.z, o.w); o2[64 * j] = w; } }
    }
}
__device__ __forceinline__ void shw_items(Frame& F) {
    const int gw = F.vcu * NWAVES + F.wave, NGW = F.G * NWAVES, lane = mk_lane();
    const bf16* WQ = (const bf16*)(F.ws + WS_WQ); const float* mod = (const float*)(F.ws + WS_MOD); float* shw = (float*)(F.ws + WS_SHW);
    for (int it = gw; it < 4 * 2048; it += NGW) { const int l = it >> 11, n = it & 2047;
        const v4u wa = *(const GAS v4u*)(WQ + ((size_t)l * 2048 + n) * 1024 + lane * 16), wb = *(const GAS v4u*)(WQ + ((size_t)l * 2048 + n) * 1024 + lane * 16 + 8);
        const unsigned ww[8] = {wa.x, wa.y, wa.z, wa.w, wb.x, wb.y, wb.z, wb.w}; float wf[16];
#pragma unroll
        for (int j = 0; j < 8; ++j) { wf[2 * j] = bflo(ww[j]); wf[2 * j + 1] = bfhi(ww[j]); }
        float res = 0.f;
#pragma unroll
        for (int b = 0; b < 8; ++b) { const float* sh = mod + ((size_t)l * 8 + b) * 6144 + 3072 + lane * 16; float d = 0.f;
#pragma unroll
            for (int q = 0; q < 4; ++q) { const f32x4 s4 = *(const GAS f32x4*)(sh + 4 * q); d += (s4.x * wf[4 * q] + s4.y * wf[4 * q + 1]) + (s4.z * wf[4 * q + 2] + s4.w * wf[4 * q + 3]); }
            d = wave_sum(d); res = (lane == b) ? d : res; }
        if (lane < 8) shw[((size_t)l * 8 + lane) * 2048 + n] = res; }
}
__device__ __forceinline__ void final_norm_phase(Frame& F, const float* src, const float* gain, float* dst) {
    const int gw = F.vcu * NWAVES + F.wave, NGW = F.G * NWAVES, lane = mk_lane();
    const GAS f32x4* g4 = (const GAS f32x4*)gain + lane;
    for (int m = gw; m < M; m += NGW) {
        const GAS f32x4* xr = (const GAS f32x4*)(src + (size_t)m * 1024) + lane;
        f32x4 v[4]; float s2 = 0.f;
#pragma unroll
        for (int j = 0; j < 4; ++j) { v[j] = xr[64 * j]; s2 += (v[j].x * v[j].x + v[j].y * v[j].y) + (v[j].z * v[j].z + v[j].w * v[j].w); }
        const float rstd = 1.0f / sqrtf(wave_sum(s2) * (1.0f / 1024.0f) + RMS_EPS);
        GAS f32x4* o4 = (GAS f32x4*)(dst + (size_t)m * 1024) + lane;
#pragma unroll
        for (int j = 0; j < 4; ++j) o4[64 * j] = v[j] * rstd * g4[64 * j];
#ifdef PROBE_TIME
        { const float cval = (float)(((const unsigned*)(F.ws + WS_CTL) + 2048)[PROBE_TIME]) * 0.00025f;
#pragma unroll
          for (int j = 0; j < 4; ++j) o4[64 * j] = (f32x4){cval, cval, cval, cval}; }
#endif
    }
}

__device__ __forceinline__ s16x4 tr16(LAS const unsigned char* p) { typedef short v4i16_t __attribute__((ext_vector_type(4))); return __builtin_bit_cast(s16x4, __builtin_amdgcn_ds_read_tr16_b64_v4i16((LAS v4i16_t*)p)); }
__device__ __forceinline__ void e2_phase(Frame& F, const KA& A, int e) {
    const int lane = mk_lane(), wave = F.wave, r32 = lane & 31, hi = lane >> 5;
    const bf16* PROJ = (const bf16*)(F.ws + WS_PROJ); bf16* MIX = (bf16*)(F.ws + WS_MIX);
    const bf16* WSG = (const bf16*)(F.ws + WS_WSG) + (size_t)e * 4 * 128 * 128; const bf16* WPT = (const bf16*)(F.ws + WS_WPT) + (size_t)e * 4 * 128 * 128;
    const float* gv = A.in(8) + e * 512; const float* bs = A.in(10) + e * 512; const float* ls = A.in(12) + e * 512;
    LAS unsigned char* lds = F.lds;
    for (int unit = F.vcu; unit < M / 128; unit += F.G) {
        const int row0 = unit * 128, pos0 = (unit & 31) * 128;
        {
            const f32x4 ga = *(const GAS f32x4*)(gv + lane * 8), gb = *(const GAS f32x4*)(gv + lane * 8 + 4);
            v4u raw[16];
#pragma unroll
            for (int tt = 0; tt < 16; ++tt) raw[tt] = *(const GAS v4u*)(PROJ + (size_t)(row0 + wave * 16 + tt) * 1536 + 512 + lane * 8);
#pragma unroll
            for (int hf = 0; hf < 2; ++hf) { float x[8][8], sm[8], q[8];
#pragma unroll
                for (int tt = 0; tt < 8; ++tt) { const v4u r = raw[hf * 8 + tt];
                    x[tt][0] = bflo(r.x); x[tt][1] = bfhi(r.x); x[tt][2] = bflo(r.y); x[tt][3] = bfhi(r.y); x[tt][4] = bflo(r.z); x[tt][5] = bfhi(r.z); x[tt][6] = bflo(r.w); x[tt][7] = bfhi(r.w);
                    float t = 0.f;
#pragma unroll
                    for (int j = 0; j < 8; ++j) t += x[tt][j];
                    sm[tt] = t; }
#pragma unroll
                for (int o = 1; o < 64; o <<= 1) {
#pragma unroll
                    for (int tt = 0; tt < 8; ++tt) sm[tt] += lshfl(sm[tt], lane ^ o); }
#pragma unroll
                for (int tt = 0; tt < 8; ++tt) { const float mu = sm[tt] * (1.0f / 512.0f); float t = 0.f;
#pragma unroll
                    for (int j = 0; j < 8; ++j) { x[tt][j] -= mu; t += x[tt][j] * x[tt][j]; }
                    q[tt] = t; }
#pragma unroll
                for (int o = 1; o < 64; o <<= 1) {
#pragma unroll
                    for (int tt = 0; tt < 8; ++tt) q[tt] += lshfl(q[tt], lane ^ o); }
#pragma unroll
                for (int tt = 0; tt < 8; ++tt) { const int s = wave * 16 + hf * 8 + tt;
                    const float rstd = 1.0f / sqrtf(q[tt] * (1.0f / 512.0f) + RMS_EPS);
                    v4u o; o.x = pk2(x[tt][0] * rstd * ga.x, x[tt][1] * rstd * ga.y); o.y = pk2(x[tt][2] * rstd * ga.z, x[tt][3] * rstd * ga.w);
                    o.z = pk2(x[tt][4] * rstd * gb.x, x[tt][5] * rstd * gb.y); o.w = pk2(x[tt][6] * rstd * gb.z, x[tt][7] * rstd * gb.w);
                    const int g = lane >> 4, c = (lane & 15) * 8;
                    *(LAS v4u*)(lds + g * 32768 + (c >> 5) * 8192 + s * 64 + (c & 31) * 2) = o; } }
        }
        LDS_WAIT(); __syncthreads();
        const int tt2 = wave >> 1, ch = wave & 1;
        const int t = 32 * tt2 + r32, row = row0 + t;
        bf16x8 wf[2][8];
#pragma unroll
        for (int ks = 0; ks < 8; ++ks) wf[0][ks] = *(const GAS bf16x8*)(WSG + (size_t)t * 128 + 8 * hi + 16 * ks);
#pragma unroll
        for (int g = 0; g < 4; ++g) {
            f32x16 acc[2]; acc[0] = f32x16{}; acc[1] = f32x16{};
            if (g + 1 < 4) {
#pragma unroll
                for (int ks = 0; ks < 8; ++ks) wf[(g + 1) & 1][ks] = *(const GAS bf16x8*)(WSG + (size_t)((g + 1) * 128 + t) * 128 + 8 * hi + 16 * ks); }
            v2u uu[2][4];
#pragma unroll
            for (int cc = 0; cc < 2; ++cc)
#pragma unroll
                for (int q = 0; q < 4; ++q) uu[cc][q] = *(const GAS v2u*)(PROJ + (size_t)row * 1536 + g * 128 + 32 * (2 * ch + cc) + 8 * q + 4 * hi);
            const float bsv = bs[g * 128 + t];
#pragma unroll
            for (int ks = 0; ks < 8; ++ks) { const bf16x8 bfrag = wf[g & 1][ks];
#pragma unroll
                for (int cc = 0; cc < 2; ++cc) { const int ct = 2 * ch + cc;
                    LAS const unsigned char* ap = lds + g * 32768 + ct * 8192 + (16 * ks) * 64 + ((lane >> 4) & 1) * 32 + (lane & 3) * 8 + (8 * hi + ((lane & 15) >> 2)) * 64;
                    const s16x4 lo = tr16(ap), h4 = tr16(ap + 256);
                    const bf16x8 afrag = (bf16x8){lo[0], lo[1], lo[2], lo[3], h4[0], h4[1], h4[2], h4[3]};
                    acc[cc] = __builtin_amdgcn_mfma_f32_32x32x16_bf16(afrag, bfrag, acc[cc], 0, 0, 0); } }
#pragma unroll
            for (int cc = 0; cc < 2; ++cc)
#pragma unroll
                for (int q = 0; q < 4; ++q) { const int c0 = 32 * (2 * ch + cc) + 8 * q + 4 * hi; const v2u u2 = uu[cc][q];
                    v2u o; o.x = pk2(bflo(u2.x) * (acc[cc][4 * q] + bsv), bfhi(u2.x) * (acc[cc][4 * q + 1] + bsv)); o.y = pk2(bflo(u2.y) * (acc[cc][4 * q + 2] + bsv), bfhi(u2.y) * (acc[cc][4 * q + 3] + bsv));
                    *(GAS v2u*)(MIX + (size_t)row * 1024 + g * 128 + c0) = o; }
        }
        LDS_WAIT(); __syncthreads();
        {
            v4u st[18];
#pragma unroll
            for (int i = 0; i < 18; ++i) { const int c = F.wave * 64 + lane + 512 * i; const int rr = c >> 6, c16 = c & 63, tt = rr - 15;
                st[i] = (v4u){0u, 0u, 0u, 0u}; if (c < 143 * 64 && pos0 + tt >= 0) st[i] = *(const GAS v4u*)(PROJ + (size_t)(row0 + tt) * 1536 + 1024 + c16 * 8); }
#pragma unroll
            for (int i = 0; i < 18; ++i) { const int c = F.wave * 64 + lane + 512 * i; const int rr = c >> 6, c16 = c & 63;
                if (c < 143 * 64) *(LAS v4u*)(lds + rr * 1040 + c16 * 16) = st[i]; }
        }
        LDS_WAIT(); __syncthreads();
        const int pos = pos0 + t;
#pragma unroll 1
        for (int g = 0; g < 4; ++g) { const int w = 2 << g;
            f32x16 acc[2]; acc[0] = f32x16{}; acc[1] = f32x16{};
            const int cnt = (pos + 1 < w) ? pos + 1 : w; const float rc = 1.0f / (float)cnt;
            bf16x8 af[8][2];
#pragma unroll
            for (int ks = 0; ks < 8; ++ks)
#pragma unroll
                for (int cc = 0; cc < 2; ++cc) af[ks][cc] = *(const GAS bf16x8*)(WPT + (size_t)(g * 128 + 32 * (2 * ch + cc) + r32) * 128 + 16 * ks + 8 * hi);
#pragma unroll
            for (int ks = 0; ks < 8; ++ks) {
                LAS const unsigned char* pp = lds + (t + 15) * 1040 + (g * 128 + 16 * ks + 8 * hi) * 2;
                float sum[8], own[8];
                { const v4u raw = *(const LAS v4u*)pp; own[0] = bflo(raw.x); own[1] = bfhi(raw.x); own[2] = bflo(raw.y); own[3] = bfhi(raw.y); own[4] = bflo(raw.z); own[5] = bfhi(raw.z); own[6] = bflo(raw.w); own[7] = bfhi(raw.w); }
#pragma unroll
                for (int j = 0; j < 8; ++j) sum[j] = own[j];
#pragma unroll 2
                for (int j2 = 1; j2 < w; ++j2) { const v4u raw = *(const LAS v4u*)(pp - j2 * 1040);
                    sum[0] += bflo(raw.x); sum[1] += bfhi(raw.x); sum[2] += bflo(raw.y); sum[3] += bfhi(raw.y); sum[4] += bflo(raw.z); sum[5] += bfhi(raw.z); sum[6] += bflo(raw.w); sum[7] += bfhi(raw.w); }
                v4u pk; pk.x = pk2(sum[0] * rc - own[0], sum[1] * rc - own[1]); pk.y = pk2(sum[2] * rc - own[2], sum[3] * rc - own[3]); pk.z = pk2(sum[4] * rc - own[4], sum[5] * rc - own[5]); pk.w = pk2(sum[6] * rc - own[6], sum[7] * rc - own[7]);
                const bf16x8 bfrag = __builtin_bit_cast(bf16x8, pk);
#pragma unroll
                for (int cc = 0; cc < 2; ++cc) acc[cc] = __builtin_amdgcn_mfma_f32_32x32x16_bf16(af[ks][cc], bfrag, acc[cc], 0, 0, 0); }
#pragma unroll
            for (int cc = 0; cc < 2; ++cc)
#pragma unroll
                for (int q = 0; q < 4; ++q) { const int d0 = 32 * (2 * ch + cc) + 8 * q + 4 * hi; const f32x4 lq = *(const GAS f32x4*)(ls + g * 128 + d0);
                    v2u o; o.x = pk2(acc[cc][4 * q] * lq.x, acc[cc][4 * q + 1] * lq.y); o.y = pk2(acc[cc][4 * q + 2] * lq.z, acc[cc][4 * q + 3] * lq.w);
                    *(GAS v2u*)(MIX + (size_t)row * 1024 + 512 + g * 128 + d0) = o; }
        }
        LDS_WAIT(); __syncthreads();
    }
}

__device__ __forceinline__ void combine_phase(Frame& F, const KA& A, int o, float lam_init) {
    const int gw = F.vcu * NWAVES + F.wave, NGW = F.G * NWAVES, lane = mk_lane();
    const float s1 = wave_sum(A.in(15)[o * 64 + lane] * A.in(16)[o * 64 + lane]), s2 = wave_sum(A.in(17)[o * 64 + lane] * A.in(18)[o * 64 + lane]);
    const float lam = __expf(s1) - __expf(s2) + lam_init, post = 1.0f - lam_init;
    const int h = lane >> 3, dv0 = (lane & 7) * 16;
    float gs[16];
#pragma unroll
    for (int j = 0; j < 16; ++j) gs[j] = A.in(19)[o * 128 + dv0 + j] * post;
    bf16* OATT = (bf16*)(F.ws + WS_HB);
    for (int m = gw; m < M; m += NGW) {
        bf16* rowp = OATT + (size_t)m * 2048;
        const v4u a0 = *(const GAS v4u*)(rowp + (2 * h) * 128 + dv0), a1 = *(const GAS v4u*)(rowp + (2 * h) * 128 + dv0 + 8);
        const v4u b0 = *(const GAS v4u*)(rowp + (2 * h + 1) * 128 + dv0), b1 = *(const GAS v4u*)(rowp + (2 * h + 1) * 128 + dv0 + 8);
        const unsigned aw[8] = {a0.x, a0.y, a0.z, a0.w, a1.x, a1.y, a1.z, a1.w}, bw[8] = {b0.x, b0.y, b0.z, b0.w, b1.x, b1.y, b1.z, b1.w};
        float ov[16]; float q = 0.f;
#pragma unroll
        for (int j = 0; j < 8; ++j) { ov[2 * j] = bflo(aw[j]) - lam * bflo(bw[j]); ov[2 * j + 1] = bfhi(aw[j]) - lam * bfhi(bw[j]); q += ov[2 * j] * ov[2 * j] + ov[2 * j + 1] * ov[2 * j + 1]; }
        q += lshfl(q, lane ^ 1); q += lshfl(q, lane ^ 2); q += lshfl(q, lane ^ 4);
        const float rstd = 1.0f / sqrtf(q * (1.0f / 128.0f) + RMS_EPS);
        v4u o0, o1;
        o0.x = pk2(ov[0] * rstd * gs[0], ov[1] * rstd * gs[1]); o0.y = pk2(ov[2] * rstd * gs[2], ov[3] * rstd * gs[3]); o0.z = pk2(ov[4] * rstd * gs[4], ov[5] * rstd * gs[5]); o0.w = pk2(ov[6] * rstd * gs[6], ov[7] * rstd * gs[7]);
        o1.x = pk2(ov[8] * rstd * gs[8], ov[9] * rstd * gs[9]); o1.y = pk2(ov[10] * rstd * gs[10], ov[11] * rstd * gs[11]); o1.z = pk2(ov[12] * rstd * gs[12], ov[13] * rstd * gs[13]); o1.w = pk2(ov[14] * rstd * gs[14], ov[15] * rstd * gs[15]);
        asm volatile("" ::: "memory");
        *(GAS v4u*)(rowp + h * 128 + dv0) = o0; *(GAS v4u*)(rowp + h * 128 + dv0 + 8) = o1;
    }
}
__device__ __forceinline__ float med3f(float a, float b, float c) { return __builtin_amdgcn_fmed3f(a, b, c); }
#define INS16(L, x) do { _Pragma("unroll") for (int i_ = 15; i_ >= 1; --i_) L[i_] = med3f(L[i_ - 1], L[i_], (x)); L[0] = __builtin_fmaxf(L[0], (x)); } while (0)
__device__ __forceinline__ void topk128_sorted(const bf16x8 (&bq)[8], LAS const unsigned char* skl, int hi, int r32, float (&S)[16]) {
    f32x16 acc[4]; acc[0] = f32x16{}; acc[1] = f32x16{}; acc[2] = f32x16{}; acc[3] = f32x16{};
    LAS const unsigned char* sp = skl + r32 * 272 + 16 * hi;
#pragma unroll
    for (int kc = 0; kc < 8; ++kc) {
#pragma unroll
        for (int kt = 0; kt < 4; ++kt) { const bf16x8 a = *(const LAS bf16x8*)(sp + kt * 32 * 272 + 32 * kc);
            acc[kt] = __builtin_amdgcn_mfma_f32_32x32x16_bf16(a, bq[kc], acc[kt], 0, 0, 0); } }
    const unsigned hi4 = 4u * (unsigned)hi;
    float G[4][16];
#pragma unroll
    for (int kt = 0; kt < 4; ++kt) {
#pragma unroll
        for (int r = 0; r < 16; ++r) { const unsigned n = (unsigned)(32 * kt + (r & 3) + 8 * (r >> 2)) | hi4; G[kt][r] = asf((asu(acc[kt][r]) & ~127u) | n); }
#define CE(i, j) do { const float a_ = G[kt][i], b_ = G[kt][j]; G[kt][i] = __builtin_fmaxf(a_, b_); G[kt][j] = __builtin_fminf(a_, b_); } while (0);
        CE(0,1) CE(2,3) CE(0,2) CE(1,3) CE(1,2) CE(4,5) CE(6,7) CE(4,6) CE(5,7) CE(5,6) CE(0,4) CE(2,6) CE(2,4) CE(1,5) CE(3,7) CE(3,5) CE(1,2) CE(3,4) CE(5,6) CE(8,9) CE(10,11) CE(8,10) CE(9,11) CE(9,10) CE(12,13) CE(14,15) CE(12,14) CE(13,15) CE(13,14) CE(8,12) CE(10,14) CE(10,12) CE(9,13) CE(11,15) CE(11,13) CE(9,10) CE(11,12) CE(13,14) CE(0,8) CE(4,12) CE(4,8) CE(2,10) CE(6,14) CE(6,10) CE(2,4) CE(6,8) CE(10,12) CE(1,9) CE(5,13) CE(5,9) CE(3,11) CE(7,15) CE(7,11) CE(3,5) CE(7,9) CE(11,13) CE(1,2) CE(3,4) CE(5,6) CE(7,8) CE(9,10) CE(11,12) CE(13,14)
#undef CE
    }
#define MERGE16(X, Y, O) do { _Pragma("unroll") for (int i_ = 0; i_ < 16; ++i_) O[i_] = __builtin_fmaxf(X[i_], Y[15 - i_]); \
        _Pragma("unroll") for (int st_ = 8; st_ >= 1; st_ >>= 1) _Pragma("unroll") for (int i_ = 0; i_ < 16; ++i_) if (!(i_ & st_)) { const float a_ = O[i_], b_ = O[i_ + st_]; O[i_] = __builtin_fmaxf(a_, b_); O[i_ + st_] = __builtin_fminf(a_, b_); } } while (0)
    float MA[16], MB[16], L[16];
    MERGE16(G[0], G[1], MA); MERGE16(G[2], G[3], MB); MERGE16(MA, MB, L);
#undef MERGE16
#pragma unroll
    for (int i = 0; i < 8; ++i) { const int j = 15 - i;
        auto ri = __builtin_amdgcn_permlane32_swap(asu(L[i]), asu(L[i]), false, false); auto rj = __builtin_amdgcn_permlane32_swap(asu(L[j]), asu(L[j]), false, false);
        S[i] = __builtin_fmaxf(asf(ri[0]), asf(rj[1])); S[j] = __builtin_fmaxf(asf(rj[0]), asf(ri[1])); }
#pragma unroll
    for (int st = 8; st >= 1; st >>= 1)
#pragma unroll
        for (int i = 0; i < 16; ++i) if (!(i & st)) { const float a = S[i], b = S[i + st]; S[i] = __builtin_fmaxf(a, b); S[i + st] = __builtin_fminf(a, b); }
}
__device__ __forceinline__ void topk_phase(Frame& F, int l) {
    const int gw = F.vcu * NWAVES + F.wave, NGW = F.G * NWAVES, lane = mk_lane(), r32 = lane & 31, hi = lane >> 5;
    const bf16* QP = (const bf16*)(F.ws + WS_PROJ); const bf16* SUBK = (const bf16*)(F.ws + WS_SUBK) + (size_t)l * 8 * 2 * 128 * 128;
    unsigned short* EIDX = (unsigned short*)(F.ws + WS_EIDX); float* GATE = (float*)(F.ws + WS_GATE);
    LAS unsigned char* myl = F.lds + F.wave * 2048 + lane * 32;
    LAS unsigned char* skl = F.lds + 16384;
    const int wpg = (F.G >= 8 && F.G % 8 == 0) ? F.G / 8 : 0;
    const int h_fix = wpg ? F.vcu / wpg : 0;
    if (wpg) { const bf16* sk = SUBK + (size_t)h_fix * 2 * 128 * 128;
#pragma unroll
        for (int j = 0; j < 8; ++j) { const int c = F.wave * 64 + lane + 512 * j, pp = c >> 11, row = (c >> 4) & 127, c16 = c & 15;
            *(LAS v4u*)(skl + pp * 34816 + row * 272 + c16 * 16) = *(const GAS v4u*)(sk + (size_t)pp * 128 * 128 + row * 128 + c16 * 8); }
        LDS_WAIT(); __syncthreads(); }
    const int it0 = wpg ? (F.vcu % wpg) * NWAVES + F.wave : gw, itstep = wpg ? wpg * NWAVES : NGW, itend = wpg ? M / 32 : 8 * (M / 32);
    for (int item = it0; item < itend; item += itstep) {
        const int h = wpg ? h_fix : item / (M / 32), tg = wpg ? item : item % (M / 32), tok = tg * 32 + r32;
        bf16x8 bq0[8], bq1[8]; const bf16* qp = QP + (size_t)tok * 2048 + h * 256 + 8 * hi;
#pragma unroll
        for (int kc = 0; kc < 8; ++kc) bq0[kc] = *(const GAS bf16x8*)(qp + 16 * kc);
        if (!wpg) { __syncthreads();
            const bf16* sk = SUBK + (size_t)h * 2 * 128 * 128;
#pragma unroll
            for (int j = 0; j < 8; ++j) { const int c = F.wave * 64 + lane + 512 * j, pp = c >> 11, row = (c >> 4) & 127, c16 = c & 15;
                *(LAS v4u*)(skl + pp * 34816 + row * 272 + c16 * 16) = *(const GAS v4u*)(sk + (size_t)pp * 128 * 128 + row * 128 + c16 * 8); }
            LDS_WAIT(); __syncthreads(); }
        float S0[16], S1[16];
        topk128_sorted(bq0, skl, hi, r32, S0);
#pragma unroll
        for (int kc = 0; kc < 8; ++kc) bq1[kc] = *(const GAS bf16x8*)(qp + 128 + 16 * kc);
        topk128_sorted(bq1, skl + 34816, hi, r32, S1);
        float T[16];
#pragma unroll
        for (int i = 0; i < 16; ++i) T[i] = -3.0e38f;
#pragma unroll
        for (int i = 0; i < 16; ++i)
#pragma unroll
            for (int j = 0; j < 16; ++j) if ((i + 1) * (j + 1) <= 16) { const float s = S0[i] + S1[j]; const float key = asf((asu(s) & ~255u) | (unsigned)(i * 16 + j)); INS16(T, key); }
#pragma unroll
        for (int i = 0; i < 16; ++i) { myl[i] = (unsigned char)(asu(S0[i]) & 127u); myl[16 + i] = (unsigned char)(asu(S1[i]) & 127u); }
        LDS_WAIT();
        float gt[16]; float Z = 0.f; unsigned ee[16];
#pragma unroll
        for (int k = 0; k < 16; ++k) { gt[k] = __expf(T[k] - T[0]); Z += gt[k];
            const unsigned pos = asu(T[k]) & 255u; const unsigned n0 = myl[pos >> 4], n1 = myl[16 + (pos & 15u)]; ee[k] = n0 * 128u + n1; }
        const float rz = 1.0f / Z;
        LDS_WAIT();
        if (hi == 0) {
            GAS v4u* ep = (GAS v4u*)(EIDX + (size_t)tok * 128 + h * 16);
            v4u e0, e1; e0.x = ee[0] | (ee[1] << 16); e0.y = ee[2] | (ee[3] << 16); e0.z = ee[4] | (ee[5] << 16); e0.w = ee[6] | (ee[7] << 16);
            e1.x = ee[8] | (ee[9] << 16); e1.y = ee[10] | (ee[11] << 16); e1.z = ee[12] | (ee[13] << 16); e1.w = ee[14] | (ee[15] << 16);
            ep[0] = e0; ep[1] = e1;
            GAS f32x4* gp = (GAS f32x4*)(GATE + (size_t)tok * 128 + h * 16);
            gp[0] = (f32x4){gt[0] * rz, gt[1] * rz, gt[2] * rz, gt[3] * rz}; gp[1] = (f32x4){gt[4] * rz, gt[5] * rz, gt[6] * rz, gt[7] * rz};
            gp[2] = (f32x4){gt[8] * rz, gt[9] * rz, gt[10] * rz, gt[11] * rz}; gp[3] = (f32x4){gt[12] * rz, gt[13] * rz, gt[14] * rz, gt[15] * rz};
        }
    }
}

__device__ __forceinline__ float gelu1(float v) { const f32x2 r = pg8::gelu_pk((f32x2){v, v}); return r.x; }
#ifndef PEER_SSH
#define PEER_SSH 11
#endif
#define PEER_SMASK ((16384u >> PEER_SSH) - 1u)
constexpr int PEER_WLDS = 17424, PEER_N = 512;
constexpr int PEER_O_SU = 1024, PEER_O_GS = 3072, PEER_O_HQ = 5120, PEER_O_ACC = 9216;
static_assert(8 * PEER_WLDS <= PEER_LDS_LIMIT, "gather LDS map");
template <int VAR>
__device__ __forceinline__ void gather_phase(Frame& F, int l, const float* ngain, const float* gain2, float* nout, const XcdBarrier& gbar, bool dry = false) {
    const int lane = mk_lane();
#ifdef PROBE_HOT
    const unsigned emask = dry ? 0xffu : 0x3fffu;
#else
    const unsigned emask = 0x3fffu;
#endif
    const unsigned char* U8 = F.ws + WS_UV + (size_t)l * 16384 * PEER_REC; const unsigned char* V8 = U8 + 512;
    const float* SU = (const float*)(F.ws + WS_SU) + (size_t)l * 16384; const float* SV = (const float*)(F.ws + WS_SV) + (size_t)l * 16384;
    const bf16* HB = (const bf16*)(F.ws + WS_HB); bf16* XRES = (bf16*)(F.ws + WS_XRES); const bf16* XS = (const bf16*)(F.ws + WS_XS); const float* SSQ = (const float*)(F.ws + WS_SSQ);
    const float* sh2 = (const float*)(F.ws + WS_MOD) + (size_t)l * 8 * 6144 + 3 * 1024;
    const unsigned short* EIDX = (const unsigned short*)(F.ws + WS_EIDX); const float* GATE = (const float*)(F.ws + WS_GATE);
    const float* g2 = (const float*)(F.ws + WS_MOD) + (size_t)l * 8 * 6144 + 5 * 1024;
    LAS unsigned char* wl = F.lds + F.wave * PEER_WLDS;
    LAS unsigned short* elist = (LAS unsigned short*)wl; LAS float* sul = (LAS float*)(wl + PEER_O_SU); LAS float* gsl = (LAS float*)(wl + PEER_O_GS);
    LAS unsigned char* hql = wl + PEER_O_HQ; LAS unsigned char* accl = wl + PEER_O_ACC; LAS unsigned* cnt = (LAS unsigned*)(wl + PEER_O_ACC);
#ifdef PEER_ROTX
    const unsigned srot = 2u * xb_xcc_id();
#else
    const unsigned srot = 0u;
#endif
    unsigned ev0[4], ev1[4]; float gt0[4], gt1[4]; v4u ha[4], hb[4]; float ssq1;
    auto BPRE = [&](int t0) __attribute__((always_inline)) {
        ssq1 = SSQ[(size_t)(t0 + (lane >> 4)) * 16 + (lane & 15)];
#pragma unroll
        for (int tk = 0; tk < 4; ++tk) { const size_t tok = (size_t)(t0 + tk);
            ev0[tk] = EIDX[tok * 128 + lane]; ev1[tk] = EIDX[tok * 128 + 64 + lane]; gt0[tk] = GATE[tok * 128 + lane]; gt1[tk] = GATE[tok * 128 + 64 + lane];
            ha[tk] = *(const GAS v4u*)(XS + tok * 1024 + lane * 16); hb[tk] = *(const GAS v4u*)(XS + tok * 1024 + lane * 16 + 8); } };
    if (F.vcu < M / 32) BPRE(F.vcu * 32 + F.wave * 4);
    for (int blk = F.vcu; blk < M / 32; blk += F.G) {
        const int tok0 = blk * 32 + F.wave * 4;
#pragma unroll
        for (int j = 0; j < 4; ++j) cnt[64 * j + lane] = 0u;
        float fa0[4], fa1[4], fb0[4], fb1[4]; int rk0[4], rk1[4];
        {
            float su0[4], su1[4], sv0[4], sv1[4];
#pragma unroll
            for (int tk = 0; tk < 4; ++tk) { su0[tk] = SU[ev0[tk]]; su1[tk] = SU[ev1[tk]]; sv0[tk] = SV[ev0[tk]]; sv1[tk] = SV[ev1[tk]]; }
            f32x4 s4[4]; { const float* shp = sh2 + (size_t)(tok0 >> 12) * 6144 + lane * 16;
#pragma unroll
                for (int j = 0; j < 4; ++j) s4[j] = *(const GAS f32x4*)(shp + 4 * j); }
            float sqs = ssq1; sqs += lshfl(sqs, lane ^ 1); sqs += lshfl(sqs, lane ^ 2); sqs += lshfl(sqs, lane ^ 4); sqs += lshfl(sqs, lane ^ 8);
            float hv[4][16], am[4], sc[4];
#pragma unroll
            for (int tk = 0; tk < 4; ++tk) { const unsigned hw[8] = {ha[tk].x, ha[tk].y, ha[tk].z, ha[tk].w, hb[tk].x, hb[tk].y, hb[tk].z, hb[tk].w};
                const float sq = asf((unsigned)__builtin_amdgcn_readlane((int)asu(sqs), 16 * tk));
                const float rs2 = 1.0f / sqrtf(sq * (1.0f / 1024.0f) + RMS_EPS);
                float m = 0.f;
#pragma unroll
                for (int j = 0; j < 4; ++j) { hv[tk][4 * j] = bflo(hw[2 * j]) * rs2 + s4[j].x; hv[tk][4 * j + 1] = bfhi(hw[2 * j]) * rs2 + s4[j].y; hv[tk][4 * j + 2] = bflo(hw[2 * j + 1]) * rs2 + s4[j].z; hv[tk][4 * j + 3] = bfhi(hw[2 * j + 1]) * rs2 + s4[j].w; }
#pragma unroll
                for (int j = 0; j < 16; ++j) m = __builtin_fmaxf(m, __builtin_fabsf(hv[tk][j]));
                am[tk] = m; }
#pragma unroll
            for (int o = 1; o < 64; o <<= 1) {
#pragma unroll
                for (int tk = 0; tk < 4; ++tk) am[tk] = __builtin_fmaxf(am[tk], lshfl(am[tk], lane ^ o)); }
#pragma unroll
            for (int tk = 0; tk < 4; ++tk) { sc[tk] = am[tk] > 0.f ? am[tk] * (1.0f / 448.0f) : 1.0f; const float inv = 1.0f / sc[tk];
                int qd[4];
#pragma unroll
                for (int g = 0; g < 4; ++g) { int pk = 0; pk = __builtin_amdgcn_cvt_pk_fp8_f32(hv[tk][4 * g] * inv, hv[tk][4 * g + 1] * inv, pk, false); pk = __builtin_amdgcn_cvt_pk_fp8_f32(hv[tk][4 * g + 2] * inv, hv[tk][4 * g + 3] * inv, pk, true); qd[g] = pk; }
                *(LAS v4i*)(hql + tk * 1024 + lane * 16) = (v4i){qd[0], qd[1], qd[2], qd[3]}; }
#pragma unroll
            for (int tk = 0; tk < 4; ++tk) {
                fa0[tk] = su0[tk] * sc[tk]; fa1[tk] = su1[tk] * sc[tk]; fb0[tk] = gt0[tk] * sv0[tk]; fb1[tk] = gt1[tk] * sv1[tk];
                rk0[tk] = (int)__hip_atomic_fetch_add(cnt + ((((ev0[tk] >> PEER_SSH) + srot) & PEER_SMASK) * 4 + tk), 1u, __ATOMIC_RELAXED, __HIP_MEMORY_SCOPE_WORKGROUP);
                rk1[tk] = (int)__hip_atomic_fetch_add(cnt + ((((ev1[tk] >> PEER_SSH) + srot) & PEER_SMASK) * 4 + tk), 1u, __ATOMIC_RELAXED, __HIP_MEMORY_SCOPE_WORKGROUP); } }
        LDS_WAIT();
        { int inc[4], mine[4];
#pragma unroll
            for (int j = 0; j < 4; ++j) { inc[j] = (int)cnt[64 * j + lane]; mine[j] = inc[j]; }
#pragma unroll
            for (int o = 1; o < 64; o <<= 1) {
#pragma unroll
                for (int j = 0; j < 4; ++j) { const int t = lshfl(inc[j], lane - o); inc[j] += (lane >= o) ? t : 0; } }
            int base = 0; LDS_WAIT();
#pragma unroll
            for (int j = 0; j < 4; ++j) { cnt[64 * j + lane] = (unsigned)(base + inc[j] - mine[j]); base += __builtin_amdgcn_readlane(inc[j], 63); } }
        LDS_WAIT();
#pragma unroll
        for (int tk = 0; tk < 4; ++tk) { const int p0 = (int)cnt[(((ev0[tk] >> PEER_SSH) + srot) & PEER_SMASK) * 4 + tk] + rk0[tk], p1 = (int)cnt[(((ev1[tk] >> PEER_SSH) + srot) & PEER_SMASK) * 4 + tk] + rk1[tk];
            elist[p0] = (unsigned short)(ev0[tk] | ((unsigned)tk << 14)); elist[p1] = (unsigned short)(ev1[tk] | ((unsigned)tk << 14));
            sul[p0] = fa0[tk]; sul[p1] = fa1[tk]; gsl[p0] = fb0[tk]; gsl[p1] = fb1[tk]; }
        LDS_WAIT();
#pragma unroll
        for (int tk = 0; tk < 4; ++tk) { *(LAS v4u*)(accl + tk * 2048 + lane * 32) = (v4u){0u, 0u, 0u, 0u}; *(LAS v4u*)(accl + tk * 2048 + lane * 32 + 16) = (v4u){0u, 0u, 0u, 0u}; }
        LDS_WAIT();
        float acc[16]; float csum = 0.f; int cur = -1;
#pragma unroll
        for (int j = 0; j < 16; ++j) acc[j] = 0.f;
        v8i Af[8];
#pragma unroll
        for (int s = 0; s < 8; ++s) { const v4i lo = *(const LAS v4i*)(hql + (lane & 3) * 1024 + 128 * s + 16 * (lane >> 4)), hi4 = *(const LAS v4i*)(hql + (lane & 3) * 1024 + 128 * s + 64 + 16 * (lane >> 4));
            Af[s] = (v8i){lo.x, lo.y, lo.z, lo.w, hi4.x, hi4.y, hi4.z, hi4.w}; }
        LDS_WAIT();
#pragma unroll 1
        for (int b = 0; b < PEER_N / 16; ++b) {
            const unsigned EV = elist[16 * b + (lane & 15)];
            v4u RU[8]; v2u RV[16];
            { const unsigned char* up = U8 + (size_t)((EV & emask) * (unsigned)PEER_REC) + (unsigned)(lane >> 4) * 16u;
#pragma unroll
                for (int s = 0; s < 8; ++s) { if (VAR == 4) RU[s] = (v4u){EV, EV, EV, EV}; else RU[s] = *(const GAS v4u*)(up + 64 * s); } }
#pragma unroll
            for (int k = 0; k < 16; ++k) { const unsigned eb = ((unsigned)__builtin_amdgcn_readlane((int)EV, k) & emask) * (unsigned)PEER_REC; if (VAR == 4) RV[k] = (v2u){eb, eb}; else RV[k] = *(const GAS v2u*)(V8 + eb + (unsigned)lane * 8u); }
            asm volatile("" ::: "memory");
            f32x4 D = (f32x4){0.f, 0.f, 0.f, 0.f};
            if (VAR == 2) D = (f32x4){asf(RU[0].x), asf(RU[1].x), asf(RU[2].x), asf(RU[3].x)}; else {
#pragma unroll
                for (int s = 0; s < 8; ++s) D = __builtin_amdgcn_mfma_scale_f32_16x16x128_f8f6f4(Af[s], (v8i){(int)RU[s].x, (int)RU[s].y, (int)RU[s].z, (int)RU[s].w, 0, 0, 0, 0}, D, 0, 4, 0, 0, 0, 0); }
            const unsigned tkn = EV >> 14; const float z = tkn == 0u ? D[0] : tkn == 1u ? D[1] : tkn == 2u ? D[2] : D[3];
            const int pi = 16 * b + (lane & 15);
            const float wgt = gsl[pi] * gelu1(z * sul[pi]);
#pragma unroll
            for (int k = 0; k < 16; ++k) { const int tk = (int)((unsigned)__builtin_amdgcn_readlane((int)EV, k) >> 14);
                if (VAR != 1 && tk != cur) {
                    if (cur >= 0) { const float corr = 0.f; v4u o0, o1;
                        o0.x = pk2(acc[0] - corr, acc[1] - corr); o0.y = pk2(acc[2] - corr, acc[3] - corr); o0.z = pk2(acc[4] - corr, acc[5] - corr); o0.w = pk2(acc[6] - corr, acc[7] - corr);
                        o1.x = pk2(acc[8] - corr, acc[9] - corr); o1.y = pk2(acc[10] - corr, acc[11] - corr); o1.z = pk2(acc[12] - corr, acc[13] - corr); o1.w = pk2(acc[14] - corr, acc[15] - corr);
                        *(LAS v4u*)(accl + cur * 2048 + lane * 32) = o0; *(LAS v4u*)(accl + cur * 2048 + lane * 32 + 16) = o1; }
                    const v4u i0 = *(const LAS v4u*)(accl + tk * 2048 + lane * 32), i1 = *(const LAS v4u*)(accl + tk * 2048 + lane * 32 + 16);
                    acc[0] = bflo(i0.x); acc[1] = bfhi(i0.x); acc[2] = bflo(i0.y); acc[3] = bfhi(i0.y); acc[4] = bflo(i0.z); acc[5] = bfhi(i0.z); acc[6] = bflo(i0.w); acc[7] = bfhi(i0.w);
                    acc[8] = bflo(i1.x); acc[9] = bfhi(i1.x); acc[10] = bflo(i1.y); acc[11] = bfhi(i1.y); acc[12] = bflo(i1.z); acc[13] = bfhi(i1.z); acc[14] = bflo(i1.w); acc[15] = bfhi(i1.w);
                    csum = 0.f; cur = tk; }
                const float wk = asf((unsigned)__builtin_amdgcn_readlane((int)asu(wgt), k)); const unsigned rw[2] = {RV[k].x, RV[k].y};
                if (VAR == 3) { acc[k & 15] += wk * asf(rw[0] ^ rw[1]); continue; }
#pragma unroll
                for (int d = 0; d < 2; ++d) {
                    const f32x2 p0 = __builtin_amdgcn_cvt_scalef32_pk_f32_fp4(rw[d], 1.0f, 0), p1 = __builtin_amdgcn_cvt_scalef32_pk_f32_fp4(rw[d], 1.0f, 1),
                                p2 = __builtin_amdgcn_cvt_scalef32_pk_f32_fp4(rw[d], 1.0f, 2), p3 = __builtin_amdgcn_cvt_scalef32_pk_f32_fp4(rw[d], 1.0f, 3);
                    acc[8 * d] += wk * p0.x; acc[8 * d + 1] += wk * p0.y; acc[8 * d + 2] += wk * p1.x; acc[8 * d + 3] += wk * p1.y;
                    acc[8 * d + 4] += wk * p2.x; acc[8 * d + 5] += wk * p2.y; acc[8 * d + 6] += wk * p3.x; acc[8 * d + 7] += wk * p3.y; } }
#ifdef PEER_SYNC
            if ((b & (PEER_SYNC - 1)) == PEER_SYNC - 1) __builtin_amdgcn_s_barrier();
#endif
        }
        { const float corr = 0.f; v4u o0, o1;
            o0.x = pk2(acc[0] - corr, acc[1] - corr); o0.y = pk2(acc[2] - corr, acc[3] - corr); o0.z = pk2(acc[4] - corr, acc[5] - corr); o0.w = pk2(acc[6] - corr, acc[7] - corr);
            o1.x = pk2(acc[8] - corr, acc[9] - corr); o1.y = pk2(acc[10] - corr, acc[11] - corr); o1.z = pk2(acc[12] - corr, acc[13] - corr); o1.w = pk2(acc[14] - corr, acc[15] - corr);
            *(LAS v4u*)(accl + cur * 2048 + lane * 32) = o0; *(LAS v4u*)(accl + cur * 2048 + lane * 32 + 16) = o1; }
        LDS_WAIT();
        {
            const int bb = tok0 >> 12; const float* gp = g2 + (size_t)bb * 6144 + lane * 16;
            f32x4 xn[4][4], gq[4]; float s2[4], rstd[4];
#pragma unroll
            for (int tk = 0; tk < 4; ++tk)
#pragma unroll
                for (int q = 0; q < 2; ++q) { const v4u r = *(const GAS v4u*)(XS + (size_t)(tok0 + tk) * 1024 + lane * 16 + q * 8);
                    xn[tk][2 * q] = (f32x4){bflo(r.x), bfhi(r.x), bflo(r.y), bfhi(r.y)}; xn[tk][2 * q + 1] = (f32x4){bflo(r.z), bfhi(r.z), bflo(r.w), bfhi(r.w)}; }
            f32x4 igs[4];
#pragma unroll
            for (int q = 0; q < 4; ++q) { gq[q] = *(const GAS f32x4*)(gp + q * 4);
                const f32x4 gsv = *(const GAS f32x4*)(gain2 + lane * 16 + q * 4) * (*(const GAS f32x4*)(gp - 1024 + q * 4) + 1.0f);
                igs[q] = (f32x4){1.0f / gsv.x, 1.0f / gsv.y, 1.0f / gsv.z, 1.0f / gsv.w}; }
            if (blk + F.G < M / 32) BPRE((blk + F.G) * 32 + F.wave * 4);
#pragma unroll
            for (int tk = 0; tk < 4; ++tk) {
                const v4u i0 = *(const LAS v4u*)(accl + tk * 2048 + lane * 32), i1 = *(const LAS v4u*)(accl + tk * 2048 + lane * 32 + 16);
                const unsigned iw[8] = {i0.x, i0.y, i0.z, i0.w, i1.x, i1.y, i1.z, i1.w}; float s = 0.f;
#pragma unroll
                for (int q = 0; q < 4; ++q) { const f32x4 o = (f32x4){bflo(iw[2 * q]), bfhi(iw[2 * q]), bflo(iw[2 * q + 1]), bfhi(iw[2 * q + 1])};
                    const f32x4 t = xn[tk][q] * igs[q] + gq[q] * o; xn[tk][q] = t; s += (t.x * t.x + t.y * t.y) + (t.z * t.z + t.w * t.w); }
                s2[tk] = s; }
#pragma unroll
            for (int o = 1; o < 64; o <<= 1) {
#pragma unroll
                for (int tk = 0; tk < 4; ++tk) s2[tk] += lshfl(s2[tk], lane ^ o); }
#pragma unroll
            for (int tk = 0; tk < 4; ++tk) rstd[tk] = 1.0f / sqrtf(s2[tk] * (1.0f / 1024.0f) + RMS_EPS);
            if (dry) {
#pragma unroll
                for (int tk = 0; tk < 4; ++tk)
#pragma unroll
                    for (int q = 0; q < 4; ++q) *(GAS f32x4*)((float*)(F.ws + WS_PROJ) + (size_t)(tok0 + tk) * 1024 + lane * 16 + q * 4) = xn[tk][q] * rstd[tk];
            } else if (l == DEPTH - 1) {
#pragma unroll
                for (int q = 0; q < 4; ++q) { const f32x4 gn = *(const GAS f32x4*)(ngain + lane * 16 + q * 4);
#pragma unroll
                    for (int tk = 0; tk < 4; ++tk) *(GAS f32x4*)(nout + (size_t)(tok0 + tk) * 1024 + lane * 16 + q * 4) = xn[tk][q] * rstd[tk] * gn; }
            } else {
                const float* nsh = (const float*)(F.ws + WS_MOD) + (size_t)(l + 1) * 8 * 6144 + (size_t)bb * 6144 + lane * 16; const bool f8n = ((l + 1) & 1) ? (FP8_ODD != 0) : (FP8_EVEN != 0);
                f32x4 gm[4], sa[4];
#pragma unroll
                for (int q = 0; q < 4; ++q) { const f32x4 gn = *(const GAS f32x4*)(ngain + lane * 16 + q * 4), c = *(const GAS f32x4*)(nsh + 1024 + q * 4); sa[q] = *(const GAS f32x4*)(nsh + q * 4); gm[q] = gn * (c + 1.0f); }
#pragma unroll
                for (int tk = 0; tk < 4; ++tk) { bf16* xr = XRES + (size_t)(tok0 + tk) * 1024 + lane * 16; unsigned xw[8];
#pragma unroll
                    for (int q = 0; q < 4; ++q) { xw[2 * q] = pk2(xn[tk][q].x, xn[tk][q].y); xw[2 * q + 1] = pk2(xn[tk][q].z, xn[tk][q].w); }
                    *(GAS v4u*)xr = (v4u){xw[0], xw[1], xw[2], xw[3]}; *(GAS v4u*)(xr + 8) = (v4u){xw[4], xw[5], xw[6], xw[7]};
                    if (FP8_EVEN && FP8_ODD) { unsigned hw[4];
#pragma unroll
                        for (int q = 0; q < 4; ++q) { const f32x4 hh = xn[tk][q] * rstd[tk] * gm[q] + sa[q]; hw[q] = pk4_fp8x8(hh.x, hh.y, hh.z, hh.w); }
                        *(GAS v4u*)((unsigned char*)HB + (size_t)(tok0 + tk) * 1024 + lane * 16) = (v4u){hw[0], hw[1], hw[2], hw[3]};
                    } else { unsigned char* hp = (unsigned char*)HB + (size_t)(tok0 + tk) * (f8n ? 1024 : 2048) + lane * (f8n ? 16 : 32);
#pragma unroll
                        for (int hf = 0; hf < 2; ++hf) { unsigned hw[4];
#pragma unroll
                            for (int q = 0; q < 4; ++q) { const f32x4 hh = xn[tk][q] * rstd[tk] * gm[q] + sa[q]; hw[q] = pk4_fp8x8(hh.x, hh.y, hh.z, hh.w); }
                            if (!f8n) {
#pragma unroll
                                for (int q = 0; q < 2; ++q) { const f32x4 hh = xn[tk][2 * hf + q] * rstd[tk] * gm[2 * hf + q] + sa[2 * hf + q]; hw[2 * q] = pk2(hh.x, hh.y); hw[2 * q + 1] = pk2(hh.z, hh.w); } }
                            *(GAS v4u*)(hp + (f8n ? 0 : 16 * hf)) = (v4u){hw[0], hw[1], hw[2], hw[3]}; } } } } }
        LDS_WAIT();
#ifdef PEER_BLKSYNC
        if (blk + F.G < M / 32) xcd_barrier(gbar, F.wave * 64 + lane == 0);
#endif
    }
}
constexpr int N_PHASES = 38;
#ifndef MK_SINGLE
#define MK_SINGLE 1
#endif
__device__ __forceinline__ bool phase_empty(int p) { if (p < 1 || p > 36) return false; const int l = (p - 1) / 9, k = (p - 1) % 9; return (k == 3 && (l & 1) == 0) || (k == 0 && l > 0) || k == 5; }
__global__ void __launch_bounds__(NWAVES * 64, 2) mk_fwd(Args args) {
    extern __shared__ __attribute__((aligned(16))) unsigned char lds[];
    Frame F;
    F.lds = (LAS unsigned char*)lds;
    F.MISC = (volatile LAS unsigned*)(F.lds + MISC_OFF);
    int wave_s = __builtin_amdgcn_readfirstlane((int)(threadIdx.x >> 6));
    for (int u = MK_TID(wave_s); u < (LDS_BYTES - LDSCTL_OFF) / 4; u += NWAVES * 64) ((LAS unsigned*)(F.lds + LDSCTL_OFF))[u] = 0u;
    __syncthreads();
    const int lo = args.ph_lo, hi = args.ph_hi;
    XcdBarrier bar; bar.bar = (unsigned*)(args.ws + WS_CTL) + CW_BAR; bar.x = 0; bar.st = nullptr;
    if (hi - lo > 1) bar = xcd_barrier_post((unsigned*)(args.ws + WS_CTL) + CW_BAR, F.MISC + 8, MK_TID(wave_s) == 0);
    bool again = false;
    for (int p = lo; p < hi; ++p) {
        if (phase_empty(p) || p == 37) continue;
#ifdef PROBE_K
#ifndef PROBE_PARITY
#define PROBE_PARITY_OK(x) true
#else
#define PROBE_PARITY_OK(x) ((x) == PROBE_PARITY)
#endif
        const bool pmatch = (PROBE_K < 0) ? (p == 0) : (p >= 1 && p <= 36 && (p - 1) % 9 == PROBE_K && PROBE_PARITY_OK(((p - 1) / 9) & 1)); const bool dry = pmatch && !again;
#else
        const bool dry = false;
#endif
        KA A; A.kp = (kptr_t)__builtin_amdgcn_kernarg_segment_ptr(); asm volatile("" : "+s"(A.kp));
        { asm volatile("" : "+s"(wave_s)); F.wave = wave_s; F.lane = mk_lane(); F.tid = wave_s * 64 + F.lane;
          int G = gridDim.x, bx = blockIdx.x; asm volatile("" : "+s"(G), "+s"(bx)); F.G = G; F.bx = bx; F.vcu = (G % 8 == 0) ? (bx % 8) * (G / 8) + bx / 8 : bx; }
        unsigned char* ws = A.ws(); F.ws = ws; F.out = A.out(); F.ctl = (gu32*)(ws + WS_CTL);
        bf16* HB = (bf16*)(ws + WS_HB); bf16* MIX = (bf16*)(ws + WS_MIX); bf16* PROJ = (bf16*)(ws + WS_PROJ); bf16* XRES = (bf16*)(ws + WS_XRES);
        if (p == 0) {
#ifndef NO_P0
            p0_prologue(F, A);
#endif
        }
        else {
            const int l = (p - 1) / 9, k = (p - 1) % 9, e = l >> 1; const bool odd = l & 1;
            const float* mod = (const float*)(ws + WS_MOD) + (size_t)l * 8 * 6144;
            if (k == 0) {
#ifndef NO_NORM
                norm_phase(F, A.in(0), A.in(5) + l * 1024, mod, mod + 1024, HB);
                shw_items(F);
#endif
            }
            else if (k == 1) {
#if !defined(NO_GEMM) && !defined(NO_G1E)
                if (!odd) { pg8::Gemm g{HB, (const bf16*)(ws + WS_WINE + (size_t)e * 1536 * 1024 * (FP8_EVEN ? 1 : 2)), M, 1536, FP8_EVEN ? 512 : 1024, FP8_EVEN ? 512 : 1024}; pg8::StaticOrder S; S.init(M, 1536, F.G, F.bx);
                    pg8::EpiActTiles E{PROJ, 1536, 4}; pg8::gemm_phase<pg8::EpiActTiles, pg8::StaticOrder, true, true, FP8_EVEN != 0>(F.lds + RING_OFF, g, S, E, F.wave); }
#endif
#if !defined(NO_GEMM) && !defined(NO_G1O)
                if (odd) { pg8::Gemm g{HB, (const bf16*)(ws + WS_WINO + (size_t)e * 3072 * 1024 * (FP8_ODD ? 1 : 2)), M, 3072, FP8_ODD ? 512 : 1024, FP8_ODD ? 512 : 1024}; pg8::StaticOrder S; S.init(M, 3072, F.G, F.bx);
                    pg8::EpiRope E{PROJ, 3072, (const float*)(ws + WS_ROPE), attn_body::C2}; pg8::gemm_phase<pg8::EpiRope, pg8::StaticOrder, true, true, FP8_ODD != 0>(F.lds + RING_OFF, g, S, E, F.wave); }
#endif
            }
            else if (k == 2) {
                if (!odd) {
#ifndef NO_E2
                    e2_phase(F, A, e);
#endif
                }
                else {
#ifndef NO_ATTN
                    const attn_body::AttnTensors AT{(const attn_body::bf16*)PROJ, (const attn_body::bf16*)(PROJ + 1024), (const attn_body::bf16*)(PROJ + 2048), (attn_body::bf16*)HB};
#ifdef PROBE_AVAR
                    if (dry) attn_body::attn_phase<PROBE_AVAR>((char*)lds + RING_OFF, AT, F.vcu, F.G, F.wave); else
#endif
                    attn_body::attn_phase<0>((char*)lds + RING_OFF, AT, F.vcu, F.G, F.wave);
#endif
                }
            }
            else if (k == 3) {
#ifndef NO_COMB
                combine_phase(F, A, e, l == 1 ? 0.3555090675909693f : 0.5560582041556405f);
#endif
            }
            else if (k == 4) {
#if !defined(NO_GEMM) && !defined(NO_G2)
                pg8::Gemm g{odd ? HB : MIX, (const bf16*)(ws + (odd ? WS_WOUTO : WS_WOUTE)) + (size_t)e * 1024 * 1024, M, 1024, 1024, odd ? 2048 : 1024}; pg8::StaticOrder S; S.init(M, 1024, F.G, F.bx);
                if (l == 0) { pg8::EpiResid<true> E{A.in(0), dry ? PROJ : XRES, mod + 2048, 6144, A.in(6) + l * 1024, mod + 4096, (bf16*)(ws + WS_XS), (float*)(ws + WS_SSQ)}; pg8::gemm_phase<pg8::EpiResid<true>, pg8::StaticOrder, true, true>(F.lds + RING_OFF, g, S, E, F.wave); }
                else { pg8::EpiResid<false> E{XRES, dry ? PROJ : XRES, mod + 2048, 6144, A.in(6) + l * 1024, mod + 4096, (bf16*)(ws + WS_XS), (float*)(ws + WS_SSQ)}; pg8::gemm_phase<pg8::EpiResid<false>, pg8::StaticOrder, true, true>(F.lds + RING_OFF, g, S, E, F.wave); }
#endif
            }
            else if (k == 6) {
#if !defined(NO_GEMM) && !defined(NO_G3)
                pg8::Gemm g{(const bf16*)(ws + WS_XS), (const bf16*)(ws + WS_WQ) + (size_t)l * 2048 * 1024, M, 2048, 1024, 1024}; pg8::StaticOrder S; S.init(M, 2048, F.G, F.bx);
#ifdef PROBE_PLAIN3
                if (dry) { pg8::EpiBf16<0> E0{PROJ, 2048, nullptr, 0, 0, 1.f}; pg8::gemm_phase<pg8::EpiBf16<0>, pg8::StaticOrder, true, true>(F.lds + RING_OFF, g, S, E0, F.wave); } else
#endif
                {
                pg8::EpiScaleShift E{PROJ, 2048, (const float*)(ws + WS_SSQ), (const float*)(ws + WS_SHW) + (size_t)l * 8 * 2048, 2048, RMS_EPS}; pg8::gemm_phase<pg8::EpiScaleShift, pg8::StaticOrder, true, true>(F.lds + RING_OFF, g, S, E, F.wave);
                }
#endif
            }
            else if (k == 7) {
#ifndef NO_TOPK
                topk_phase(F, l);
#endif
            }
            else {
#ifndef NO_GATHER
#ifdef PROBE_VAR
                if (dry) gather_phase<PROBE_VAR>(F, l, l == DEPTH - 1 ? A.in(25) : A.in(5) + (l + 1) * 1024, A.in(6) + l * 1024, F.out, bar, true); else gather_phase<0>(F, l, l == DEPTH - 1 ? A.in(25) : A.in(5) + (l + 1) * 1024, A.in(6) + l * 1024, F.out, bar, false);
#else
                gather_phase<0>(F, l, l == DEPTH - 1 ? A.in(25) : A.in(5) + (l + 1) * 1024, A.in(6) + l * 1024, F.out, bar, dry);
#endif
#endif
            }
        }
#ifdef PROBE_K
        if (pmatch && !again && PROBE_K != 3) { again = true; xcd_barrier(bar, MK_TID(wave_s) == 0); --p; continue; }
        again = false;
#endif
        if (p + 1 < hi && p < 36) xcd_barrier(bar, MK_TID(wave_s) == 0);
    }
}

extern "C" void kernel_launch(void* const* d_in, const int* in_sizes, int n_in, void* d_out, int out_size, void* d_ws, size_t ws_size, hipStream_t stream) {
    static int grid = 0;
    if (grid == 0) {
        if (n_in != 26 || out_size != M * DMODEL || ws_size < WS_END) { fprintf(stderr, "kernel_launch: unexpected problem (n_in %d, out %d, ws %zu; need ws >= %zu)\n", n_in, out_size, ws_size, (size_t)WS_END); grid = -1; return; }
        int dev = 0, cus = 0, per_cu = 0;
        if (hipGetDevice(&dev) != hipSuccess || hipDeviceGetAttribute(&cus, hipDeviceAttributeMultiprocessorCount, dev) != hipSuccess) { grid = -1; return; }
        if (hipFuncSetAttribute((const void*)mk_fwd, hipFuncAttributeMaxDynamicSharedMemorySize, LDS_BYTES) != hipSuccess) { fprintf(stderr, "kernel_launch: hipFuncSetAttribute failed\n"); grid = -1; return; }
        if (hipOccupancyMaxActiveBlocksPerMultiprocessor(&per_cu, (const void*)mk_fwd, NWAVES * 64, LDS_BYTES) != hipSuccess || per_cu < 1) { fprintf(stderr, "kernel_launch: occupancy query says %d blocks per CU\n", per_cu); }
        (void)hipGetLastError();
        grid = cus;
    }
    if (grid < 0) return;
    if (hipMemsetAsync((char*)d_ws + WS_CTL, 0, CTL_ZERO_BYTES, stream) != hipSuccess) return;
    Args a{};
    for (int i = 0; i < 26; ++i) a.in[i] = (const float*)d_in[i];
    a.out = (float*)d_out; a.ws = (unsigned char*)d_ws;
#if MK_SINGLE
    a.ph_lo = 0; a.ph_hi = N_PHASES;
    hipLaunchKernelGGL(mk_fwd, dim3(grid), dim3(NWAVES * 64), LDS_BYTES, stream, a);
#else
    for (int p = 0; p < N_PHASES; ++p) {
        if (p == 37 || (p >= 1 && p <= 36 && ((((p - 1) % 9) == 3 && ((((p - 1) / 9) & 1) == 0)) || (((p - 1) % 9) == 0 && p > 9) || ((p - 1) % 9) == 5))) continue;
        a.ph_lo = p; a.ph_hi = p + 1;
        hipLaunchKernelGGL(mk_fwd, dim3(grid), dim3(NWAVES * 64), LDS_BYTES, stream, a);
    }
#endif
}
```

```cpp
#include <hip/hip_runtime.h>
__device__ __forceinline__ int mk_lane() { int l = (int)__builtin_amdgcn_mbcnt_hi(~0u, __builtin_amdgcn_mbcnt_lo(~0u, 0u)); asm volatile("" : "+v"(l)); return l; }
#define MK_TID(wave_s) ((wave_s) * 64 + mk_lane())
template <class T> __device__ __forceinline__ T lshfl(T v, int src) { return __builtin_bit_cast(T, __builtin_amdgcn_ds_bpermute(src << 2, __builtin_bit_cast(int, v))); }
#include <hip/hip_runtime.h>
#include <cstdio>
#include <cstdint>
namespace pg8 {
#define PG8_LAS __attribute__((address_space(3)))
typedef unsigned short bf16_t;
typedef short bf16x8 __attribute__((ext_vector_type(8)));
typedef float f32x4 __attribute__((ext_vector_type(4)));
typedef unsigned u32x4 __attribute__((ext_vector_type(4)));
constexpr int BM = 256, BK = 64, HALF = 128, HTB = HALF * BK * 2  , STAGE_BYTES = 8 * HTB, NXCD = 8, WGM = 8;

__host__ __device__ __forceinline__ int lds_byte(int r, int c) { const int st = (r >> 4) * 2 + (c >> 5), rr = r & 15, cc = c & 31, ob = rr * 64 + cc * 2; return st * 1024 + (ob ^ (((ob >> 9) & 1) << 5)); }
__host__ __device__ __forceinline__ void stage_rc(int b, int& R, int& C) { const int st = b / 1024, sb = b % 1024, swz = sb ^ (((sb >> 9) & 1) << 5); R = (st >> 1) * 16 + swz / 64; C = (st & 1) * 32 + (swz % 64) / 2; }
__host__ __device__ __forceinline__ int perm32(int rho) { const int n = rho >> 4, i = rho & 15; return 8 * (i >> 2) + 4 * n + (i & 3); }

struct Unit { int pm, pn; };
typedef int pg8_v4i __attribute__((ext_vector_type(4)));
typedef int pg8_v8i __attribute__((ext_vector_type(8)));
constexpr int FP8_SCALE_A = 0x7c7c7c7c, FP8_SCALE_W = 0x77777777;
struct Gemm { const bf16_t* A; const bf16_t* Bt; int M, N, K, lda; };

struct StaticOrder {
    int nM, nN, nwg, G, c;
    __host__ __device__ void init(int M, int N, int G_, int c_) { nM = M / BM; nN = N / BM; nwg = nM * nN; G = G_; c = c_; }
    __host__ __device__ bool next(int i, Unit& u) const {
        const long L = (long)i * G + c; if (L >= nwg) return false;
        int wgid = (int)L; { const int q = nwg / NXCD, r = nwg % NXCD, xcd = wgid % NXCD, off = wgid / NXCD; wgid = (xcd < r ? xcd * (q + 1) : r * (q + 1) + (xcd - r) * q) + off; }
        const int nig = WGM * nN, gid = wgid / nig, fm = gid * WGM, gsz = (nM - fm) < WGM ? (nM - fm) : WGM;
        u.pm = fm + ((wgid % nig) % gsz); u.pn = (wgid % nig) / gsz; return true;
    }
    __device__ __forceinline__ void a_ready(const Unit&) const {}
    __device__ __forceinline__ void done(const Unit&) const {}
};

__device__ __forceinline__ unsigned cvt_pk_bf16(float lo, float hi) { unsigned r; asm volatile("v_cvt_pk_bf16_f32 %0, %1, %2" : "=v"(r) : "v"(lo), "v"(hi)); return r; }
typedef float f32x2 __attribute__((ext_vector_type(2)));
__device__ __forceinline__ f32x2 gelu_pk(f32x2 v) {
    const f32x2 av = __builtin_elementwise_abs(v), d = av * 0.2316418882f + 1.0f;
    f32x2 t; t.x = __builtin_amdgcn_rcpf(d.x); t.y = __builtin_amdgcn_rcpf(d.y);
    f32x2 q = t * 0.5307027145f + (-0.7265760135f); q = q * t + 0.7107068705f; q = q * t + (-0.142248368f); q = q * t + 0.127414796f; q = q * t;
    const f32x2 s = (v * v) * (-0.72134752044f);
    f32x2 e; e.x = __builtin_amdgcn_exp2f(s.x); e.y = __builtin_amdgcn_exp2f(s.y);
    const f32x2 m = v * (q * e), r = v - m;
    f32x2 o; o.x = v.x < 0.f ? m.x : r.x; o.y = v.y < 0.f ? m.y : r.y; return o;
}

template <int ACT  > struct EpiBf16 {
    static constexpr bool PERM = true, AFTER_DRAIN = false; static_assert(ACT == 0 || ACT == 1, "EpiBf16: ACT is 0 (none) or 1 (gelu_pk)");
    bf16_t* O; int ldc; const float* bias; int split_cols; size_t split_stride; float scale0;
    __device__ __forceinline__ void operator()(const f32x4 (&acc)[2][2][4][2], const Unit& u, int wr, int wc, int fr, int fq) const {
        const int row0 = u.pm * BM + wr * 64 + fr; int colt = u.pn * BM; bf16_t* base = O;
        float sc = 1.f; if (split_cols) { const int t = colt / split_cols; base += (size_t)t * split_stride; colt -= t * split_cols; if (t == 0) sc = scale0; }
        const int col0 = colt + wc * 32 + 8 * fq, bcol0 = u.pn * BM + wc * 32 + 8 * fq;
        f32x4 bv[2][2];
#pragma unroll
        for (int bj = 0; bj < 2; ++bj)
#pragma unroll
            for (int n = 0; n < 2; ++n) bv[bj][n] = bias ? *(const f32x4*)(bias + bcol0 + bj * HALF + 4 * n) : (f32x4){0.f, 0.f, 0.f, 0.f};
#pragma unroll
        for (int ai = 0; ai < 2; ++ai)
#pragma unroll
            for (int m = 0; m < 4; ++m) { bf16_t* rowp = base + (size_t)(row0 + ai * HALF + m * 16) * ldc + col0;
#pragma unroll
                for (int bj = 0; bj < 2; ++bj) { f32x4 v0 = acc[ai][bj][m][0] + bv[bj][0], v1 = acc[ai][bj][m][1] + bv[bj][1];
                    if (ACT == 1) { f32x2 a = gelu_pk((f32x2){v0[0], v0[1]}), b = gelu_pk((f32x2){v0[2], v0[3]}), c = gelu_pk((f32x2){v1[0], v1[1]}), d = gelu_pk((f32x2){v1[2], v1[3]});
                        v0 = (f32x4){a.x, a.y, b.x, b.y}; v1 = (f32x4){c.x, c.y, d.x, d.y}; }
                    v0 = v0 * sc; v1 = v1 * sc; u32x4 w; w.x = cvt_pk_bf16(v0[0], v0[1]); w.y = cvt_pk_bf16(v0[2], v0[3]); w.z = cvt_pk_bf16(v1[0], v1[1]); w.w = cvt_pk_bf16(v1[2], v1[3]);
                    *(u32x4*)(rowp + bj * HALF) = w; } }
    }
};

struct EpiActTiles {
    static constexpr bool PERM = true, AFTER_DRAIN = false;
    bf16_t* O; int ldc; int gelu_tiles;
    __device__ __forceinline__ void operator()(const f32x4 (&acc)[2][2][4][2], const Unit& u, int wr, int wc, int fr, int fq) const {
        const int row0 = u.pm * BM + wr * 64 + fr; const int col0 = u.pn * BM + wc * 32 + 8 * fq; const bool act = u.pn < gelu_tiles;
#pragma unroll
        for (int ai = 0; ai < 2; ++ai)
#pragma unroll
            for (int m = 0; m < 4; ++m) { bf16_t* rowp = O + (size_t)(row0 + ai * HALF + m * 16) * ldc + col0;
#pragma unroll
                for (int bj = 0; bj < 2; ++bj) { f32x4 v0 = acc[ai][bj][m][0], v1 = acc[ai][bj][m][1];
                    if (act) { f32x2 a = gelu_pk((f32x2){v0[0], v0[1]}), b = gelu_pk((f32x2){v0[2], v0[3]}), c = gelu_pk((f32x2){v1[0], v1[1]}), d = gelu_pk((f32x2){v1[2], v1[3]});
                        v0 = (f32x4){a.x, a.y, b.x, b.y}; v1 = (f32x4){c.x, c.y, d.x, d.y}; }
                    u32x4 w; w.x = cvt_pk_bf16(v0[0], v0[1]); w.y = cvt_pk_bf16(v0[2], v0[3]); w.z = cvt_pk_bf16(v1[0], v1[1]); w.w = cvt_pk_bf16(v1[2], v1[3]);
                    *(u32x4*)(rowp + bj * HALF) = w; } }
    }
};
struct EpiRope {
    static constexpr bool PERM = true, AFTER_DRAIN = false;
    bf16_t* O; int ldc; const float* rope; float qscale;
    __device__ __forceinline__ void operator()(const f32x4 (&acc)[2][2][4][2], const Unit& u, int wr, int wc, int fr, int fq) const {
        const int row0 = u.pm * BM + wr * 64 + fr; const int col0 = u.pn * BM + wc * 32 + 8 * fq; const int kind = u.pn >> 2;
        const int i0 = 16 * (wc & 1) + 4 * fq;
#pragma unroll
        for (int ai = 0; ai < 2; ++ai)
#pragma unroll
            for (int m = 0; m < 4; ++m) { const int row = row0 + ai * HALF + m * 16; bf16_t* rowp = O + (size_t)row * ldc + col0;
                f32x4 cs0 = (f32x4){1.f, 0.f, 1.f, 0.f}, cs1 = cs0;
                if (kind < 2) { const float* rp = rope + ((size_t)row * 32 + i0) * 2; cs0 = *(const f32x4*)rp; cs1 = *(const f32x4*)(rp + 4); }
#pragma unroll
                for (int bj = 0; bj < 2; ++bj) { f32x4 v0 = acc[ai][bj][m][0], v1 = acc[ai][bj][m][1];
                    if (kind < 2) {
                        f32x4 r0, r1;
                        r0[0] = v0[0] * cs0[0] - v0[1] * cs0[1]; r0[1] = v0[1] * cs0[0] + v0[0] * cs0[1]; r0[2] = v0[2] * cs0[2] - v0[3] * cs0[3]; r0[3] = v0[3] * cs0[2] + v0[2] * cs0[3];
                        r1[0] = v1[0] * cs1[0] - v1[1] * cs1[1]; r1[1] = v1[1] * cs1[0] + v1[0] * cs1[1]; r1[2] = v1[2] * cs1[2] - v1[3] * cs1[3]; r1[3] = v1[3] * cs1[2] + v1[2] * cs1[3];
                        v0 = r0; v1 = r1;
                        if (kind == 0) { v0 = v0 * qscale; v1 = v1 * qscale; } }
                    u32x4 w; w.x = cvt_pk_bf16(v0[0], v0[1]); w.y = cvt_pk_bf16(v0[2], v0[3]); w.z = cvt_pk_bf16(v1[0], v1[1]); w.w = cvt_pk_bf16(v1[2], v1[3]);
                    *(u32x4*)(rowp + bj * HALF) = w; } }
    }
};
template <bool BASE_F32>
struct EpiResid {
    static constexpr bool PERM = false, AFTER_DRAIN = false;
    const void* base; bf16_t* out; const float* gate; int gpitch; const float* gain2; const float* sc2; bf16_t* xs; float* ssq;
    typedef unsigned u32x2v __attribute__((ext_vector_type(2)));
    __device__ __forceinline__ f32x4 ldbase(size_t off) const {
        if constexpr (BASE_F32) return *(const f32x4*)((const float*)base + off);
        else { const u32x2v r = *(const u32x2v*)((const bf16_t*)base + off); return (f32x4){__builtin_bit_cast(float, r.x << 16), __builtin_bit_cast(float, r.x & 0xffff0000u), __builtin_bit_cast(float, r.y << 16), __builtin_bit_cast(float, r.y & 0xffff0000u)}; } }
    __device__ __forceinline__ void operator()(const f32x4 (&acc)[2][2][4][2], const Unit& u, int wr, int wc, int fr, int fq) const {
        const int row0 = u.pm * BM + wr * 64 + fr; const int col0 = u.pn * BM + wc * 32 + 4 * fq; const int b = (u.pm * BM) >> 12;
        f32x4 gv[2][2], gs[2][2];
#pragma unroll
        for (int bj = 0; bj < 2; ++bj)
#pragma unroll
            for (int n = 0; n < 2; ++n) { gv[bj][n] = *(const f32x4*)(gate + (size_t)b * gpitch + col0 + bj * HALF + n * 16);
                gs[bj][n] = *(const f32x4*)(gain2 + col0 + bj * HALF + n * 16) * (*(const f32x4*)(sc2 + (size_t)b * gpitch + col0 + bj * HALF + n * 16) + 1.0f); }
        f32x4 xb[2][2][2];
#pragma unroll
        for (int bj = 0; bj < 2; ++bj)
#pragma unroll
            for (int n = 0; n < 2; ++n) xb[0][bj][n] = ldbase((size_t)row0 * 1024 + col0 + bj * HALF + n * 16);
#pragma unroll
        for (int rg = 0; rg < 8; ++rg) { const int ai = rg >> 2, m = rg & 3; const int row = row0 + ai * HALF + m * 16; const size_t off = (size_t)row * 1024 + col0; float s2 = 0.f;
            if (rg + 1 < 8) { const int ai2 = (rg + 1) >> 2, m2 = (rg + 1) & 3; const size_t off2 = (size_t)(row0 + ai2 * HALF + m2 * 16) * 1024 + col0;
#pragma unroll
                for (int bj = 0; bj < 2; ++bj)
#pragma unroll
                    for (int n = 0; n < 2; ++n) xb[(rg + 1) & 1][bj][n] = ldbase(off2 + bj * HALF + n * 16); }
#pragma unroll
            for (int bj = 0; bj < 2; ++bj)
#pragma unroll
                for (int n = 0; n < 2; ++n) { const f32x4 x = xb[rg & 1][bj][n];
                    const f32x4 o = x + gv[bj][n] * acc[ai][bj][m][n];
                    s2 += (o[0] * o[0] + o[1] * o[1]) + (o[2] * o[2] + o[3] * o[3]);
                    const f32x4 t = o * gs[bj][n]; u32x2v w; w.x = cvt_pk_bf16(t[0], t[1]); w.y = cvt_pk_bf16(t[2], t[3]);
                    *(u32x2v*)(xs + off + bj * HALF + n * 16) = w; }
            { const int ln = fr + 16 * fq; s2 += lshfl(s2, ln ^ 16); s2 += lshfl(s2, ln ^ 32); }
            if (fq == 0) ssq[(size_t)row * 16 + u.pn * 4 + wc] = s2; }
    }
};
struct EpiScaleShift {
    static constexpr bool PERM = true, AFTER_DRAIN = false;
    bf16_t* O; int ldc; const float* ssq; const float* shift; int spitch; float eps;
    __device__ __forceinline__ void operator()(const f32x4 (&acc)[2][2][4][2], const Unit& u, int wr, int wc, int fr, int fq) const {
        const int row0 = u.pm * BM + wr * 64 + fr; const int col0 = u.pn * BM + wc * 32 + 8 * fq; const int b = (u.pm * BM) >> 12;
        f32x4 sv[2][2];
#pragma unroll
        for (int bj = 0; bj < 2; ++bj)
#pragma unroll
            for (int n = 0; n < 2; ++n) sv[bj][n] = *(const f32x4*)(shift + (size_t)b * spitch + col0 + bj * HALF + 4 * n);
#pragma unroll
        for (int ai = 0; ai < 2; ++ai)
#pragma unroll
            for (int m = 0; m < 4; ++m) { const int row = row0 + ai * HALF + m * 16; bf16_t* rowp = O + (size_t)row * ldc + col0;
                float sq; { const f32x4 a = *(const f32x4*)(ssq + (size_t)row * 16), b2 = *(const f32x4*)(ssq + (size_t)row * 16 + 4), c = *(const f32x4*)(ssq + (size_t)row * 16 + 8), d = *(const f32x4*)(ssq + (size_t)row * 16 + 12);
                    sq = (((a[0] + a[1]) + (a[2] + a[3])) + ((b2[0] + b2[1]) + (b2[2] + b2[3]))) + (((c[0] + c[1]) + (c[2] + c[3])) + ((d[0] + d[1]) + (d[2] + d[3]))); }
                const float rstd = 1.0f / sqrtf(sq * (1.0f / 1024.0f) + eps);
#pragma unroll
                for (int bj = 0; bj < 2; ++bj) { const f32x4 v0 = acc[ai][bj][m][0] * rstd + sv[bj][0], v1 = acc[ai][bj][m][1] * rstd + sv[bj][1];
                    u32x4 w; w.x = cvt_pk_bf16(v0[0], v0[1]); w.y = cvt_pk_bf16(v0[2], v0[3]); w.z = cvt_pk_bf16(v1[0], v1[1]); w.w = cvt_pk_bf16(v1[2], v1[3]);
                    *(u32x4*)(rowp + bj * HALF) = w; } }
    }
};

template <class Epi, class Sched, bool ALIGN_EPI = false, bool SP2 = false, bool FP8 = false>
__device__ __forceinline__ void gemm_phase(PG8_LAS unsigned char* lds, const Gemm g, const Sched& S, const Epi& E, int wave_s) {
    const int wid = wave_s, lane = mk_lane(), tid = wid * 64 + lane;
    const int wr = wid >> 2, wc = wid & 3, fr = lane & 15, fq = lane >> 4;
    const int K = g.K, nt = K / BK;
    unsigned voffA[2], voffB[2];
#pragma unroll
    for (int i = 0; i < 2; ++i) { int R, C; stage_rc(tid * 16 + i * 8192, R, C); const int Rb = Epi::PERM ? ((R & ~31) + perm32(R & 31)) : R;
        voffA[i] = (unsigned)(R * g.lda + C) * 2u; voffB[i] = (unsigned)(Rb * K + C) * 2u; }
    const size_t kstep = (size_t)(BK * 2);
    const size_t hstep = (size_t)HALF * K * 2;
    const size_t tstep = 2 * hstep;
    const size_t hstepA = (size_t)HALF * g.lda * 2, tstepA = 2 * hstepA;
    const unsigned ldsw = (unsigned)wid * 1024u;
    const int aoff = lds_byte(wr * 64 + fr, fq * 8), boff = lds_byte(wc * 32 + fr, fq * 8);
#define PG8_SA(b, h) (((b) * 2 + (h)) * HTB)
#define PG8_SB(b, h) ((4 + (b) * 2 + (h)) * HTB)
#define PG8_STAGE(bufoff, gbase, voff) do { _Pragma("unroll") for (int _i = 0; _i < 2; ++_i) \
        __builtin_amdgcn_global_load_lds((const unsigned*)((const char*)(gbase) + (voff)[_i]), (PG8_LAS unsigned*)(lds + (bufoff) + ldsw + _i * 8192), 16, 0, 0); } while (0)
#define PG8_LDA(dst, b, h) do { _Pragma("unroll") for (int m = 0; m < 4; ++m) { if constexpr (FP8) dst##8[m] = PG8_CAT8(*(const PG8_LAS bf16x8*)(lds + PG8_SA(b, h) + aoff + m * 2048), *(const PG8_LAS bf16x8*)(lds + PG8_SA(b, h) + aoff + m * 2048 + 1024)); \
        else { _Pragma("unroll") for (int k = 0; k < 2; ++k) dst[m][k] = *(const PG8_LAS bf16x8*)(lds + PG8_SA(b, h) + aoff + m * 2048 + k * 1024); } } } while (0)
#define PG8_LDB(dst, b, h) do { _Pragma("unroll") for (int n = 0; n < 2; ++n) { if constexpr (FP8) dst##8[n] = PG8_CAT8(*(const PG8_LAS bf16x8*)(lds + PG8_SB(b, h) + boff + n * 2048), *(const PG8_LAS bf16x8*)(lds + PG8_SB(b, h) + boff + n * 2048 + 1024)); \
        else { _Pragma("unroll") for (int k = 0; k < 2; ++k) dst[n][k] = *(const PG8_LAS bf16x8*)(lds + PG8_SB(b, h) + boff + n * 2048 + k * 1024); } } } while (0)
#define PG8_CAT8(x, y) __builtin_shufflevector(__builtin_bit_cast(pg8_v4i, x), __builtin_bit_cast(pg8_v4i, y), 0, 1, 2, 3, 4, 5, 6, 7)
#define PG8_MMA(ai, bj, At, Bt) do { __builtin_amdgcn_s_setprio(1); _Pragma("unroll") for (int m = 0; m < 4; ++m) _Pragma("unroll") for (int n = 0; n < 2; ++n) { \
        if constexpr (FP8) { acc[ai][bj][m][n] = __builtin_amdgcn_mfma_scale_f32_16x16x128_f8f6f4(Bt##8[n], At##8[m], acc[ai][bj][m][n], 0, 0, 0, FP8_SCALE_W, 0, FP8_SCALE_A); asm volatile("" : "+v"(acc[ai][bj][m][n])); }   \
        else { _Pragma("unroll") for (int k = 0; k < 2; ++k) acc[ai][bj][m][n] = __builtin_amdgcn_mfma_f32_16x16x32_bf16(Bt[n][k], At[m][k], acc[ai][bj][m][n], 0, 0, 0); } } __builtin_amdgcn_s_setprio(0); } while (0)
#define PG8_WAIT_V(n) asm volatile("s_waitcnt vmcnt(" #n ")" ::: "memory")
#define PG8_WAIT_L(n) asm volatile("s_waitcnt lgkmcnt(" #n ")" ::: "memory")
#define PG8_BAR __builtin_amdgcn_s_barrier()
#define PG8_SCHED __builtin_amdgcn_sched_barrier(0)
    Unit cur, nxt; int ui = 0;
    if (!S.next(0, cur)) return;
    f32x4 acc[2][2][4][2];
#pragma unroll
    for (int a = 0; a < 2; ++a)
#pragma unroll
        for (int b = 0; b < 2; ++b)
#pragma unroll
            for (int m = 0; m < 4; ++m)
#pragma unroll
                for (int n = 0; n < 2; ++n) acc[a][b][m][n] = (f32x4){0.f, 0.f, 0.f, 0.f};
    bf16x8 At[4][2], B0[2][2], B1[2][2]; pg8_v8i At8[4], B08[2], B18[2];
    const char* cA = (const char*)g.A + (size_t)cur.pm * tstepA; const char* cB = (const char*)g.Bt + (size_t)cur.pn * tstep;
    S.a_ready(cur);
    if constexpr (SP2) {
        PG8_STAGE(PG8_SB(0, 0), cB, voffB); PG8_STAGE(PG8_SB(0, 1), cB + hstep, voffB); PG8_STAGE(PG8_SA(0, 0), cA, voffA); PG8_STAGE(PG8_SA(0, 1), cA + hstepA, voffA);
        if (wr == 1) PG8_BAR;
        PG8_WAIT_V(2); PG8_BAR;
        PG8_STAGE(PG8_SB(1, 0), cB + kstep, voffB); PG8_STAGE(PG8_SA(1, 0), cA + kstep, voffA); PG8_STAGE(PG8_SB(1, 1), cB + hstep + kstep, voffB);
        PG8_WAIT_V(6); PG8_BAR;
    } else {
        PG8_STAGE(PG8_SB(0, 0), cB, voffB); PG8_STAGE(PG8_SA(0, 0), cA, voffA); PG8_STAGE(PG8_SB(0, 1), cB + hstep, voffB); PG8_STAGE(PG8_SA(0, 1), cA + hstepA, voffA);
        if (wr == 1) PG8_BAR;
        PG8_WAIT_V(4); PG8_BAR;
        PG8_STAGE(PG8_SB(1, 0), cB + kstep, voffB); PG8_STAGE(PG8_SA(1, 0), cA + kstep, voffA); PG8_STAGE(PG8_SB(1, 1), cB + hstep + kstep, voffB);
        PG8_WAIT_V(6); PG8_BAR;
    }
    for (;;) {
        const bool has_next = S.next(ui + 1, nxt);
        const char* nA = has_next ? (const char*)g.A + (size_t)nxt.pm * tstepA : cA; const char* nB = has_next ? (const char*)g.Bt + (size_t)nxt.pn * tstep : cB;
        for (int t = 0; t < nt; t += 2) {
            const bool last = (t == nt - 2);
            const char* a1 = cA + (size_t)(t + 1) * kstep;
            const char* a2 = last ? nA : cA + (size_t)(t + 2) * kstep; const char* b2 = last ? nB : cB + (size_t)(t + 2) * kstep;
            const char* a3 = a2 + kstep; const char* b3 = b2 + kstep;
            if (last && has_next) S.a_ready(nxt);
            if constexpr (SP2) {
            PG8_LDB(B0, 0, 0); PG8_LDB(B1, 0, 1); PG8_SCHED; PG8_LDA(At, 0, 0); PG8_STAGE(PG8_SA(1, 1), a1 + hstepA, voffA);
            PG8_WAIT_V(8); PG8_WAIT_L(0); PG8_BAR; PG8_MMA(0, 0, At, B0); PG8_MMA(0, 1, At, B1); PG8_BAR; PG8_SCHED;
            PG8_LDA(At, 0, 1); PG8_STAGE(PG8_SB(0, 0), b2, voffB); PG8_STAGE(PG8_SB(0, 1), b2 + hstep, voffB); PG8_STAGE(PG8_SA(0, 0), a2, voffA);
            PG8_WAIT_V(8); PG8_WAIT_L(0); PG8_BAR; PG8_MMA(1, 0, At, B0); PG8_MMA(1, 1, At, B1); PG8_BAR; PG8_SCHED;
            PG8_LDB(B0, 1, 0); PG8_LDB(B1, 1, 1); PG8_SCHED; PG8_LDA(At, 1, 0); PG8_STAGE(PG8_SA(0, 1), a2 + hstepA, voffA);
            PG8_WAIT_V(8); PG8_WAIT_L(0); PG8_BAR; PG8_MMA(0, 0, At, B0); PG8_MMA(0, 1, At, B1); PG8_BAR; PG8_SCHED;
            PG8_LDA(At, 1, 1); PG8_STAGE(PG8_SB(1, 0), b3, voffB); PG8_STAGE(PG8_SB(1, 1), b3 + hstep, voffB); PG8_STAGE(PG8_SA(1, 0), a3, voffA);
            PG8_WAIT_V(8); PG8_WAIT_L(0); PG8_BAR; PG8_MMA(1, 0, At, B0); PG8_MMA(1, 1, At, B1); PG8_BAR; PG8_SCHED;
            } else {
            PG8_LDB(B0, 0, 0); PG8_SCHED; PG8_LDA(At, 0, 0); PG8_STAGE(PG8_SA(1, 1), a1 + hstepA, voffA);
            PG8_WAIT_L(8); PG8_BAR; PG8_WAIT_L(0); PG8_MMA(0, 0, At, B0); PG8_BAR; PG8_SCHED;
            PG8_LDB(B1, 0, 1); PG8_STAGE(PG8_SB(0, 0), b2, voffB);
            PG8_BAR; PG8_WAIT_L(0); PG8_MMA(0, 1, At, B1); PG8_BAR;
            PG8_LDA(At, 0, 1); PG8_STAGE(PG8_SA(0, 0), a2, voffA);
            PG8_BAR; PG8_WAIT_L(0); PG8_MMA(1, 0, At, B0); PG8_BAR; PG8_SCHED;
            PG8_STAGE(PG8_SB(0, 1), b2 + hstep, voffB);
            PG8_WAIT_V(6); PG8_BAR; PG8_MMA(1, 1, At, B1); PG8_BAR;
            PG8_LDB(B0, 1, 0); PG8_SCHED; PG8_LDA(At, 1, 0); PG8_STAGE(PG8_SA(0, 1), a2 + hstepA, voffA);
            PG8_WAIT_L(8); PG8_BAR; PG8_WAIT_L(0); PG8_MMA(0, 0, At, B0); PG8_BAR; PG8_SCHED;
            PG8_LDB(B1, 1, 1); PG8_STAGE(PG8_SB(1, 0), b3, voffB);
            PG8_BAR; PG8_WAIT_L(0); PG8_MMA(0, 1, At, B1); PG8_BAR;
            PG8_LDA(At, 1, 1); PG8_STAGE(PG8_SA(1, 0), a3, voffA);
            PG8_BAR; PG8_WAIT_L(0); PG8_MMA(1, 0, At, B0); PG8_BAR; PG8_SCHED;
            PG8_STAGE(PG8_SB(1, 1), b3 + hstep, voffB);
            PG8_WAIT_V(6); PG8_BAR; PG8_MMA(1, 1, At, B1); PG8_BAR;
            }
        }
        if constexpr (ALIGN_EPI) { if (wr == 0) PG8_BAR; }
        if constexpr (!Epi::AFTER_DRAIN) { E(acc, cur, wr, wc, fr, fq); S.done(cur); }
        if (!has_next) break;
#pragma unroll
        for (int a = 0; a < 2; ++a)
#pragma unroll
            for (int b = 0; b < 2; ++b)
#pragma unroll
                for (int m = 0; m < 4; ++m)
#pragma unroll
                    for (int n = 0; n < 2; ++n) acc[a][b][m][n] = (f32x4){0.f, 0.f, 0.f, 0.f};
        cur = nxt; cA = nA; cB = nB; ++ui;
        if constexpr (ALIGN_EPI) { if (wr == 1) PG8_BAR; }
    }
    PG8_WAIT_V(0);
    if constexpr (!ALIGN_EPI) { if (wr == 0) PG8_BAR; }
    PG8_BAR;
    if constexpr (Epi::AFTER_DRAIN) { E.fused(acc, cur, wr, wc, fr, fq, lds, wid, lane); S.done(cur); }
#undef PG8_SA
#undef PG8_SB
#undef PG8_STAGE
#undef PG8_LDA
#undef PG8_LDB
#undef PG8_MMA
#undef PG8_CAT8
#undef PG8_WAIT_V
#undef PG8_WAIT_L
#undef PG8_BAR
#undef PG8_SCHED
}
}
#include <hip/hip_bf16.h>
#include <cmath>
namespace attn_body {
using bf16=__hip_bfloat16;
using bf16x8=__attribute__((ext_vector_type(8)))short;
using s16x4=__attribute__((ext_vector_type(4)))short;
using f32x16=__attribute__((ext_vector_type(16)))float;
using u32x4=__attribute__((ext_vector_type(4)))unsigned;
constexpr int BATCH=8,NHEAD=16,SEQ=4096,D=64,PQ=3072,OP=2048;
constexpr int NW=8,QBLK=32,QB=QBLK*NW,KVBLK=64,NQB=SEQ/QB;
constexpr int ATTN_UNIT_ROWS=QB;
__device__ __forceinline__ int crow(int r,int hi){return (r&3)+8*(r>>2)+4*hi;}
#define SBAR() __builtin_amdgcn_sched_barrier(0)
__device__ __forceinline__ void cmask(f32x16&p0,f32x16&p1,int jb,int qrel,int hi){
  const float NEG=-INFINITY; int kb=64*jb+4*hi;
  #pragma unroll
  for(int r=0;r<16;++r){int kv=kb+(r&3)+8*(r>>2); if(kv>qrel)p0[r]=NEG; if(kv+32>qrel)p1[r]=NEG;}
}

constexpr int NSLOT=3, SLOTB=8192, VSLOTB=16384;
constexpr int LDS_K=0, LDS_V=NSLOT*SLOTB, LDS_WS=LDS_V+NSLOT*VSLOTB, LDS_Q=LDS_WS+NW*64*4, LDS_OST=LDS_Q+NW*4096, LDS_BYTES=LDS_OST+NW*4096;
constexpr float C2=0.125f*1.4426950408889634f;
__device__ __forceinline__ void glds16(const void*sbase,unsigned voff,unsigned lds_dst){unsigned keep;
  asm volatile("s_mov_b32 %0, m0\n\ts_mov_b32 m0, %3\n\ts_nop 4\n\tglobal_load_lds_dwordx4 %1, %2\n\ts_mov_b32 m0, %0":"=&s"(keep):"v"(voff),"s"(sbase),"s"(lds_dst):"memory");}
__device__ __forceinline__ float max3f(float a,float b,float c){float r;asm("v_max3_f32 %0, %1, %2, %3":"=v"(r):"v"(a),"v"(b),"v"(c));return r;}
__device__ __forceinline__ float max2f(float a,float b){float r;asm("v_max_f32_e32 %0, %1, %2":"=v"(r):"v"(a),"v"(b));return r;}
__device__ __forceinline__ float fadd_s(float a,float b){float r;asm("v_add_f32_e32 %0, %1, %2":"=v"(r):"v"(a),"v"(b));return r;}
__device__ __forceinline__ float fsub_s(float a,float b){float r;asm("v_sub_f32_e32 %0, %1, %2":"=v"(r):"v"(a),"v"(b));return r;}
typedef float f32x2_t __attribute__((ext_vector_type(2))); typedef __bf16 bf16x2_t __attribute__((ext_vector_type(2)));
__device__ __forceinline__ unsigned cvtpk_s(float lo,float hi){f32x2_t v={lo,hi};bf16x2_t b=__builtin_convertvector(v,bf16x2_t);return __builtin_bit_cast(unsigned,b);}
#define WAIT_BAR(N) asm volatile("s_waitcnt vmcnt(" #N ") lgkmcnt(0)\n\ts_barrier":::"memory")

typedef __attribute__((address_space(3))) const char* lds_cptr0;
__device__ __forceinline__ void qkt(f32x16&p0,f32x16&p1,const char*Kslot,lds_cptr0 qs,const f32x16&negm,int r32,int hi){
  const char*kb=Kslot+hi*1024+r32*16;
  #pragma unroll
  for(int d0=0;d0<4;++d0){
    const bf16x8 b0=*reinterpret_cast<const bf16x8*>(kb+d0*2048);
    const bf16x8 b1=*reinterpret_cast<const bf16x8*>(kb+d0*2048+512);
    const bf16x8 qd=*(const __attribute__((address_space(3))) bf16x8*)(qs+d0*1024);
    if(d0==0){p0=__builtin_amdgcn_mfma_f32_32x32x16_bf16(b0,qd,negm,0,0,0);p1=__builtin_amdgcn_mfma_f32_32x32x16_bf16(b1,qd,negm,0,0,0);}
    else{p0=__builtin_amdgcn_mfma_f32_32x32x16_bf16(b0,qd,p0,0,0,0);p1=__builtin_amdgcn_mfma_f32_32x32x16_bf16(b1,qd,p1,0,0,0);}}
}
typedef __attribute__((address_space(3))) const char* lds_cptr;
typedef short v4i16_t __attribute__((ext_vector_type(4)));
__device__ __forceinline__ void kload8(bf16x8*kf,lds_cptr kp){
  kf[0]=*(const __attribute__((address_space(3))) bf16x8*)(kp);      kf[1]=*(const __attribute__((address_space(3))) bf16x8*)(kp+512);
  kf[2]=*(const __attribute__((address_space(3))) bf16x8*)(kp+2048); kf[3]=*(const __attribute__((address_space(3))) bf16x8*)(kp+2560);
  kf[4]=*(const __attribute__((address_space(3))) bf16x8*)(kp+4096); kf[5]=*(const __attribute__((address_space(3))) bf16x8*)(kp+4608);
  kf[6]=*(const __attribute__((address_space(3))) bf16x8*)(kp+6144); kf[7]=*(const __attribute__((address_space(3))) bf16x8*)(kp+6656);
}
__device__ __forceinline__ void kload2(bf16x8*kf,lds_cptr kp,int j){ kf[2*j]=*(const __attribute__((address_space(3))) bf16x8*)(kp+j*2048); kf[2*j+1]=*(const __attribute__((address_space(3))) bf16x8*)(kp+j*2048+512); }
__device__ __forceinline__ s16x4 vtr(lds_cptr p){ return __builtin_bit_cast(s16x4,__builtin_amdgcn_ds_read_tr16_b64_v4i16((__attribute__((address_space(3))) v4i16_t*)p)); }
__device__ __forceinline__ float rowmax(const f32x16&p0,const f32x16&p1){
  float a=max3f(p0[0],p0[1],p1[0]),b=max3f(p0[2],p0[3],p1[1]);a=max3f(a,p1[2],p1[3]);
  #pragma unroll
  for(int r=4;r<16;r+=4){a=max3f(a,p0[r],p0[r+1]);b=max3f(b,p0[r+2],p0[r+3]);a=max3f(a,p1[r],p1[r+1]);b=max3f(b,p1[r+2],p1[r+3]);}
  const float m=max2f(a,b);
  auto rr=__builtin_amdgcn_permlane32_swap(__float_as_uint(m),__float_as_uint(m),false,false);
  return max2f(__uint_as_float(rr[0]),__uint_as_float(rr[1]));
}
__device__ __forceinline__ void pv(f32x16*o,int vb,bf16x8 pa0,bf16x8 pa1,bf16x8 pa2,bf16x8 pa3){
  #pragma unroll
  for(int d0=0;d0<4;++d0){s16x4 lo[4],hi[4];
    #pragma unroll
    for(int ks=0;ks<4;++ks){
      asm volatile("ds_read_b64_tr_b16 %0,%1 offset:%c2":"=&v"(lo[ks]):"v"(vb),"i"(d0*4096+ks*1024):"memory");
      asm volatile("ds_read_b64_tr_b16 %0,%1 offset:%c2":"=&v"(hi[ks]):"v"(vb),"i"(d0*4096+ks*1024+512):"memory");}
    asm volatile("s_waitcnt lgkmcnt(0)":::"memory");SBAR();
    #define PK(k) (bf16x8){lo[k][0],lo[k][1],lo[k][2],lo[k][3],hi[k][0],hi[k][1],hi[k][2],hi[k][3]}
    o[d0]=__builtin_amdgcn_mfma_f32_32x32x16_bf16(pa0,PK(0),o[d0],0,0,0);
    o[d0]=__builtin_amdgcn_mfma_f32_32x32x16_bf16(pa1,PK(1),o[d0],0,0,0);
    o[d0]=__builtin_amdgcn_mfma_f32_32x32x16_bf16(pa2,PK(2),o[d0],0,0,0);
    o[d0]=__builtin_amdgcn_mfma_f32_32x32x16_bf16(pa3,PK(3),o[d0],0,0,0);
    #undef PK
  }
}

#ifndef ATTN_STORE16
#define ATTN_STORE16(p,v) (*(u32x4*)(p)=(v))
#endif
template<int THRL,int VAR> __device__ __forceinline__ void attn_unit(int wave_s,int b,int hq,int qb,const bf16*Q,const bf16*__restrict__ K,const bf16*__restrict__ V,bf16*O,char*shm,int cm,float lam,const float*gsub,float post,bf16*A2){
  const int lane=mk_lane(),r32=lane&31,hi=lane>>5; const int wid=wave_s; const int tid=wid*64+lane;
  const long rowbase=(long)b*SEQ; const int q0=qb*QB;
  const bf16*Qw=Q+(rowbase+q0+wid*QBLK)*PQ+hq*D;
  const bf16*Kh=K+rowbase*PQ+hq*D,*Vh=V+rowbase*PQ+(hq>>1)*128;
  const unsigned lds0=(unsigned)(uintptr_t)shm;
  float*wsf=(float*)(shm+LDS_WS)+wid*64;
  const unsigned koff=(unsigned)(lane*PQ+wid*8)*2u;
  const unsigned voff=(unsigned)((16*(wid&3)+(lane>>2))*PQ+(wid>>2)*32+(lane&3)*8)*2u;
  const unsigned kdst=lds0+LDS_K+wid*1024, vdst=lds0+LDS_V+wid*1024;
  #define DMA_K(t,slot) glds16(Kh+(long)(t)*KVBLK*PQ,koff,(unsigned)__builtin_amdgcn_readfirstlane(kdst+(slot)))
  #define DMA_V(t,slot) do{ if(VAR==1)break; glds16(Vh+(long)(t)*KVBLK*PQ,voff,(unsigned)__builtin_amdgcn_readfirstlane(vdst+2*(slot))); glds16(Vh+(long)(t)*KVBLK*PQ,voff+128u,(unsigned)__builtin_amdgcn_readfirstlane(vdst+8192+2*(slot))); }while(0)
  const int vb0=(int)(lds0+LDS_V)+((lane>>4)&1)*32+(lane&3)*8+(4*hi+((lane&15)>>2))*64;
  const char*Kbase=shm+LDS_K; bf16x8 kf[8];
  const lds_cptr shm3=(lds_cptr)shm; const lds_cptr kp0=shm3+LDS_K+hi*1024+r32*16; const lds_cptr vp0=shm3+LDS_V+((lane>>4)&1)*32+(lane&3)*8+(4*hi+((lane&15)>>2))*64;
  const int NT=(q0+QB)/KVBLK;
  DMA_K(0,0);DMA_V(0,0);DMA_K(1,SLOTB);
  const lds_cptr qs=shm3+LDS_Q+wid*4096+lane*16;
  #pragma unroll
  for(int d0=0;d0<4;++d0)*(__attribute__((address_space(3))) bf16x8*)(const_cast<__attribute__((address_space(3))) char*>(qs)+d0*1024)=*reinterpret_cast<const bf16x8*>(&Qw[(long)r32*PQ+d0*16+hi*8]);
  #define LDQ(d0) (*(const __attribute__((address_space(3))) bf16x8*)(qs+(d0)*1024))
  float mhat=0.f,l_reg=0.f;f32x16 o[4];o[0]=f32x16{};o[1]=f32x16{};o[2]=f32x16{};o[3]=f32x16{};const f32x16 negm=f32x16{};
  const int qrel=wid*QBLK+r32;
  #define CMASK(P0,P1,t) do{int jb_=(t)-(NT-4); if(jb_>=0)cmask(P0,P1,jb_,qrel,hi);}while(0)
  bool resc=false;
  #define START(P0,P1) do{ const float rm=rowmax(P0,P1); resc=false; \
    { const float dl=rm; mhat=fadd_s(mhat,dl); \
      _Pragma("unroll") for(int r=0;r<16;++r){P0[r]=fsub_s(P0[r],dl);P1[r]=fsub_s(P1[r],dl);} \
      } \
    _Pragma("unroll") for(int r=0;r<16;++r)P0[r]=__builtin_amdgcn_exp2f(P0[r]); }while(0)
  #define RESC() do{ if(resc){ asm volatile("s_waitcnt lgkmcnt(0)":::"memory"); \
      _Pragma("unroll") for(int d_=0;d_<4;++d_) _Pragma("unroll") for(int r=0;r<16;++r)o[d_][r]*=wsf[crow(r,hi)]; } }while(0)
  f32x16 pA0,pA1,pB0,pB1;
  int sl_prev=0,sl_cur=0,sl_next=SLOTB;
  #define ROT() do{sl_prev=sl_cur;sl_cur=sl_next;sl_next=(sl_next==(NSLOT-1)*SLOTB)?0:sl_next+SLOTB;}while(0)
  DMA_K(2,2*SLOTB);
  WAIT_BAR(4);
  qkt(pA0,pA1,Kbase,qs,negm,r32,hi);asm volatile("s_nop 15\n\ts_nop 7":"+v"(pA0),"+v"(pA1));CMASK(pA0,pA1,0);
  START(pA0,pA1);
  _Pragma("unroll") for(int r=0;r<16;++r)pA1[r]=__builtin_amdgcn_exp2f(pA1[r]);
  WAIT_BAR(0);
  DMA_K(3,0);DMA_V(1,SLOTB);
  ROT();
  kload8(kf,kp0+sl_cur);
  WAIT_BAR(3);
  s16x4 vlo[8],vhi[8]; u32x4 pw0=u32x4{},pw1=u32x4{},pw2=u32x4{},pw3=u32x4{};
  if(VAR==3){_Pragma("unroll") for(int i_=0;i_<8;++i_){vlo[i_]=s16x4{};vhi[i_]=s16x4{};}}
  #define PKW(P,B) cvtpk_s(P[B],P[B+1])
  #define PAF(k) __builtin_bit_cast(bf16x8,pw##k)
  #define VFR(i) (bf16x8){vlo[i][0],vlo[i][1],vlo[i][2],vlo[i][3],vhi[i][0],vhi[i][1],vhi[i][2],vhi[i][3]}
  #define PIN(x) asm volatile("":"+v"(x))
  #define MX3(a,b,c) __builtin_fmaxf(__builtin_fmaxf((a),(b)),(c))
  #define GAPA(MF,A0,A1,A2,A3,W0,W1,PW) do{ MF; if(VAR!=5){sacc+=A0; sacc+=A1; sacc+=A2; sacc+=A3; PIN(sacc); W0; W1; PIN(PW);} SBAR(); }while(0)
  #define EX(v) (VAR==2?(v)*0.5f:__builtin_amdgcn_exp2f(v))
  #define GAPB(MF,X,B) do{ if(VAR!=4){MF;} X[B]=EX(X[B]); X[B+1]=EX(X[B+1]); PIN(X); SBAR(); }while(0)
  #define VRD2(i) do{ if(VAR==3)break; vlo[i]=vtr(vp_+((((i)>>2)+2)*4096+((i)&3)*1024)); vhi[i]=vtr(vp_+((((i)>>2)+2)*4096+((i)&3)*1024+512)); }while(0)
  #define VRD(i) do{ if(VAR==3)break; vlo[i]=vtr(vp_+(((i)>>2)*4096+((i)&3)*1024)); vhi[i]=vtr(vp_+(((i)>>2)*4096+((i)&3)*1024+512)); }while(0)
  #define KRD(G,j) do{ if(G){ kload2(kf,kp0+sl_next,j); SBAR(); } }while(0)
  #define STEP(C0,C1,P0,P1,t,GK,GV,GL) do{ SBAR(); \
    const lds_cptr vp_=vp0+2*sl_prev; \
    bf16x8 qa_=LDQ(0),qb_=LDQ(1); VRD(0); SBAR(); float sacc=(P0[0]+P0[1]); \
    GAPA(C0=__builtin_amdgcn_mfma_f32_32x32x16_bf16(kf[0],qa_,negm,0,0,0), P0[2],P0[3],P0[4],P0[5],     pw0[0]=PKW(P0,0), pw0[1]=PKW(P0,2), pw0); \
    VRD(4); SBAR(); GAPA(C1=__builtin_amdgcn_mfma_f32_32x32x16_bf16(kf[1],qa_,negm,0,0,0), P0[6],P0[7],P0[8],P0[9],     pw0[2]=PKW(P0,4), pw0[3]=PKW(P0,6), pw0); \
    VRD(1); qa_=LDQ(2); SBAR(); GAPA(C0=__builtin_amdgcn_mfma_f32_32x32x16_bf16(kf[2],qb_,C0,0,0,0),   P0[10],P0[11],P0[12],P0[13], pw1[0]=PKW(P0,8), pw1[1]=PKW(P0,10), pw1); \
    VRD(5); SBAR(); GAPA(C1=__builtin_amdgcn_mfma_f32_32x32x16_bf16(kf[3],qb_,C1,0,0,0),   P0[14],P0[15],P1[0],P1[1],   pw1[2]=PKW(P0,12),pw1[3]=PKW(P0,14), pw1); \
    VRD(2); qb_=LDQ(3); SBAR(); GAPA(C0=__builtin_amdgcn_mfma_f32_32x32x16_bf16(kf[4],qa_,C0,0,0,0),   P1[2],P1[3],P1[4],P1[5],     pw2[0]=PKW(P1,0), pw2[1]=PKW(P1,2), pw2); \
    VRD(6); SBAR(); GAPA(C1=__builtin_amdgcn_mfma_f32_32x32x16_bf16(kf[5],qa_,C1,0,0,0),   P1[6],P1[7],P1[8],P1[9],     pw2[2]=PKW(P1,4), pw2[3]=PKW(P1,6), pw2); \
    VRD(3); SBAR(); GAPA(C0=__builtin_amdgcn_mfma_f32_32x32x16_bf16(kf[6],qb_,C0,0,0,0),   P1[10],P1[11],P1[12],P1[13], pw3[0]=PKW(P1,8), pw3[1]=PKW(P1,10), pw3); \
    VRD(7); SBAR(); GAPA(C1=__builtin_amdgcn_mfma_f32_32x32x16_bf16(kf[7],qb_,C1,0,0,0),   P1[14],P1[15],0.f,0.f,       pw3[2]=PKW(P1,12),pw3[3]=PKW(P1,14), pw3); \
    l_reg+=sacc; \
    if(GK){DMA_K((t)+3,sl_cur);} if(GV){DMA_V((t)+1,sl_next);} \
    CMASK(C0,C1,t); \
    _Pragma("unroll") for(int r=0;r<16;++r){C0[r]-=mhat;C1[r]-=mhat;} \
    if(VAR!=6){ float a=MX3(C0[0],C0[1],C1[0]),b=MX3(C0[2],C0[3],C1[1]); a=MX3(a,C1[2],C1[3]); \
      _Pragma("unroll") for(int r=4;r<16;r+=4){a=MX3(a,C0[r],C0[r+1]);b=MX3(b,C0[r+2],C0[r+3]);a=MX3(a,C1[r],C1[r+1]);b=MX3(b,C1[r+2],C1[r+3]);} \
      float rm=__builtin_fmaxf(a,b); { auto rr=__builtin_amdgcn_permlane32_swap(__float_as_uint(rm),__float_as_uint(rm),false,false); rm=__builtin_fmaxf(__uint_as_float(rr[0]),__uint_as_float(rr[1])); } \
      resc=false; \
      if(__builtin_expect(__any(rm>(float)THRL),0)){ const float dl=__builtin_fmaxf(rm,0.f); mhat+=dl; \
        _Pragma("unroll") for(int r=0;r<16;++r){C0[r]-=dl;C1[r]-=dl;} \
        const float f=__builtin_amdgcn_exp2f(-dl); l_reg*=f; if(hi==0)wsf[r32]=f; resc=true; } } \
    SBAR(); \
    GAPB(o[0]=__builtin_amdgcn_mfma_f32_32x32x16_bf16(PAF(0),VFR(0),o[0],0,0,0), C0,0);  VRD2(0); SBAR(); \
    GAPB(o[1]=__builtin_amdgcn_mfma_f32_32x32x16_bf16(PAF(0),VFR(4),o[1],0,0,0), C0,2);  VRD2(4); SBAR(); \
    KRD(GL,0); GAPB(o[0]=__builtin_amdgcn_mfma_f32_32x32x16_bf16(PAF(1),VFR(1),o[0],0,0,0), C0,4);  VRD2(1); SBAR(); \
    KRD(GL,1); GAPB(o[1]=__builtin_amdgcn_mfma_f32_32x32x16_bf16(PAF(1),VFR(5),o[1],0,0,0), C0,6);  VRD2(5); SBAR(); \
    KRD(GL,2); GAPB(o[0]=__builtin_amdgcn_mfma_f32_32x32x16_bf16(PAF(2),VFR(2),o[0],0,0,0), C0,8);  VRD2(2); SBAR(); \
    KRD(GL,3); GAPB(o[1]=__builtin_amdgcn_mfma_f32_32x32x16_bf16(PAF(2),VFR(6),o[1],0,0,0), C0,10); VRD2(6); SBAR(); \
    GAPB(o[0]=__builtin_amdgcn_mfma_f32_32x32x16_bf16(PAF(3),VFR(3),o[0],0,0,0), C0,12); VRD2(3); SBAR(); \
    GAPB(o[1]=__builtin_amdgcn_mfma_f32_32x32x16_bf16(PAF(3),VFR(7),o[1],0,0,0), C0,14); VRD2(7); SBAR(); \
    GAPB(o[2]=__builtin_amdgcn_mfma_f32_32x32x16_bf16(PAF(0),VFR(0),o[2],0,0,0), C1,0); \
    GAPB(o[3]=__builtin_amdgcn_mfma_f32_32x32x16_bf16(PAF(0),VFR(4),o[3],0,0,0), C1,2); \
    GAPB(o[2]=__builtin_amdgcn_mfma_f32_32x32x16_bf16(PAF(1),VFR(1),o[2],0,0,0), C1,4); \
    GAPB(o[3]=__builtin_amdgcn_mfma_f32_32x32x16_bf16(PAF(1),VFR(5),o[3],0,0,0), C1,6); \
    GAPB(o[2]=__builtin_amdgcn_mfma_f32_32x32x16_bf16(PAF(2),VFR(2),o[2],0,0,0), C1,8); \
    GAPB(o[3]=__builtin_amdgcn_mfma_f32_32x32x16_bf16(PAF(2),VFR(6),o[3],0,0,0), C1,10); \
    GAPB(o[2]=__builtin_amdgcn_mfma_f32_32x32x16_bf16(PAF(3),VFR(3),o[2],0,0,0), C1,12); \
    GAPB(o[3]=__builtin_amdgcn_mfma_f32_32x32x16_bf16(PAF(3),VFR(7),o[3],0,0,0), C1,14); \
    }while(0)
  int t=1;
  #undef CMASK
  #define CMASK(P0,P1,t) do{}while(0)
  for(;t+5<NT;t+=2){
    STEP(pB0,pB1,pA0,pA1,t,true,true,true);     WAIT_BAR(3); RESC(); ROT();
    STEP(pA0,pA1,pB0,pB1,t+1,true,true,true);   WAIT_BAR(3); RESC(); ROT();
  }
  #undef CMASK
  #define CMASK(P0,P1,t) do{int jb_=(t)-(NT-4); if(jb_>=0)cmask(P0,P1,jb_,qrel,hi);}while(0)
  #define ENDW(tt) do{ if((tt)+3<NT){WAIT_BAR(3);} else if((tt)+2<NT){WAIT_BAR(2);} else {WAIT_BAR(0);} }while(0)
  for(;t+1<NT;t+=2){
    STEP(pB0,pB1,pA0,pA1,t,(t+3<NT),(t+1<NT),(t+1<NT));       ENDW(t);   RESC(); ROT();
    STEP(pA0,pA1,pB0,pB1,t+1,(t+4<NT),(t+2<NT),(t+2<NT));     ENDW(t+1); RESC(); ROT();
  }
  STEP(pB0,pB1,pA0,pA1,NT-1,false,false,false); RESC();
  { float sacc=pB0[0]+pB0[1]; _Pragma("unroll") for(int r=2;r<16;++r)sacc+=pB0[r]; _Pragma("unroll") for(int r=0;r<16;++r)sacc+=pB1[r]; l_reg+=sacc;
    pw0=(u32x4){PKW(pB0,0),PKW(pB0,2),PKW(pB0,4),PKW(pB0,6)};pw1=(u32x4){PKW(pB0,8),PKW(pB0,10),PKW(pB0,12),PKW(pB0,14)};pw2=(u32x4){PKW(pB1,0),PKW(pB1,2),PKW(pB1,4),PKW(pB1,6)};pw3=(u32x4){PKW(pB1,8),PKW(pB1,10),PKW(pB1,12),PKW(pB1,14)};
    SBAR(); pv(o,vb0+2*sl_cur,PAF(0),PAF(1),PAF(2),PAF(3)); }
  #undef PKW
  #undef PAF
  #undef VFR
  #undef PIN
  #undef MX3
  #undef GAPA
  #undef GAPB
  #undef EX
  #undef VRD
  #undef VRD2
  #undef KRD
  #undef STEP
  #undef ENDW
  const int lane_e=mk_lane();
  bf16*Ow=O+(rowbase+q0+wid*QBLK)*OP+hq*128;
  u32x4 o1v[2][4];
  if(cm){
    #pragma unroll
    for(int h2=0;h2<2;++h2)
      #pragma unroll
      for(int i=0;i<4;++i) o1v[h2][i]=*(const u32x4*)(Ow-128+(long)(i*8+(lane_e>>3))*OP+h2*64+(lane_e&7)*8); }
  {auto rr=__builtin_amdgcn_permlane32_swap(__float_as_uint(l_reg),__float_as_uint(l_reg),false,false);l_reg=__uint_as_float(rr[0])+__uint_as_float(rr[1]);}
  if(hi==0)wsf[32+r32]=l_reg;asm volatile("s_waitcnt lgkmcnt(0)":::"memory");
  float rli[16];
  #pragma unroll
  for(int r=0;r<16;++r)rli[r]=__builtin_amdgcn_rcpf(wsf[32+crow(r,hi)]);
  if(cm){ bf16*stg=(bf16*)(shm+LDS_OST)+wid*2048; const int ch=lane_e&7;
    float ovv[2][4][8],qs[4]={0.f,0.f,0.f,0.f};
    #pragma unroll
    for(int h2=0;h2<2;++h2){
      #pragma unroll
      for(int r=0;r<16;++r){const int orow=crow(r,hi);
        #pragma unroll
        for(int d0=0;d0<2;++d0)stg[orow*64+d0*32+r32]=__float2bfloat16(o[2*h2+d0][r]*rli[r]);}
      asm volatile("s_waitcnt lgkmcnt(0)":::"memory");
      #pragma unroll
      for(int i=0;i<4;++i){const int row=i*8+(lane_e>>3); const u32x4 v2=*(const u32x4*)(stg+row*64+ch*8); const u32x4 v1=o1v[h2][i];
        const unsigned w1[4]={v1.x,v1.y,v1.z,v1.w},w2[4]={v2.x,v2.y,v2.z,v2.w};
        #pragma unroll
        for(int j=0;j<4;++j){ const float a0=__uint_as_float(w1[j]<<16)-lam*__uint_as_float(w2[j]<<16), a1=__uint_as_float(w1[j]&0xffff0000u)-lam*__uint_as_float(w2[j]&0xffff0000u);
          ovv[h2][i][2*j]=a0; ovv[h2][i][2*j+1]=a1; qs[i]+=a0*a0+a1*a1; } }
      asm volatile("s_waitcnt lgkmcnt(0)":::"memory"); }
    typedef float f32x4a __attribute__((ext_vector_type(4))); f32x4a g4[2][2];
    #pragma unroll
    for(int h2=0;h2<2;++h2){ g4[h2][0]=*(const f32x4a*)(gsub+h2*64+ch*8)*post; g4[h2][1]=*(const f32x4a*)(gsub+h2*64+ch*8+4)*post; }
    bf16*Aw=A2+(rowbase+q0+wid*QBLK)*1024+(hq>>1)*128;
    #pragma unroll
    for(int i=0;i<4;++i){ const int row=i*8+(lane_e>>3); float q=qs[i];
      q+=__uint_as_float(__builtin_amdgcn_ds_bpermute((lane_e^1)<<2,__float_as_uint(q))); q+=__uint_as_float(__builtin_amdgcn_ds_bpermute((lane_e^2)<<2,__float_as_uint(q))); q+=__uint_as_float(__builtin_amdgcn_ds_bpermute((lane_e^4)<<2,__float_as_uint(q)));
      const float rstd=1.0f/sqrtf(q*(1.0f/128.0f)+1e-6f);
      #pragma unroll
      for(int h2=0;h2<2;++h2){ const float gv[8]={g4[h2][0][0],g4[h2][0][1],g4[h2][0][2],g4[h2][0][3],g4[h2][1][0],g4[h2][1][1],g4[h2][1][2],g4[h2][1][3]}; unsigned pw[4];
        #pragma unroll
        for(int j=0;j<4;++j) pw[j]=cvtpk_s(ovv[h2][i][2*j]*rstd*gv[2*j],ovv[h2][i][2*j+1]*rstd*gv[2*j+1]);
        ATTN_STORE16(Aw+(long)row*1024+h2*64+ch*8,((u32x4){pw[0],pw[1],pw[2],pw[3]})); } } }
  else { bf16*stg=(bf16*)(shm+LDS_OST)+wid*2048;
    #pragma unroll
    for(int h2=0;h2<2;++h2){
      #pragma unroll
      for(int r=0;r<16;++r){const int orow=crow(r,hi);
        #pragma unroll
        for(int d0=0;d0<2;++d0)stg[orow*64+d0*32+r32]=__float2bfloat16(o[2*h2+d0][r]*rli[r]);}
      asm volatile("s_waitcnt lgkmcnt(0)":::"memory");
      #pragma unroll
      for(int i=0;i<4;++i){const int row=i*8+(lane_e>>3),ch=lane_e&7; const u32x4 v=*(const u32x4*)(stg+row*64+ch*8); ATTN_STORE16(Ow+(long)row*OP+h2*64+ch*8,v);}
      asm volatile("s_waitcnt lgkmcnt(0)":::"memory"); } }
  asm volatile("s_waitcnt lgkmcnt(0)\n\ts_barrier":::"memory");
  #undef DMA_K
  #undef DMA_V
  #undef CMASK
  #undef START
  #undef RESC
  #undef ROT
  #undef LDQ
}
constexpr int ATTN_LDS_BYTES=LDS_BYTES;
struct AttnTensors { const bf16* Q; const bf16* K; const bf16* V; bf16* O; bf16* A2; const float* gsub; float lam, post; };
template<int VAR> __device__ __forceinline__ void attn_phase(char*lds,const AttnTensors&T,int vcu,int G,int wave_s){
  for(int c=vcu;c<BATCH*NHEAD*2;c+=G){ const int b=c>>5,head=(c>>2)&7,j=c&3;
    for(int p=3;p>=0;--p){ const int qb=(p==3)?15-j:(p==2)?8+j:(p==1)?7-j:j;
      attn_unit<8,VAR>(wave_s,b,2*head,qb,T.Q,T.K,T.V,T.O,lds,0,T.lam,T.gsub,T.post,T.A2);
      attn_unit<8,VAR>(wave_s,b,2*head+1,qb,T.Q,T.K,T.V,T.O,lds,1,T.lam,T.gsub,T.post,T.A2); } }
}
#undef SBAR
#undef WAIT_BAR
}
constexpr int NWAVES = 8;
constexpr int NB = 8, SEQ = 4096, DMODEL = 1024, M = NB * SEQ, DEPTH = 4;
constexpr float RMS_EPS = 1e-6f;
constexpr size_t MiB = 1u << 20;
constexpr size_t WS_CTL = 0, CTL_ZERO_BYTES = 1 * MiB;
constexpr size_t WS_MOD = 1 * MiB;
constexpr size_t WS_ROPE = 2 * MiB;
constexpr size_t WS_WINE = 10 * MiB;
constexpr size_t WS_WOUTE = 16 * MiB;
constexpr size_t WS_WINO = 20 * MiB;
constexpr size_t WS_WOUTO = 32 * MiB;
constexpr size_t WS_WQ = 36 * MiB;
constexpr size_t WS_WSG = 52 * MiB;
constexpr size_t WS_WPT = 52 * MiB + 512 * 1024;
constexpr size_t WS_SUBK = 53 * MiB;
constexpr size_t WS_UV = 56 * MiB;
constexpr int PEER_REC = 1024;
constexpr size_t WS_U = 56 * MiB;
constexpr size_t WS_V = 120 * MiB;
constexpr size_t WS_SU = 184 * MiB;
constexpr size_t WS_SV = 184 * MiB + 512 * 1024;
constexpr size_t WS_SSQ = 185 * MiB;
constexpr size_t WS_SHW = 188 * MiB;
constexpr size_t WS_XRES = 320 * MiB;
constexpr size_t WS_HB = 448 * MiB;
constexpr size_t WS_MIX = 512 * MiB;
constexpr size_t WS_PROJ = 704 * MiB;
constexpr size_t WS_XS = 896 * MiB;
constexpr size_t WS_EIDX = 960 * MiB;
constexpr size_t WS_GATE = 968 * MiB;
constexpr size_t WS_QP = 192 * MiB;
constexpr size_t WS_OATT = 576 * MiB;
constexpr size_t WS_END = 984 * MiB;
constexpr int CW_BAR = 4096;
constexpr int RING_OFF = 0, RING_BYTES = 131072;
constexpr int LDS_BYTES = 163840;
constexpr int LDSCTL_OFF = LDS_BYTES - 1024, MISC_OFF = LDSCTL_OFF + 320;
constexpr int PEER_LDS_LIMIT = LDSCTL_OFF;

#define GAS __attribute__((address_space(1)))
#define LAS __attribute__((address_space(3)))
typedef unsigned short bf16;
typedef unsigned v4u __attribute__((ext_vector_type(4)));
typedef unsigned v2u __attribute__((ext_vector_type(2)));
typedef int v4i __attribute__((ext_vector_type(4)));
typedef int v8i __attribute__((ext_vector_type(8)));
typedef float f32x4 __attribute__((ext_vector_type(4)));
typedef float f32x2 __attribute__((ext_vector_type(2)));
typedef float f32x16 __attribute__((ext_vector_type(16)));
typedef short bf16x8 __attribute__((ext_vector_type(8)));
typedef short s16x4 __attribute__((ext_vector_type(4)));
typedef __bf16 bf16x2_t __attribute__((ext_vector_type(2)));
typedef GAS unsigned gu32;
#define RLX_AGENT __ATOMIC_RELAXED, __HIP_MEMORY_SCOPE_AGENT
#define LDS_WAIT() asm volatile("s_waitcnt lgkmcnt(0)" ::: "memory")
#define VM_WAIT() asm volatile("s_waitcnt vmcnt(0)" ::: "memory")
__device__ __forceinline__ unsigned f2bf(float f) { unsigned u = __builtin_bit_cast(unsigned, f); return (u + 0x7fffu + ((u >> 16) & 1u)) >> 16; }
__device__ __forceinline__ unsigned pk2(float lo, float hi) { const f32x2 v = {lo, hi}; return __builtin_bit_cast(unsigned, __builtin_convertvector(v, bf16x2_t)); }
#ifndef FP8_EVEN
#define FP8_EVEN 1
#endif
#ifndef FP8_ODD
#define FP8_ODD 1
#endif
__device__ __forceinline__ unsigned pk4_fp8x8(float a, float b, float c, float d) {
    int pk = 0; pk = __builtin_amdgcn_cvt_pk_fp8_f32(__builtin_amdgcn_fmed3f(a * 8.0f, -448.f, 448.f), __builtin_amdgcn_fmed3f(b * 8.0f, -448.f, 448.f), pk, false);
    pk = __builtin_amdgcn_cvt_pk_fp8_f32(__builtin_amdgcn_fmed3f(c * 8.0f, -448.f, 448.f), __builtin_amdgcn_fmed3f(d * 8.0f, -448.f, 448.f), pk, true); return (unsigned)pk; }
__device__ __forceinline__ float bflo(unsigned w) { return __builtin_bit_cast(float, w << 16); }
__device__ __forceinline__ float bfhi(unsigned w) { return __builtin_bit_cast(float, w & 0xffff0000u); }
__device__ __forceinline__ float asf(unsigned u) { return __builtin_bit_cast(float, u); }
__device__ __forceinline__ unsigned asu(float f) { return __builtin_bit_cast(unsigned, f); }
__device__ __forceinline__ float dot2bf(unsigned a, unsigned b, float c) { return __builtin_amdgcn_fdot2_f32_bf16(__builtin_bit_cast(bf16x2_t, a), __builtin_bit_cast(bf16x2_t, b), c, false); }
#define XB_TMO      128
#define XB_XCNT(j)  (256  + 64 * (j))
#define XB_XSUB(j)  (1280 + 64 * (j))
#define XB_XGEN(j)  (2304 + 64 * (j))
#define XB_TOP      3328
#define XB_TOPGEN   3392
#define XCD_BAR_WORDS 3456
#define XB_MISM     3520
#define XB_LSUB(j)  (3584 + 64 * (j))
#define XB_LGEN(j)  (4608 + 64 * (j))
#define XB_SPIN_CAP (1u << 18)

__device__ __forceinline__ unsigned xb_ld(unsigned* p)              { return __hip_atomic_load(p, __ATOMIC_RELAXED, __HIP_MEMORY_SCOPE_AGENT); }
__device__ __forceinline__ unsigned xb_add(unsigned* p, unsigned v) { return __hip_atomic_fetch_add(p, v, __ATOMIC_RELAXED, __HIP_MEMORY_SCOPE_AGENT); }
__device__ __forceinline__ unsigned xb_xcc_id() { return (unsigned)__builtin_amdgcn_s_getreg((3 << 11) | 20) & 0xFu; }
#define XB_SPIN(cond, bar) do { unsigned _sp = 0; while (cond) { __builtin_amdgcn_s_sleep(1); \
    if ((++_sp & 255u) == 0u) { if (xb_ld(&(bar)[XB_TMO])) break; if (_sp > XB_SPIN_CAP) { atomicAdd(&(bar)[XB_TMO], 1u); break; } } } } while (0)

struct XcdBarrier {
    unsigned* bar; unsigned x;
    volatile LAS unsigned* st;
};

__device__ __forceinline__ XcdBarrier xcd_barrier_post(unsigned* bar, volatile LAS unsigned* st, bool leader) {
    XcdBarrier b; b.bar = bar; b.x = xb_xcc_id(); b.st = st;
    if (leader) { (void)xb_add(&bar[XB_XCNT(b.x)], 1u); if (b.x != (blockIdx.x & 7u)) (void)xb_add(&bar[XB_MISM], 1u); }
    return b;
}
__device__ __forceinline__ void xcd_barrier_complete(unsigned* bar, unsigned x, unsigned& nloc, unsigned& nx) {
    const unsigned G = gridDim.x * gridDim.y * gridDim.z;
    unsigned sum, cnt, mine, sp = 0u;
    for (;;) {
        sum = 0u; cnt = 0u; mine = 0u;
#pragma unroll
        for (unsigned j = 0; j < 16; ++j) { const unsigned c = xb_ld(&bar[XB_XCNT(j)]); sum += c; cnt += (c > 0u) ? 1u : 0u; }
        mine = xb_ld(&bar[XB_XCNT(x)]);
        if (sum == G) break;
        __builtin_amdgcn_s_sleep(1);
        if ((++sp & 255u) == 0u) { if (xb_ld(&bar[XB_TMO])) break; if (sp > XB_SPIN_CAP) { atomicAdd(&bar[XB_TMO], 1u); break; } }
    }
    nloc = mine > 0u ? mine : 1u; nx = cnt > 0u ? cnt : 1u;
}

__device__ __forceinline__ void xcd_barrier(const XcdBarrier& b, bool leader) {
    asm volatile("s_waitcnt vmcnt(0)" ::: "memory");
    __syncthreads();
    if (leader) {
        unsigned* bar = b.bar;
        __builtin_amdgcn_s_waitcnt(0);
        unsigned nloc = b.st[0], nx = b.st[1];
        if (nloc == 0u) { xcd_barrier_complete(bar, b.x, nloc, nx); b.st[0] = nloc; b.st[1] = nx; }
        const bool first_ = b.st[3] == 0u; b.st[3] = 1u;
        const unsigned old = xb_add(&bar[XB_XSUB(b.x)], 1u);
        const unsigned gen = old / nloc;
        if (old + 1u == (gen + 1u) * nloc) {
            __builtin_amdgcn_fence(__ATOMIC_RELEASE, "agent");
            asm volatile("s_waitcnt vmcnt(0)" ::: "memory");
            const unsigned og = xb_add(&bar[XB_TOP], 1u);
            const unsigned tg = og / nx;
            if (og + 1u == (tg + 1u) * nx) xb_add(&bar[XB_TOPGEN], 1u);
            else XB_SPIN(xb_ld(&bar[XB_TOPGEN]) == tg, bar);
            __builtin_amdgcn_fence(__ATOMIC_ACQUIRE, "agent");
            xb_add(&bar[XB_XGEN(b.x)], 1u);
            asm volatile("s_waitcnt vmcnt(0)" ::: "memory");
        } else {
            XB_SPIN(xb_ld(&bar[XB_XGEN(b.x)]) == gen, bar);
            __builtin_amdgcn_fence(__ATOMIC_ACQUIRE, "agent");
            asm volatile("s_waitcnt vmcnt(0)" ::: "memory");
        }
        if (first_) {
            const unsigned G = gridDim.x; bool ok = (G == 256u) && xb_ld(&bar[XB_MISM]) == 0u;
#pragma unroll
            for (unsigned j = 0; j < 8; ++j) ok = ok && xb_ld(&bar[XB_XCNT(j)]) == G / 8u;
            b.st[2] = ok ? 1u : 0u; }
    }
    __syncthreads();
}
__device__ __forceinline__ bool xcd_local_ok(const XcdBarrier& b) { return b.st[2] != 0u; }
__device__ __forceinline__ void xcd_barrier_local(const XcdBarrier& b, bool leader) {
    asm volatile("s_waitcnt vmcnt(0)" ::: "memory");
    __syncthreads();
    if (leader) {
        unsigned* bar = b.bar;
        __builtin_amdgcn_s_waitcnt(0);
        const unsigned nloc = b.st[0];
        const unsigned old = xb_add(&bar[XB_LSUB(b.x)], 1u);
        const unsigned gen = old / nloc;
        if (old + 1u == (gen + 1u) * nloc) xb_add(&bar[XB_LGEN(b.x)], 1u);
        else XB_SPIN(xb_ld(&bar[XB_LGEN(b.x)]) == gen, bar);
        __builtin_amdgcn_fence(__ATOMIC_ACQUIRE, "agent");
        asm volatile("s_waitcnt vmcnt(0)" ::: "memory");
    }
    __syncthreads();
}
struct Args { const float* in[26]; float* out; unsigned char* ws; int ph_lo, ph_hi; };
typedef const unsigned char __attribute__((address_space(4)))* kptr_t;
struct KA { kptr_t kp;
    __device__ __forceinline__ const float* in(int k) const { return *(const float* const __attribute__((address_space(4)))*)(kp + 8 * k); }
    __device__ __forceinline__ float* out() const { return *(float* const __attribute__((address_space(4)))*)(kp + 208); }
    __device__ __forceinline__ unsigned char* ws() const { return *(unsigned char* const __attribute__((address_space(4)))*)(kp + 216); } };
struct Frame {
    LAS unsigned char* lds;
    volatile LAS unsigned* MISC;
    gu32* ctl;
    int tid, lane, wave;
    int vcu, G, bx;
    float* out; unsigned char* ws;
};
__device__ __forceinline__ float wave_sum(float v) {
    const int lane = mk_lane();
#pragma unroll
    for (int o = 1; o < 64; o <<= 1) v += lshfl(v, lane ^ o);
    return v;
}
template <bool ROPEPERM, bool F8 = false>
__device__ __forceinline__ void p0_transpose_item(const float* W, int K, int N, bf16* WT, LAS float* scr, int item, int lane) {
    const int nblk = N / 32, kb = item / nblk, nb = item % nblk, k0 = 64 * kb, n0 = 32 * nb;
    int ncol = n0 + (lane & 31);
    if (ROPEPERM && ncol < 2048) { const int pc = ncol & 63; ncol = (ncol & ~63) + (pc >> 1) + 32 * (pc & 1); }
#pragma unroll 8
    for (int i = 0; i < 32; ++i) { const int kk = 2 * i + (lane >> 5); scr[kk * 33 + (lane & 31)] = W[(size_t)(k0 + kk) * N + ncol]; }
    LDS_WAIT(); asm volatile("" ::: "memory");
    const int c = lane & 7;
#pragma unroll
    for (int j = 0; j < 4; ++j) { const int n = (lane >> 3) + 8 * j; const LAS float* s = scr + (8 * c) * 33 + n;
        if (F8) { v2u o; o.x = pk4_fp8x8(s[0 * 33] * 32.0f, s[1 * 33] * 32.0f, s[2 * 33] * 32.0f, s[3 * 33] * 32.0f); o.y = pk4_fp8x8(s[4 * 33] * 32.0f, s[5 * 33] * 32.0f, s[6 * 33] * 32.0f, s[7 * 33] * 32.0f);
            *(GAS v2u*)((unsigned char*)WT + (size_t)(n0 + n) * K + k0 + 8 * c) = o; continue; }
        v4u o; o.x = pk2(s[0 * 33], s[1 * 33]); o.y = pk2(s[2 * 33], s[3 * 33]); o.z = pk2(s[4 * 33], s[5 * 33]); o.w = pk2(s[6 * 33], s[7 * 33]);
        *(GAS v4u*)(WT + (size_t)(n0 + n) * K + k0 + 8 * c) = o; }
    LDS_WAIT(); asm volatile("" ::: "memory");
}
template <bool MASK>
__device__ __forceinline__ void cvt_row(const float* src, bf16* dst, int lane, int flat0) {
    const GAS f32x4* s4 = (const GAS f32x4*)src + lane; GAS v2u* d2 = (GAS v2u*)dst + lane;
#pragma unroll
    for (int j = 0; j < 4; ++j) { f32x4 v = s4[64 * j];
        if (MASK) { const int idx = flat0 + j * 256 + lane * 4; const int t = (idx >> 7) & 127, s = idx & 127;
            if (s + 0 > t) v.x = 0.f; if (s + 1 > t) v.y = 0.f; if (s + 2 > t) v.z = 0.f; if (s + 3 > t) v.w = 0.f; }
        v2u o; o.x = pk2(v.x, v.y); o.y = pk2(v.z, v.w); d2[64 * j] = o; }
}
template <int OFFS>
__device__ __forceinline__ void quant_rows4(const float* src, unsigned char* dst, int dpitch, float* scale, int lane) {
    f32x4 v[4][4];
#pragma unroll
    for (int r = 0; r < 4; ++r)
#pragma unroll
        for (int j = 0; j < 4; ++j) v[r][j] = *((const GAS f32x4*)(src + (size_t)r * 1024) + lane + 64 * j);
#pragma unroll
    for (int r = 0; r < 4; ++r) { float am = 0.f;
#pragma unroll
        for (int j = 0; j < 4; ++j) am = __builtin_fmaxf(am, __builtin_fmaxf(__builtin_fmaxf(__builtin_fabsf(v[r][j].x), __builtin_fabsf(v[r][j].y)), __builtin_fmaxf(__builtin_fabsf(v[r][j].z), __builtin_fabsf(v[r][j].w))));
#pragma unroll
        for (int o = 1; o < 64; o <<= 1) am = __builtin_fmaxf(am, lshfl(am, lane ^ o));
        const float sc = am > 0.f ? am * (OFFS == -8 ? 1.0f / 448.0f : 1.0f / 127.0f) : 1.0f, inv = 1.0f / sc; GAS unsigned* d1 = (GAS unsigned*)(dst + (size_t)r * dpitch) + lane;
#pragma unroll
        for (int j = 0; j < 4; ++j) { if (OFFS == -8) {
                int pk = 0; pk = __builtin_amdgcn_cvt_pk_fp8_f32(v[r][j].x * inv, v[r][j].y * inv, pk, false); pk = __builtin_amdgcn_cvt_pk_fp8_f32(v[r][j].z * inv, v[r][j].w * inv, pk, true); d1[64 * j] = (unsigned)pk; continue; } const int a = (int)__builtin_rintf(v[r][j].x * inv) + OFFS, b = (int)__builtin_rintf(v[r][j].y * inv) + OFFS, c = (int)__builtin_rintf(v[r][j].z * inv) + OFFS, d = (int)__builtin_rintf(v[r][j].w * inv) + OFFS;
            d1[64 * j] = (unsigned)(a & 255) | ((unsigned)(b & 255) << 8) | ((unsigned)(c & 255) << 16) | ((unsigned)(d & 255) << 24); }
        if (lane == 0) scale[r] = sc; }
}
__device__ __forceinline__ void quant_rows4_u4(const float* src, unsigned char* dst, int dpitch, float* scale, int lane) {
    f32x4 v[4][4];
#pragma unroll
    for (int r = 0; r < 4; ++r)
#pragma unroll
        for (int j = 0; j < 4; ++j) v[r][j] = *((const GAS f32x4*)(src + (size_t)r * 1024) + lane + 64 * j);
#pragma unroll
    for (int r = 0; r < 4; ++r) { float s2 = 0.f;
#pragma unroll
        for (int j = 0; j < 4; ++j) s2 += (v[r][j].x * v[r][j].x + v[r][j].y * v[r][j].y) + (v[r][j].z * v[r][j].z + v[r][j].w * v[r][j].w);
        s2 = wave_sum(s2);
        const float sc = s2 > 0.f ? 0.3352f * sqrtf(s2 * (1.0f / 1024.0f)) : 1.0f, inv = 1.0f / sc; GAS unsigned short* d1 = (GAS unsigned short*)(dst + (size_t)r * dpitch) + lane;
#pragma unroll
        for (int j = 0; j < 4; ++j) { const float c0 = __builtin_fminf(__builtin_fmaxf(__builtin_rintf(v[r][j].x * inv + 7.5f), 0.f), 15.f), c1 = __builtin_fminf(__builtin_fmaxf(__builtin_rintf(v[r][j].y * inv + 7.5f), 0.f), 15.f),
                c2 = __builtin_fminf(__builtin_fmaxf(__builtin_rintf(v[r][j].z * inv + 7.5f), 0.f), 15.f), c3 = __builtin_fminf(__builtin_fmaxf(__builtin_rintf(v[r][j].w * inv + 7.5f), 0.f), 15.f);
            d1[64 * j] = (unsigned short)((unsigned)c0 | ((unsigned)c1 << 4) | ((unsigned)c2 << 8) | ((unsigned)c3 << 12)); }
        if (lane == 0) scale[r] = sc; }
}
__device__ __forceinline__ void quant_rows4_fp4(const float* src, unsigned char* dst, int dpitch, float* scale, int lane) {
    f32x4 v[4][4];
#pragma unroll
    for (int r = 0; r < 4; ++r)
#pragma unroll
        for (int j = 0; j < 4; ++j) v[r][j] = *((const GAS f32x4*)(src + (size_t)r * 1024) + lane + 64 * j);
#pragma unroll
    for (int r = 0; r < 4; ++r) { float s2 = 0.f;
#pragma unroll
        for (int j = 0; j < 4; ++j) s2 += (v[r][j].x * v[r][j].x + v[r][j].y * v[r][j].y) + (v[r][j].z * v[r][j].z + v[r][j].w * v[r][j].w);
        s2 = wave_sum(s2);
        const float sc = s2 > 0.f ? 0.5f * sqrtf(s2 * (1.0f / 1024.0f)) : 1.0f, inv = 1.0f / sc; GAS unsigned short* d1 = (GAS unsigned short*)(dst + (size_t)r * dpitch) + lane;
#pragma unroll
        for (int j = 0; j < 4; ++j) { const float c0 = __builtin_fminf(__builtin_fmaxf(v[r][j].x * inv, -6.f), 6.f), c1 = __builtin_fminf(__builtin_fmaxf(v[r][j].y * inv, -6.f), 6.f),
                c2 = __builtin_fminf(__builtin_fmaxf(v[r][j].z * inv, -6.f), 6.f), c3 = __builtin_fminf(__builtin_fmaxf(v[r][j].w * inv, -6.f), 6.f);
            unsigned pk = 0u; pk = __builtin_amdgcn_cvt_scalef32_pk_fp4_f32(pk, c0, c1, 1.0f, 0); pk = __builtin_amdgcn_cvt_scalef32_pk_fp4_f32(pk, c2, c3, 1.0f, 1);
            d1[64 * j] = (unsigned short)pk; }
        if (lane == 0) scale[r] = sc; }
}
constexpr int I_WINE = 2 * 16 * 48, I_WOUTE = 2 * 16 * 32, I_WINO = 2 * 16 * 96, I_WOUTO = 2 * 16 * 32, I_WQ = 4 * 16 * 64, I_WPT = 8 * 8;
constexpr int I_RU = 16384, I_RV = 16384  , I_RSK = 1024, I_RWS = 128, I_ROPE = M * 32 / 64;
constexpr int NITEMS = I_WINE + I_WOUTE + I_WINO + I_WOUTO + I_WQ + I_WPT + I_RU + I_RV + I_RSK + I_RWS + I_ROPE;
__device__ __forceinline__ void p0_prologue(Frame& F, const KA& A) {
    unsigned char* ws = F.ws; const int lane = mk_lane();
    for (int item = F.vcu; item < 4 * 48 + ((F.G - (4 * 48) % F.G) % F.G); item += F.G) {
        float acc[8][2];
#pragma unroll
        for (int b = 0; b < 8; ++b) { acc[b][0] = 0.f; acc[b][1] = 0.f; }
        const bool live = item < 4 * 48; const int l = live ? item / 48 : 0, nb = live ? item % 48 : 0;
        if (live) { const float* W = A.in(3) + (size_t)l * 1024 * 6144 + nb * 128 + 2 * lane; const float* c = A.in(1);
#pragma unroll 1
            for (int kb = 0; kb < 2; ++kb) { const int k0 = F.wave * 128 + kb * 64;
                float cv[8];
#pragma unroll
                for (int b = 0; b < 8; ++b) { const float x = c[b * 1024 + k0 + lane]; cv[b] = x / (1.0f + __expf(-x)); }
#pragma unroll 16
                for (int kk = 0; kk < 64; ++kk) { const f32x2 w = *(const GAS f32x2*)(W + (size_t)(k0 + kk) * 6144);
#pragma unroll
                    for (int b = 0; b < 8; ++b) { const float cb = asf(__builtin_amdgcn_readlane(asu(cv[b]), kk)); acc[b][0] += cb * w.x; acc[b][1] += cb * w.y; } } } }
        LAS float* red = (LAS float*)(F.lds + RING_OFF);
#pragma unroll
        for (int b = 0; b < 8; ++b) *(LAS f32x2*)(red + (F.wave * 8 + b) * 128 + 2 * lane) = (f32x2){acc[b][0], acc[b][1]};
        LDS_WAIT(); __syncthreads();
        if (live) { const int t = F.wave * 64 + lane;
#pragma unroll
            for (int q = 0; q < 2; ++q) { const int o = t + 512 * q, b = o >> 7, col = o & 127; float sum = 0.f;
#pragma unroll
                for (int w = 0; w < 8; ++w) sum += red[(w * 8 + b) * 128 + col];
                ((float*)(ws + WS_MOD))[((size_t)l * 8 + b) * 6144 + nb * 128 + col] = sum + A.in(4)[l * 6144 + nb * 128 + col]; } }
        LDS_WAIT(); __syncthreads();
    }
    LAS float* scr = (LAS float*)(F.lds + RING_OFF + F.wave * 16384);
    const int gw = F.vcu * NWAVES + F.wave, NGW = F.G * NWAVES;
    for (int it = gw; it < NITEMS; it += NGW) {
        int r = it;
        if (r < I_WINE) { const int e = r / 768; p0_transpose_item<false, FP8_EVEN != 0>(A.in(7) + (size_t)e * 1024 * 1536, 1024, 1536, (bf16*)(ws + WS_WINE + (size_t)e * 1536 * 1024 * (FP8_EVEN ? 1 : 2)), scr, r % 768, lane); continue; } r -= I_WINE;
        if (r < I_WOUTE) { const int e = r / 512; p0_transpose_item<false>(A.in(13) + (size_t)e * 1024 * 1024, 1024, 1024, (bf16*)(ws + WS_WOUTE) + (size_t)e * 1024 * 1024, scr, r % 512, lane); continue; } r -= I_WOUTE;
        if (r < I_WINO) { const int e = r / 1536; p0_transpose_item<true, FP8_ODD != 0>(A.in(14) + (size_t)e * 1024 * 3072, 1024, 3072, (bf16*)(ws + WS_WINO + (size_t)e * 3072 * 1024 * (FP8_ODD ? 1 : 2)), scr, r % 1536, lane); continue; } r -= I_WINO;
        if (r < I_WOUTO) { const int e = r / 512; p0_transpose_item<false>(A.in(20) + (size_t)e * 1024 * 1024, 1024, 1024, (bf16*)(ws + WS_WOUTO) + (size_t)e * 1024 * 1024, scr, r % 512, lane); continue; } r -= I_WOUTO;
        if (r < I_WQ) { const int e = r / 1024; p0_transpose_item<false>(A.in(21) + (size_t)e * 1024 * 2048, 1024, 2048, (bf16*)(ws + WS_WQ) + (size_t)e * 2048 * 1024, scr, r % 1024, lane); continue; } r -= I_WQ;
        if (r < I_WPT) { const int e = r / 8; p0_transpose_item<false>(A.in(11) + (size_t)e * 128 * 128, 128, 128, (bf16*)(ws + WS_WPT) + (size_t)e * 128 * 128, scr, r % 8, lane); continue; } r -= I_WPT;
        if (r < I_RU) { quant_rows4_fp4(A.in(23) + (size_t)r * 4096, ws + WS_UV + (size_t)r * (4 * PEER_REC), PEER_REC, (float*)(ws + WS_SU) + 4 * r, lane); continue; } r -= I_RU;
        if (r < I_RV) { quant_rows4_fp4(A.in(24) + (size_t)r * 4096, ws + WS_UV + 512 + (size_t)r * (4 * PEER_REC), PEER_REC, (float*)(ws + WS_SV) + 4 * r, lane); continue; } r -= I_RV;
        if (r < I_RSK) { cvt_row<false>(A.in(22) + (size_t)r * 1024, (bf16*)(ws + WS_SUBK) + (size_t)r * 1024, lane, 0); continue; } r -= I_RSK;
        if (r < I_RWS) { cvt_row<true>(A.in(9) + (size_t)r * 1024, (bf16*)(ws + WS_WSG) + (size_t)r * 1024, lane, r * 1024); continue; } r -= I_RWS;
        {
            const int idx = r * 64 + lane, row = idx >> 5, i = idx & 31;
            const int pos = ((const int*)A.in(2))[row];
            const float g = __builtin_amdgcn_exp2f(-0.41524101186092029f * (float)i) * 0.15915494309189535f, fp = (float)pos;
            const float fr = __builtin_fmaf(fp, g, -__builtin_rintf(fp * g));
            const float s = __builtin_amdgcn_sinf(fr), c = __builtin_amdgcn_cosf(fr);
            ((GAS f32x2*)(ws + WS_ROPE))[idx] = (f32x2){c, s};
        }
    }
}

__device__ __forceinline__ void norm_phase(Frame& F, const float* src, const float* gain, const float* sh, const float* sc, bf16* dst) {
    const int gw = F.vcu * NWAVES + F.wave, NGW = F.G * NWAVES, lane = mk_lane();
    const GAS f32x4* g4 = (const GAS f32x4*)gain + lane;
    for (int m0 = 4 * gw; m0 < M; m0 += 4 * NGW) {
        const int b = m0 >> 12;
        const GAS f32x4* s4 = (const GAS f32x4*)(sh + (size_t)b * 6144) + lane; const GAS f32x4* c4 = (const GAS f32x4*)(sc + (size_t)b * 6144) + lane;
        f32x4 v[4][4]; float s2[4];
#pragma unroll
        for (int r = 0; r < 4; ++r) { const GAS f32x4* xr = (const GAS f32x4*)(src + (size_t)(m0 + r) * 1024) + lane;
#pragma unroll
            for (int j = 0; j < 4; ++j) v[r][j] = xr[64 * j]; }
        f32x4 gm_[4], aq_[4];
#pragma unroll
        for (int j = 0; j < 4; ++j) { const f32x4 g = g4[64 * j], c = c4[64 * j]; aq_[j] = s4[64 * j]; gm_[j] = g * (c + 1.0f); }
#pragma unroll
        for (int r = 0; r < 4; ++r) { float t = 0.f;
#pragma unroll
            for (int j = 0; j < 4; ++j) t += (v[r][j].x * v[r][j].x + v[r][j].y * v[r][j].y) + (v[r][j].z * v[r][j].z + v[r][j].w * v[r][j].w);
            s2[r] = t; }
#pragma unroll
        for (int o = 1; o < 64; o <<= 1) {
#pragma unroll
            for (int r = 0; r < 4; ++r) s2[r] += lshfl(s2[r], lane ^ o); }
#pragma unroll
        for (int r = 0; r < 4; ++r) { const float rstd = 1.0f / sqrtf(s2[r] * (1.0f / 1024.0f) + RMS_EPS); const int m = m0 + r;
            GAS unsigned* o1 = (GAS unsigned*)((unsigned char*)dst + (size_t)m * 1024) + lane;
            GAS v2u* o2 = (GAS v2u*)(dst + (size_t)m * 1024) + lane;
#pragma unroll
            for (int j = 0; j < 4; ++j) { const f32x4 o = v[r][j] * rstd * gm_[j] + aq_[j]; if (FP8_EVEN) o1[64 * j] = pk4_fp8x8(o.x, o.y, o.z, o.w); else { v2u w; w.x = pk2(o.x, o.y); w.y = pk2(o.z, o.w); o2[64 * j] = w; } } }
    }
}
__device__ __forceinline__ void shw_items(Frame& F) {
    const int gw = F.vcu * NWAVES + F.wave, NGW = F.G * NWAVES, lane = mk_lane();
    const bf16* WQ = (const bf16*)(F.ws + WS_WQ); const float* mod = (const float*)(F.ws + WS_MOD); float* shw = (float*)(F.ws + WS_SHW);
    for (int it = gw; it < 4 * 2048; it += NGW) { const int l = it >> 11, n = it & 2047;
        const v4u wa = *(const GAS v4u*)(WQ + ((size_t)l * 2048 + n) * 1024 + lane * 16), wb = *(const GAS v4u*)(WQ + ((size_t)l * 2048 + n) * 1024 + lane * 16 + 8);
        const unsigned ww[8] = {wa.x, wa.y, wa.z, wa.w, wb.x, wb.y, wb.z, wb.w}; float wf[16];
#pragma unroll
        for (int j = 0; j < 8; ++j) { wf[2 * j] = bflo(ww[j]); wf[2 * j + 1] = bfhi(ww[j]); }
        float res = 0.f;
#pragma unroll
        for (int b = 0; b < 8; ++b) { const float* sh = mod + ((size_t)l * 8 + b) * 6144 + 3072 + lane * 16; float d = 0.f;
#pragma unroll
            for (int q = 0; q < 4; ++q) { const f32x4 s4 = *(const GAS f32x4*)(sh + 4 * q); d += (s4.x * wf[4 * q] + s4.y * wf[4 * q + 1]) + (s4.z * wf[4 * q + 2] + s4.w * wf[4 * q + 3]); }
            d = wave_sum(d); res = (lane == b) ? d : res; }
        if (lane < 8) shw[((size_t)l * 8 + lane) * 2048 + n] = res; }
}
__device__ __forceinline__ void final_norm_phase(Frame& F, const float* src, const float* gain, float* dst) {
    const int gw = F.vcu * NWAVES + F.wave, NGW = F.G * NWAVES, lane = mk_lane();
    const GAS f32x4* g4 = (const GAS f32x4*)gain + lane;
    for (int m = gw; m < M; m += NGW) {
        const GAS f32x4* xr = (const GAS f32x4*)(src + (size_t)m * 1024) + lane;
        f32x4 v[4]; float s2 = 0.f;
#pragma unroll
        for (int j = 0; j < 4; ++j) { v[j] = xr[64 * j]; s2 += (v[j].x * v[j].x + v[j].y * v[j].y) + (v[j].z * v[j].z + v[j].w * v[j].w); }
        const float rstd = 1.0f / sqrtf(wave_sum(s2) * (1.0f / 1024.0f) + RMS_EPS);
        GAS f32x4* o4 = (GAS f32x4*)(dst + (size_t)m * 1024) + lane;
#pragma unroll
        for (int j = 0; j < 4; ++j) o4[64 * j] = v[j] * rstd * g4[64 * j];
#ifdef PROBE_TIME
        { const float cval = (float)(((const unsigned*)(F.ws + WS_CTL) + 2048)[PROBE_TIME]) * 0.00025f;
#pragma unroll
          for (int j = 0; j < 4; ++j) o4[64 * j] = (f32x4){cval, cval, cval, cval}; }
#endif
    }
}

__device__ __forceinline__ s16x4 tr16(LAS const unsigned char* p) { typedef short v4i16_t __attribute__((ext_vector_type(4))); return __builtin_bit_cast(s16x4, __builtin_amdgcn_ds_read_tr16_b64_v4i16((LAS v4i16_t*)p)); }
__device__ __forceinline__ void e2_phase(Frame& F, const KA& A, int e) {
    const int lane = mk_lane(), wave = F.wave, r32 = lane & 31, hi = lane >> 5;
    const bf16* PROJ = (const bf16*)(F.ws + WS_PROJ); bf16* MIX = (bf16*)(F.ws + WS_MIX);
    const bf16* WSG = (const bf16*)(F.ws + WS_WSG) + (size_t)e * 4 * 128 * 128; const bf16* WPT = (const bf16*)(F.ws + WS_WPT) + (size_t)e * 4 * 128 * 128;
    const float* gv = A.in(8) + e * 512; const float* bs = A.in(10) + e * 512; const float* ls = A.in(12) + e * 512;
    LAS unsigned char* lds = F.lds;
    for (int unit = F.vcu; unit < M / 128; unit += F.G) {
        const int row0 = unit * 128, pos0 = (unit & 31) * 128;
        {
            const f32x4 ga = *(const GAS f32x4*)(gv + lane * 8), gb = *(const GAS f32x4*)(gv + lane * 8 + 4);
            v4u raw[16];
#pragma unroll
            for (int tt = 0; tt < 16; ++tt) raw[tt] = *(const GAS v4u*)(PROJ + (size_t)(row0 + wave * 16 + tt) * 1536 + 512 + lane * 8);
#pragma unroll
            for (int hf = 0; hf < 2; ++hf) { float x[8][8], sm[8], q[8];
#pragma unroll
                for (int tt = 0; tt < 8; ++tt) { const v4u r = raw[hf * 8 + tt];
                    x[tt][0] = bflo(r.x); x[tt][1] = bfhi(r.x); x[tt][2] = bflo(r.y); x[tt][3] = bfhi(r.y); x[tt][4] = bflo(r.z); x[tt][5] = bfhi(r.z); x[tt][6] = bflo(r.w); x[tt][7] = bfhi(r.w);
                    float t = 0.f;
#pragma unroll
                    for (int j = 0; j < 8; ++j) t += x[tt][j];
                    sm[tt] = t; }
#pragma unroll
                for (int o = 1; o < 64; o <<= 1) {
#pragma unroll
                    for (int tt = 0; tt < 8; ++tt) sm[tt] += lshfl(sm[tt], lane ^ o); }
#pragma unroll
                for (int tt = 0; tt < 8; ++tt) { const float mu = sm[tt] * (1.0f / 512.0f); float t = 0.f;
#pragma unroll
                    for (int j = 0; j < 8; ++j) { x[tt][j] -= mu; t += x[tt][j] * x[tt][j]; }
                    q[tt] = t; }
#pragma unroll
                for (int o = 1; o < 64; o <<= 1) {
#pragma unroll
                    for (int tt = 0; tt < 8; ++tt) q[tt] += lshfl(q[tt], lane ^ o); }
#pragma unroll
                for (int tt = 0; tt < 8; ++tt) { const int s = wave * 16 + hf * 8 + tt;
                    const float rstd = 1.0f / sqrtf(q[tt] * (1.0f / 512.0f) + RMS_EPS);
                    v4u o; o.x = pk2(x[tt][0] * rstd * ga.x, x[tt][1] * rstd * ga.y); o.y = pk2(x[tt][2] * rstd * ga.z, x[tt][3] * rstd * ga.w);
                    o.z = pk2(x[tt][4] * rstd * gb.x, x[tt][5] * rstd * gb.y); o.w = pk2(x[tt][6] * rstd * gb.z, x[tt][7] * rstd * gb.w);
                    const int g = lane >> 4, c = (lane & 15) * 8;
                    *(LAS v4u*)(lds + g * 32768 + (c >> 5) * 8192 + s * 64 + (c & 31) * 2) = o; } }
        }
        LDS_WAIT(); __syncthreads();
        const int tt2 = wave >> 1, ch = wave & 1;
        const int t = 32 * tt2 + r32, row = row0 + t;
        bf16x8 wf[2][8];
#pragma unroll
        for (int ks = 0; ks < 8; ++ks) wf[0][ks] = *(const GAS bf16x8*)(WSG + (size_t)t * 128 + 8 * hi + 16 * ks);
#pragma unroll
        for (int g = 0; g < 4; ++g) {
            f32x16 acc[2]; acc[0] = f32x16{}; acc[1] = f32x16{};
            if (g + 1 < 4) {
#pragma unroll
                for (int ks = 0; ks < 8; ++ks) wf[(g + 1) & 1][ks] = *(const GAS bf16x8*)(WSG + (size_t)((g + 1) * 128 + t) * 128 + 8 * hi + 16 * ks); }
            v2u uu[2][4];
#pragma unroll
            for (int cc = 0; cc < 2; ++cc)
#pragma unroll
                for (int q = 0; q < 4; ++q) uu[cc][q] = *(const GAS v2u*)(PROJ + (size_t)row * 1536 + g * 128 + 32 * (2 * ch + cc) + 8 * q + 4 * hi);
            const float bsv = bs[g * 128 + t];
#pragma unroll
            for (int ks = 0; ks < 8; ++ks) { const bf16x8 bfrag = wf[g & 1][ks];
#pragma unroll
                for (int cc = 0; cc < 2; ++cc) { const int ct = 2 * ch + cc;
                    LAS const unsigned char* ap = lds + g * 32768 + ct * 8192 + (16 * ks) * 64 + ((lane >> 4) & 1) * 32 + (lane & 3) * 8 + (8 * hi + ((lane & 15) >> 2)) * 64;
                    const s16x4 lo = tr16(ap), h4 = tr16(ap + 256);
                    const bf16x8 afrag = (bf16x8){lo[0], lo[1], lo[2], lo[3], h4[0], h4[1], h4[2], h4[3]};
                    acc[cc] = __builtin_amdgcn_mfma_f32_32x32x16_bf16(afrag, bfrag, acc[cc], 0, 0, 0); } }
#pragma unroll
            for (int cc = 0; cc < 2; ++cc)
#pragma unroll
                for (int q = 0; q < 4; ++q) { const int c0 = 32 * (2 * ch + cc) + 8 * q + 4 * hi; const v2u u2 = uu[cc][q];
                    v2u o; o.x = pk2(bflo(u2.x) * (acc[cc][4 * q] + bsv), bfhi(u2.x) * (acc[cc][4 * q + 1] + bsv)); o.y = pk2(bflo(u2.y) * (acc[cc][4 * q + 2] + bsv), bfhi(u2.y) * (acc[cc][4 * q + 3] + bsv));
                    *(GAS v2u*)(MIX + (size_t)row * 1024 + g * 128 + c0) = o; }
        }
        LDS_WAIT(); __syncthreads();
        {
            v4u st[18];
#pragma unroll
            for (int i = 0; i < 18; ++i) { const int c = F.wave * 64 + lane + 512 * i; const int rr = c >> 6, c16 = c & 63, tt = rr - 15;
                st[i] = (v4u){0u, 0u, 0u, 0u}; if (c < 143 * 64 && pos0 + tt >= 0) st[i] = *(const GAS v4u*)(PROJ + (size_t)(row0 + tt) * 1536 + 1024 + c16 * 8); }
#pragma unroll
            for (int i = 0; i < 18; ++i) { const int c = F.wave * 64 + lane + 512 * i; const int rr = c >> 6, c16 = c & 63;
                if (c < 143 * 64) *(LAS v4u*)(lds + rr * 1040 + c16 * 16) = st[i]; }
        }
        LDS_WAIT(); __syncthreads();
        const int pos = pos0 + t;
#pragma unroll 1
        for (int g = 0; g < 4; ++g) { const int w = 2 << g;
            f32x16 acc[2]; acc[0] = f32x16{}; acc[1] = f32x16{};
            const int cnt = (pos + 1 < w) ? pos + 1 : w; const float rc = 1.0f / (float)cnt;
            bf16x8 af[8][2];
#pragma unroll
            for (int ks = 0; ks < 8; ++ks)
#pragma unroll
                for (int cc = 0; cc < 2; ++cc) af[ks][cc] = *(const GAS bf16x8*)(WPT + (size_t)(g * 128 + 32 * (2 * ch + cc) + r32) * 128 + 16 * ks + 8 * hi);
#pragma unroll
            for (int ks = 0; ks < 8; ++ks) {
                LAS const unsigned char* pp = lds + (t + 15) * 1040 + (g * 128 + 16 * ks + 8 * hi) * 2;
                float sum[8], own[8];
                { const v4u raw = *(const LAS v4u*)pp; own[0] = bflo(raw.x); own[1] = bfhi(raw.x); own[2] = bflo(raw.y); own[3] = bfhi(raw.y); own[4] = bflo(raw.z); own[5] = bfhi(raw.z); own[6] = bflo(raw.w); own[7] = bfhi(raw.w); }
#pragma unroll
                for (int j = 0; j < 8; ++j) sum[j] = own[j];
#pragma unroll 2
                for (int j2 = 1; j2 < w; ++j2) { const v4u raw = *(const LAS v4u*)(pp - j2 * 1040);
                    sum[0] += bflo(raw.x); sum[1] += bfhi(raw.x); sum[2] += bflo(raw.y); sum[3] += bfhi(raw.y); sum[4] += bflo(raw.z); sum[5] += bfhi(raw.z); sum[6] += bflo(raw.w); sum[7] += bfhi(raw.w); }
                v4u pk; pk.x = pk2(sum[0] * rc - own[0], sum[1] * rc - own[1]); pk.y = pk2(sum[2] * rc - own[2], sum[3] * rc - own[3]); pk.z = pk2(sum[4] * rc - own[4], sum[5] * rc - own[5]); pk.w = pk2(sum[6] * rc - own[6], sum[7] * rc - own[7]);
                const bf16x8 bfrag = __builtin_bit_cast(bf16x8, pk);
#pragma unroll
                for (int cc = 0; cc < 2; ++cc) acc[cc] = __builtin_amdgcn_mfma_f32_32x32x16_bf16(af[ks][cc], bfrag, acc[cc], 0, 0, 0); }
#pragma unroll
            for (int cc = 0; cc < 2; ++cc)
#pragma unroll
                for (int q = 0; q < 4; ++q) { const int d0 = 32 * (2 * ch + cc) + 8 * q + 4 * hi; const f32x4 lq = *(const GAS f32x4*)(ls + g * 128 + d0);
                    v2u o; o.x = pk2(acc[cc][4 * q] * lq.x, acc[cc][4 * q + 1] * lq.y); o.y = pk2(acc[cc][4 * q + 2] * lq.z, acc[cc][4 * q + 3] * lq.w);
                    *(GAS v2u*)(MIX + (size_t)row * 1024 + 512 + g * 128 + d0) = o; }
        }
        LDS_WAIT(); __syncthreads();
    }
}

__device__ __forceinline__ void combine_phase(Frame& F, const KA& A, int o, float lam_init) {
    const int gw = F.vcu * NWAVES + F.wave, NGW = F.G * NWAVES, lane = mk_lane();
    const float s1 = wave_sum(A.in(15)[o * 64 + lane] * A.in(16)[o * 64 + lane]), s2 = wave_sum(A.in(17)[o * 64 + lane] * A.in(18)[o * 64 + lane]);
    const float lam = __expf(s1) - __expf(s2) + lam_init, post = 1.0f - lam_init;
    const int h = lane >> 3, dv0 = (lane & 7) * 16;
    float gs[16];
#pragma unroll
    for (int j = 0; j < 16; ++j) gs[j] = A.in(19)[o * 128 + dv0 + j] * post;
    bf16* OATT = (bf16*)(F.ws + WS_OATT);
    for (int m = gw; m < M; m += NGW) {
        bf16* rowp = OATT + (size_t)m * 2048;
        const v4u a0 = *(const GAS v4u*)(rowp + (2 * h) * 128 + dv0), a1 = *(const GAS v4u*)(rowp + (2 * h) * 128 + dv0 + 8);
        const v4u b0 = *(const GAS v4u*)(rowp + (2 * h + 1) * 128 + dv0), b1 = *(const GAS v4u*)(rowp + (2 * h + 1) * 128 + dv0 + 8);
        const unsigned aw[8] = {a0.x, a0.y, a0.z, a0.w, a1.x, a1.y, a1.z, a1.w}, bw[8] = {b0.x, b0.y, b0.z, b0.w, b1.x, b1.y, b1.z, b1.w};
        float ov[16]; float q = 0.f;
#pragma unroll
        for (int j = 0; j < 8; ++j) { ov[2 * j] = bflo(aw[j]) - lam * bflo(bw[j]); ov[2 * j + 1] = bfhi(aw[j]) - lam * bfhi(bw[j]); q += ov[2 * j] * ov[2 * j] + ov[2 * j + 1] * ov[2 * j + 1]; }
        q += lshfl(q, lane ^ 1); q += lshfl(q, lane ^ 2); q += lshfl(q, lane ^ 4);
        const float rstd = 1.0f / sqrtf(q * (1.0f / 128.0f) + RMS_EPS);
        v4u o0, o1;
        o0.x = pk2(ov[0] * rstd * gs[0], ov[1] * rstd * gs[1]); o0.y = pk2(ov[2] * rstd * gs[2], ov[3] * rstd * gs[3]); o0.z = pk2(ov[4] * rstd * gs[4], ov[5] * rstd * gs[5]); o0.w = pk2(ov[6] * rstd * gs[6], ov[7] * rstd * gs[7]);
        o1.x = pk2(ov[8] * rstd * gs[8], ov[9] * rstd * gs[9]); o1.y = pk2(ov[10] * rstd * gs[10], ov[11] * rstd * gs[11]); o1.z = pk2(ov[12] * rstd * gs[12], ov[13] * rstd * gs[13]); o1.w = pk2(ov[14] * rstd * gs[14], ov[15] * rstd * gs[15]);
        asm volatile("" ::: "memory");
        *(GAS v4u*)(rowp + h * 128 + dv0) = o0; *(GAS v4u*)(rowp + h * 128 + dv0 + 8) = o1;
    }
}
__device__ __forceinline__ float med3f(float a, float b, float c) { return __builtin_amdgcn_fmed3f(a, b, c); }
#define INS16(L, x) do { _Pragma("unroll") for (int i_ = 15; i_ >= 1; --i_) L[i_] = med3f(L[i_ - 1], L[i_], (x)); L[0] = __builtin_fmaxf(L[0], (x)); } while (0)
__device__ __forceinline__ void topk128_sorted(const bf16x8 (&bq)[8], LAS const unsigned char* skl, int hi, int r32, float (&S)[16]) {
    f32x16 acc[4]; acc[0] = f32x16{}; acc[1] = f32x16{}; acc[2] = f32x16{}; acc[3] = f32x16{};
    LAS const unsigned char* sp = skl + r32 * 272 + 16 * hi;
#pragma unroll
    for (int kc = 0; kc < 8; ++kc) {
#pragma unroll
        for (int kt = 0; kt < 4; ++kt) { const bf16x8 a = *(const LAS bf16x8*)(sp + kt * 32 * 272 + 32 * kc);
            acc[kt] = __builtin_amdgcn_mfma_f32_32x32x16_bf16(a, bq[kc], acc[kt], 0, 0, 0); } }
    const unsigned hi4 = 4u * (unsigned)hi;
    float G[4][16];
#pragma unroll
    for (int kt = 0; kt < 4; ++kt) {
#pragma unroll
        for (int r = 0; r < 16; ++r) { const unsigned n = (unsigned)(32 * kt + (r & 3) + 8 * (r >> 2)) | hi4; G[kt][r] = asf((asu(acc[kt][r]) & ~127u) | n); }
#define CE(i, j) do { const float a_ = G[kt][i], b_ = G[kt][j]; G[kt][i] = __builtin_fmaxf(a_, b_); G[kt][j] = __builtin_fminf(a_, b_); } while (0);
        CE(0,1) CE(2,3) CE(0,2) CE(1,3) CE(1,2) CE(4,5) CE(6,7) CE(4,6) CE(5,7) CE(5,6) CE(0,4) CE(2,6) CE(2,4) CE(1,5) CE(3,7) CE(3,5) CE(1,2) CE(3,4) CE(5,6) CE(8,9) CE(10,11) CE(8,10) CE(9,11) CE(9,10) CE(12,13) CE(14,15) CE(12,14) CE(13,15) CE(13,14) CE(8,12) CE(10,14) CE(10,12) CE(9,13) CE(11,15) CE(11,13) CE(9,10) CE(11,12) CE(13,14) CE(0,8) CE(4,12) CE(4,8) CE(2,10) CE(6,14) CE(6,10) CE(2,4) CE(6,8) CE(10,12) CE(1,9) CE(5,13) CE(5,9) CE(3,11) CE(7,15) CE(7,11) CE(3,5) CE(7,9) CE(11,13) CE(1,2) CE(3,4) CE(5,6) CE(7,8) CE(9,10) CE(11,12) CE(13,14)
#undef CE
    }
#define MERGE16(X, Y, O) do { _Pragma("unroll") for (int i_ = 0; i_ < 16; ++i_) O[i_] = __builtin_fmaxf(X[i_], Y[15 - i_]); \
        _Pragma("unroll") for (int st_ = 8; st_ >= 1; st_ >>= 1) _Pragma("unroll") for (int i_ = 0; i_ < 16; ++i_) if (!(i_ & st_)) { const float a_ = O[i_], b_ = O[i_ + st_]; O[i_] = __builtin_fmaxf(a_, b_); O[i_ + st_] = __builtin_fminf(a_, b_); } } while (0)
    float MA[16], MB[16], L[16];
    MERGE16(G[0], G[1], MA); MERGE16(G[2], G[3], MB); MERGE16(MA, MB, L);
#undef MERGE16
#pragma unroll
    for (int i = 0; i < 8; ++i) { const int j = 15 - i;
        auto ri = __builtin_amdgcn_permlane32_swap(asu(L[i]), asu(L[i]), false, false); auto rj = __builtin_amdgcn_permlane32_swap(asu(L[j]), asu(L[j]), false, false);
        S[i] = __builtin_fmaxf(asf(ri[0]), asf(rj[1])); S[j] = __builtin_fmaxf(asf(rj[0]), asf(ri[1])); }
#pragma unroll
    for (int st = 8; st >= 1; st >>= 1)
#pragma unroll
        for (int i = 0; i < 16; ++i) if (!(i & st)) { const float a = S[i], b = S[i + st]; S[i] = __builtin_fmaxf(a, b); S[i + st] = __builtin_fminf(a, b); }
}
template <bool GEN>
__device__ __forceinline__ void topk_phase_t(Frame& F, int l) {
    const int gw = F.vcu * NWAVES + F.wave, NGW = F.G * NWAVES, lane = mk_lane(), r32 = lane & 31, hi = lane >> 5;
    const bf16* QP = (const bf16*)(F.ws + WS_QP); const bf16* SUBK = (const bf16*)(F.ws + WS_SUBK) + (size_t)l * 8 * 2 * 128 * 128;
    unsigned short* EIDX = (unsigned short*)(F.ws + WS_EIDX); float* GATE = (float*)(F.ws + WS_GATE);
    LAS unsigned char* myl = F.lds + F.wave * 2048 + lane * 32;
    LAS unsigned char* skl = F.lds + 16384;
    const int wpg = GEN ? 0 : F.G / 8;
    const bool bm = wpg >= 8 && wpg % 8 == 0; const int wph = bm ? wpg / 8 : 1;
    const int h_fix = !wpg ? 0 : bm ? (F.vcu % wpg) / wph : F.vcu / wpg;
    if (!GEN) { const bf16* sk = SUBK + (size_t)h_fix * 2 * 128 * 128;
#pragma unroll
        for (int j = 0; j < 8; ++j) { const int c = F.wave * 64 + lane + 512 * j, pp = c >> 11, row = (c >> 4) & 127, c16 = c & 15;
            *(LAS v4u*)(skl + pp * 34816 + row * 272 + c16 * 16) = *(const GAS v4u*)(sk + (size_t)pp * 128 * 128 + row * 128 + c16 * 8); }
        LDS_WAIT(); __syncthreads(); }
    const int tgb = (M / 32) / 8;
    const int it0 = !wpg ? gw : bm ? (F.vcu / wpg) * tgb + ((F.vcu % wpg) % wph) * NWAVES + F.wave : (F.vcu % wpg) * NWAVES + F.wave, itstep = !wpg ? NGW : bm ? wph * NWAVES : wpg * NWAVES, itend = !wpg ? 8 * (M / 32) : bm ? (F.vcu / wpg + 1) * tgb : M / 32;
    for (int item = it0; item < itend; item += itstep) {
        const int h = wpg ? h_fix : item / (M / 32), tg = wpg ? item : item % (M / 32), tok = tg * 32 + r32;
        bf16x8 bq0[8], bq1[8]; const bf16* qp = QP + (size_t)tok * 2048 + h * 256 + 8 * hi;
#pragma unroll
        for (int kc = 0; kc < 8; ++kc) bq0[kc] = *(const GAS bf16x8*)(qp + 16 * kc);
        if (GEN) { __syncthreads();
            const bf16* sk = SUBK + (size_t)h * 2 * 128 * 128;
#pragma unroll
            for (int j = 0; j < 8; ++j) { const int c = F.wave * 64 + lane + 512 * j, pp = c >> 11, row = (c >> 4) & 127, c16 = c & 15;
                *(LAS v4u*)(skl + pp * 34816 + row * 272 + c16 * 16) = *(const GAS v4u*)(sk + (size_t)pp * 128 * 128 + row * 128 + c16 * 8); }
            LDS_WAIT(); __syncthreads(); }
        float S0[16], S1[16];
        topk128_sorted(bq0, skl, hi, r32, S0);
#pragma unroll
        for (int kc = 0; kc < 8; ++kc) bq1[kc] = *(const GAS bf16x8*)(qp + 128 + 16 * kc);
        topk128_sorted(bq1, skl + 34816, hi, r32, S1);
#pragma unroll
        for (int i = 0; i < 16; ++i) { myl[i] = (unsigned char)(asu(S0[i]) & 127u); myl[16 + i] = (unsigned char)(asu(S1[i]) & 127u); }
        const unsigned hi16 = 16u * (unsigned)hi;
#pragma unroll
        for (int i = 0; i < 16; ++i) S0[i] = hi ? (i < 15 ? S0[i + 1] : -3.0e38f) : S0[i];
        float T[16];
#pragma unroll
        for (int j = 0; j < 16; ++j) { const float s = S0[0] + S1[j]; T[j] = asf((asu(s) & ~511u) | (unsigned)(256 + 15 - j)); }
#pragma unroll
        for (int i = 2; i < 16; i += 2)
#pragma unroll
            for (int j = 0; j < 16; ++j) if ((i + 1) * (j + 1) <= 16) { const float s = S0[i] + S1[j]; const float key = asf((asu(s) & ~511u) | (unsigned)(i * 16 + j)); INS16(T, key); }
#pragma unroll
        for (int i = 0; i < 16; ++i) T[i] = asf(asu(T[i]) | hi16);
        { float U[16];
#pragma unroll
            for (int i = 0; i < 8; ++i) { const int j = 15 - i;
                auto ri = __builtin_amdgcn_permlane32_swap(asu(T[i]), asu(T[i]), false, false); auto rj = __builtin_amdgcn_permlane32_swap(asu(T[j]), asu(T[j]), false, false);
                U[i] = __builtin_fmaxf(asf(ri[0]), asf(rj[1])); U[j] = __builtin_fmaxf(asf(rj[0]), asf(ri[1])); }
#pragma unroll
            for (int st = 8; st >= 1; st >>= 1)
#pragma unroll
                for (int i = 0; i < 16; ++i) if (!(i & st)) { const float a = U[i], b = U[i + st]; U[i] = __builtin_fmaxf(a, b); U[i + st] = __builtin_fminf(a, b); }
#pragma unroll
            for (int i = 0; i < 16; ++i) T[i] = U[i]; }
        LDS_WAIT();
        float gt[8]; float Z = 0.f; unsigned ee[8];
#pragma unroll
        for (int k = 0; k < 8; ++k) { const float tv = hi ? T[8 + k] : T[k]; gt[k] = __expf(tv - T[0]); Z += gt[k];
            const unsigned pos = asu(tv) & 511u; const unsigned pi_ = (pos >> 4) & 15u, pj_ = (pos & 15u) ^ ((pos >> 8) * 15u);
            const unsigned n0 = myl[pi_], n1 = myl[16 + pj_]; ee[k] = n0 * 128u + n1; }
        { auto rr = __builtin_amdgcn_permlane32_swap(asu(Z), asu(Z), false, false); Z = asf(rr[0]) + asf(rr[1]); }
        const float rz = 1.0f / Z;
        LDS_WAIT();
        { GAS v4u* ep = (GAS v4u*)(EIDX + (size_t)tok * 128 + h * 16 + 8 * hi);
            v4u e0; e0.x = ee[0] | (ee[1] << 16); e0.y = ee[2] | (ee[3] << 16); e0.z = ee[4] | (ee[5] << 16); e0.w = ee[6] | (ee[7] << 16);
            ep[0] = e0;
            GAS f32x4* gp = (GAS f32x4*)(GATE + (size_t)tok * 128 + h * 16 + 8 * hi);
            gp[0] = (f32x4){gt[0] * rz, gt[1] * rz, gt[2] * rz, gt[3] * rz}; gp[1] = (f32x4){gt[4] * rz, gt[5] * rz, gt[6] * rz, gt[7] * rz}; }
    }
}

__device__ __forceinline__ void topk_phase(Frame& F, int l) { if (F.G >= 8 && F.G % 8 == 0) topk_phase_t<false>(F, l); else topk_phase_t<true>(F, l); }
__device__ __forceinline__ float gelu1(float v) { const f32x2 r = pg8::gelu_pk((f32x2){v, v}); return r.x; }
#ifndef PEER_SSH
#define PEER_SSH 11
#endif
#define PEER_SMASK ((16384u >> PEER_SSH) - 1u)
constexpr int PEER_WLDS = 17424, PEER_N = 512;
constexpr int PEER_O_SU = 1024, PEER_O_GS = 3072, PEER_O_HQ = 5120, PEER_O_ACC = 9216;
static_assert(8 * PEER_WLDS <= PEER_LDS_LIMIT, "gather LDS map");
template <int VAR>
__device__ __forceinline__ void gather_phase(Frame& F, int l, const float* ngain, const float* gain2, float* nout, const XcdBarrier& gbar, bool dry = false) {
    const int lane = mk_lane();
#ifdef PROBE_HOT
    const unsigned emask = dry ? 0xffu : 0x3fffu;
#else
    const unsigned emask = 0x3fffu;
#endif
    const unsigned char* U8 = F.ws + WS_UV + (size_t)l * 16384 * PEER_REC; const unsigned char* V8 = U8 + 512;
    const float* SU = (const float*)(F.ws + WS_SU) + (size_t)l * 16384; const float* SV = (const float*)(F.ws + WS_SV) + (size_t)l * 16384;
    const bf16* HB = (const bf16*)(F.ws + WS_HB); bf16* XRES = (bf16*)(F.ws + WS_XRES); const bf16* XS = (const bf16*)(F.ws + WS_XS); const float* SSQ = (const float*)(F.ws + WS_SSQ);
    const float* sh2 = (const float*)(F.ws + WS_MOD) + (size_t)l * 8 * 6144 + 3 * 1024;
    const unsigned short* EIDX = (const unsigned short*)(F.ws + WS_EIDX); const float* GATE = (const float*)(F.ws + WS_GATE);
    const float* g2 = (const float*)(F.ws + WS_MOD) + (size_t)l * 8 * 6144 + 5 * 1024;
    LAS unsigned char* wl = F.lds + F.wave * PEER_WLDS;
    LAS unsigned short* elist = (LAS unsigned short*)wl; LAS float* sul = (LAS float*)(wl + PEER_O_SU); LAS float* gsl = (LAS float*)(wl + PEER_O_GS);
    LAS unsigned char* hql = wl + PEER_O_HQ; LAS unsigned char* accl = wl + PEER_O_ACC; LAS unsigned* cnt = (LAS unsigned*)(wl + PEER_O_ACC);
#ifdef PEER_ROTX
    const unsigned srot = 2u * xb_xcc_id();
#else
    const unsigned srot = 0u;
#endif
    unsigned ev0[4], ev1[4]; float gt0[4], gt1[4]; v4u ha[4], hb[4]; float ssq1;
    auto BPRE = [&](int t0) __attribute__((always_inline)) {
        ssq1 = SSQ[(size_t)(t0 + (lane >> 4)) * 16 + (lane & 15)];
#pragma unroll
        for (int tk = 0; tk < 4; ++tk) { const size_t tok = (size_t)(t0 + tk);
            ev0[tk] = EIDX[tok * 128 + lane]; ev1[tk] = EIDX[tok * 128 + 64 + lane]; gt0[tk] = GATE[tok * 128 + lane]; gt1[tk] = GATE[tok * 128 + 64 + lane];
            ha[tk] = *(const GAS v4u*)(XS + tok * 1024 + lane * 16); hb[tk] = *(const GAS v4u*)(XS + tok * 1024 + lane * 16 + 8); } };
    const bool bcont = ((M / 32) % F.G) == 0; const int bstep = bcont ? 1 : F.G, bstart = bcont ? F.vcu * ((M / 32) / F.G) : F.vcu, bend = bcont ? bstart + (M / 32) / F.G : M / 32;
    if (bstart < bend) BPRE(bstart * 32 + F.wave * 4);
    for (int blk = bstart; blk < bend; blk += bstep) {
        const int tok0 = blk * 32 + F.wave * 4;
#pragma unroll
        for (int j = 0; j < 4; ++j) cnt[64 * j + lane] = 0u;
        float fa0[4], fa1[4], fb0[4], fb1[4]; int rk0[4], rk1[4];
        {
            float su0[4], su1[4], sv0[4], sv1[4];
#pragma unroll
            for (int tk = 0; tk < 4; ++tk) { su0[tk] = SU[ev0[tk]]; su1[tk] = SU[ev1[tk]]; sv0[tk] = SV[ev0[tk]]; sv1[tk] = SV[ev1[tk]]; }
            f32x4 s4[4]; { const float* shp = sh2 + (size_t)(tok0 >> 12) * 6144 + lane * 16;
#pragma unroll
                for (int j = 0; j < 4; ++j) s4[j] = *(const GAS f32x4*)(shp + 4 * j); }
            float sqs = ssq1; sqs += lshfl(sqs, lane ^ 1); sqs += lshfl(sqs, lane ^ 2); sqs += lshfl(sqs, lane ^ 4); sqs += lshfl(sqs, lane ^ 8);
            float hv[4][16], am[4], sc[4];
#pragma unroll
            for (int tk = 0; tk < 4; ++tk) { const unsigned hw[8] = {ha[tk].x, ha[tk].y, ha[tk].z, ha[tk].w, hb[tk].x, hb[tk].y, hb[tk].z, hb[tk].w};
                const float sq = asf((unsigned)__builtin_amdgcn_readlane((int)asu(sqs), 16 * tk));
                const float rs2 = 1.0f / sqrtf(sq * (1.0f / 1024.0f) + RMS_EPS);
                float m = 0.f;
#pragma unroll
                for (int j = 0; j < 4; ++j) { hv[tk][4 * j] = bflo(hw[2 * j]) * rs2 + s4[j].x; hv[tk][4 * j + 1] = bfhi(hw[2 * j]) * rs2 + s4[j].y; hv[tk][4 * j + 2] = bflo(hw[2 * j + 1]) * rs2 + s4[j].z; hv[tk][4 * j + 3] = bfhi(hw[2 * j + 1]) * rs2 + s4[j].w; }
#pragma unroll
                for (int j = 0; j < 16; ++j) m = __builtin_fmaxf(m, __builtin_fabsf(hv[tk][j]));
                am[tk] = m; }
#pragma unroll
            for (int o = 1; o < 64; o <<= 1) {
#pragma unroll
                for (int tk = 0; tk < 4; ++tk) am[tk] = __builtin_fmaxf(am[tk], lshfl(am[tk], lane ^ o)); }
#pragma unroll
            for (int tk = 0; tk < 4; ++tk) { sc[tk] = am[tk] > 0.f ? am[tk] * (1.0f / 448.0f) : 1.0f; const float inv = 1.0f / sc[tk];
                int qd[4];
#pragma unroll
                for (int g = 0; g < 4; ++g) { int pk = 0; pk = __builtin_amdgcn_cvt_pk_fp8_f32(hv[tk][4 * g] * inv, hv[tk][4 * g + 1] * inv, pk, false); pk = __builtin_amdgcn_cvt_pk_fp8_f32(hv[tk][4 * g + 2] * inv, hv[tk][4 * g + 3] * inv, pk, true); qd[g] = pk; }
                *(LAS v4i*)(hql + tk * 1024 + lane * 16) = (v4i){qd[0], qd[1], qd[2], qd[3]}; }
#pragma unroll
            for (int tk = 0; tk < 4; ++tk) {
                fa0[tk] = su0[tk] * sc[tk]; fa1[tk] = su1[tk] * sc[tk]; fb0[tk] = gt0[tk] * sv0[tk]; fb1[tk] = gt1[tk] * sv1[tk];
                rk0[tk] = (int)__hip_atomic_fetch_add(cnt + ((((ev0[tk] >> PEER_SSH) + srot) & PEER_SMASK) * 4 + tk), 1u, __ATOMIC_RELAXED, __HIP_MEMORY_SCOPE_WORKGROUP);
                rk1[tk] = (int)__hip_atomic_fetch_add(cnt + ((((ev1[tk] >> PEER_SSH) + srot) & PEER_SMASK) * 4 + tk), 1u, __ATOMIC_RELAXED, __HIP_MEMORY_SCOPE_WORKGROUP); } }
        LDS_WAIT();
        { int inc[4], mine[4];
#pragma unroll
            for (int j = 0; j < 4; ++j) { inc[j] = (int)cnt[64 * j + lane]; mine[j] = inc[j]; }
#pragma unroll
            for (int o = 1; o < 64; o <<= 1) {
#pragma unroll
                for (int j = 0; j < 4; ++j) { const int t = lshfl(inc[j], lane - o); inc[j] += (lane >= o) ? t : 0; } }
            int base = 0; LDS_WAIT();
#pragma unroll
            for (int j = 0; j < 4; ++j) { cnt[64 * j + lane] = (unsigned)(base + inc[j] - mine[j]); base += __builtin_amdgcn_readlane(inc[j], 63); } }
        LDS_WAIT();
#pragma unroll
        for (int tk = 0; tk < 4; ++tk) { const int p0 = (int)cnt[(((ev0[tk] >> PEER_SSH) + srot) & PEER_SMASK) * 4 + tk] + rk0[tk], p1 = (int)cnt[(((ev1[tk] >> PEER_SSH) + srot) & PEER_SMASK) * 4 + tk] + rk1[tk];
            elist[p0] = (unsigned short)(ev0[tk] | ((unsigned)tk << 14)); elist[p1] = (unsigned short)(ev1[tk] | ((unsigned)tk << 14));
            sul[p0] = fa0[tk]; sul[p1] = fa1[tk]; gsl[p0] = fb0[tk]; gsl[p1] = fb1[tk]; }
        LDS_WAIT();
#pragma unroll
        for (int tk = 0; tk < 4; ++tk) { *(LAS v4u*)(accl + tk * 2048 + lane * 32) = (v4u){0u, 0u, 0u, 0u}; *(LAS v4u*)(accl + tk * 2048 + lane * 32 + 16) = (v4u){0u, 0u, 0u, 0u}; }
        LDS_WAIT();
        float acc[16]; float csum = 0.f; int cur = -1;
#pragma unroll
        for (int j = 0; j < 16; ++j) acc[j] = 0.f;
        v8i Af[8];
#pragma unroll
        for (int s = 0; s < 8; ++s) { const v4i lo = *(const LAS v4i*)(hql + (lane & 3) * 1024 + 128 * s + 16 * (lane >> 4)), hi4 = *(const LAS v4i*)(hql + (lane & 3) * 1024 + 128 * s + 64 + 16 * (lane >> 4));
            Af[s] = (v8i){lo.x, lo.y, lo.z, lo.w, hi4.x, hi4.y, hi4.z, hi4.w}; }
        LDS_WAIT();
#pragma unroll 1
        for (int b = 0; b < PEER_N / 16; ++b) {
            const unsigned EV = elist[16 * b + (lane & 15)];
            v4u RU[8]; v2u RV[16];
            { const unsigned char* up = U8 + (size_t)((EV & emask) * (unsigned)PEER_REC) + (unsigned)(lane >> 4) * 16u;
#pragma unroll
                for (int s = 0; s < 8; ++s) { if (VAR == 4) RU[s] = (v4u){EV, EV, EV, EV}; else RU[s] = *(const GAS v4u*)(up + 64 * s); } }
#pragma unroll
            for (int k = 0; k < 16; ++k) { const unsigned eb = ((unsigned)__builtin_amdgcn_readlane((int)EV, k) & emask) * (unsigned)PEER_REC; if (VAR == 4) RV[k] = (v2u){eb, eb}; else RV[k] = *(const GAS v2u*)(V8 + eb + (unsigned)lane * 8u); }
            asm volatile("" ::: "memory");
            f32x4 D = (f32x4){0.f, 0.f, 0.f, 0.f};
            if (VAR == 2) D = (f32x4){asf(RU[0].x), asf(RU[1].x), asf(RU[2].x), asf(RU[3].x)}; else {
#pragma unroll
                for (int s = 0; s < 8; ++s) D = __builtin_amdgcn_mfma_scale_f32_16x16x128_f8f6f4(Af[s], (v8i){(int)RU[s].x, (int)RU[s].y, (int)RU[s].z, (int)RU[s].w, 0, 0, 0, 0}, D, 0, 4, 0, 0, 0, 0); }
            const unsigned tkn = EV >> 14; const float z = tkn == 0u ? D[0] : tkn == 1u ? D[1] : tkn == 2u ? D[2] : D[3];
            const int pi = 16 * b + (lane & 15);
            const float wgt = gsl[pi] * gelu1(z * sul[pi]);
#pragma unroll
            for (int k = 0; k < 16; ++k) { const int tk = (int)((unsigned)__builtin_amdgcn_readlane((int)EV, k) >> 14);
                if (VAR != 1 && tk != cur) {
                    if (cur >= 0) { const float corr = 0.f; v4u o0, o1;
                        o0.x = pk2(acc[0] - corr, acc[1] - corr); o0.y = pk2(acc[2] - corr, acc[3] - corr); o0.z = pk2(acc[4] - corr, acc[5] - corr); o0.w = pk2(acc[6] - corr, acc[7] - corr);
                        o1.x = pk2(acc[8] - corr, acc[9] - corr); o1.y = pk2(acc[10] - corr, acc[11] - corr); o1.z = pk2(acc[12] - corr, acc[13] - corr); o1.w = pk2(acc[14] - corr, acc[15] - corr);
                        *(LAS v4u*)(accl + cur * 2048 + lane * 32) = o0; *(LAS v4u*)(accl + cur * 2048 + lane * 32 + 16) = o1; }
                    const v4u i0 = *(const LAS v4u*)(accl + tk * 2048 + lane * 32), i1 = *(const LAS v4u*)(accl + tk * 2048 + lane * 32 + 16);
                    acc[0] = bflo(i0.x); acc[1] = bfhi(i0.x); acc[2] = bflo(i0.y); acc[3] = bfhi(i0.y); acc[4] = bflo(i0.z); acc[5] = bfhi(i0.z); acc[6] = bflo(i0.w); acc[7] = bfhi(i0.w);
                    acc[8] = bflo(i1.x); acc[9] = bfhi(i1.x); acc[10] = bflo(i1.y); acc[11] = bfhi(i1.y); acc[12] = bflo(i1.z); acc[13] = bfhi(i1.z); acc[14] = bflo(i1.w); acc[15] = bfhi(i1.w);
                    csum = 0.f; cur = tk; }
                const float wk = asf((unsigned)__builtin_amdgcn_readlane((int)asu(wgt), k)); const unsigned rw[2] = {RV[k].x, RV[k].y};
                if (VAR == 3) { acc[k & 15] += wk * asf(rw[0] ^ rw[1]); continue; }
#pragma unroll
                for (int d = 0; d < 2; ++d) {
                    const f32x2 p0 = __builtin_amdgcn_cvt_scalef32_pk_f32_fp4(rw[d], 1.0f, 0), p1 = __builtin_amdgcn_cvt_scalef32_pk_f32_fp4(rw[d], 1.0f, 1),
                                p2 = __builtin_amdgcn_cvt_scalef32_pk_f32_fp4(rw[d], 1.0f, 2), p3 = __builtin_amdgcn_cvt_scalef32_pk_f32_fp4(rw[d], 1.0f, 3);
                    acc[8 * d] += wk * p0.x; acc[8 * d + 1] += wk * p0.y; acc[8 * d + 2] += wk * p1.x; acc[8 * d + 3] += wk * p1.y;
                    acc[8 * d + 4] += wk * p2.x; acc[8 * d + 5] += wk * p2.y; acc[8 * d + 6] += wk * p3.x; acc[8 * d + 7] += wk * p3.y; } }
#ifdef PEER_SYNC
            if ((b & (PEER_SYNC - 1)) == PEER_SYNC - 1) __builtin_amdgcn_s_barrier();
#endif
        }
        { const float corr = 0.f; v4u o0, o1;
            o0.x = pk2(acc[0] - corr, acc[1] - corr); o0.y = pk2(acc[2] - corr, acc[3] - corr); o0.z = pk2(acc[4] - corr, acc[5] - corr); o0.w = pk2(acc[6] - corr, acc[7] - corr);
            o1.x = pk2(acc[8] - corr, acc[9] - corr); o1.y = pk2(acc[10] - corr, acc[11] - corr); o1.z = pk2(acc[12] - corr, acc[13] - corr); o1.w = pk2(acc[14] - corr, acc[15] - corr);
            *(LAS v4u*)(accl + cur * 2048 + lane * 32) = o0; *(LAS v4u*)(accl + cur * 2048 + lane * 32 + 16) = o1; }
        LDS_WAIT();
        {
            const int bb = tok0 >> 12; const float* gp = g2 + (size_t)bb * 6144 + lane * 16;
            f32x4 xn[4][4], gq[4]; float s2[4], rstd[4];
#pragma unroll
            for (int tk = 0; tk < 4; ++tk)
#pragma unroll
                for (int q = 0; q < 2; ++q) { const v4u r = *(const GAS v4u*)(XS + (size_t)(tok0 + tk) * 1024 + lane * 16 + q * 8);
                    xn[tk][2 * q] = (f32x4){bflo(r.x), bfhi(r.x), bflo(r.y), bfhi(r.y)}; xn[tk][2 * q + 1] = (f32x4){bflo(r.z), bfhi(r.z), bflo(r.w), bfhi(r.w)}; }
            f32x4 igs[4];
#pragma unroll
            for (int q = 0; q < 4; ++q) { gq[q] = *(const GAS f32x4*)(gp + q * 4);
                const f32x4 gsv = *(const GAS f32x4*)(gain2 + lane * 16 + q * 4) * (*(const GAS f32x4*)(gp - 1024 + q * 4) + 1.0f);
                igs[q] = (f32x4){1.0f / gsv.x, 1.0f / gsv.y, 1.0f / gsv.z, 1.0f / gsv.w}; }
            if (blk + bstep < bend) BPRE((blk + bstep) * 32 + F.wave * 4);
#pragma unroll
            for (int tk = 0; tk < 4; ++tk) {
                const v4u i0 = *(const LAS v4u*)(accl + tk * 2048 + lane * 32), i1 = *(const LAS v4u*)(accl + tk * 2048 + lane * 32 + 16);
                const unsigned iw[8] = {i0.x, i0.y, i0.z, i0.w, i1.x, i1.y, i1.z, i1.w}; float s = 0.f;
#pragma unroll
                for (int q = 0; q < 4; ++q) { const f32x4 o = (f32x4){bflo(iw[2 * q]), bfhi(iw[2 * q]), bflo(iw[2 * q + 1]), bfhi(iw[2 * q + 1])};
                    const f32x4 t = xn[tk][q] * igs[q] + gq[q] * o; xn[tk][q] = t; s += (t.x * t.x + t.y * t.y) + (t.z * t.z + t.w * t.w); }
                s2[tk] = s; }
#pragma unroll
            for (int o = 1; o < 64; o <<= 1) {
#pragma unroll
                for (int tk = 0; tk < 4; ++tk) s2[tk] += lshfl(s2[tk], lane ^ o); }
#pragma unroll
            for (int tk = 0; tk < 4; ++tk) rstd[tk] = 1.0f / sqrtf(s2[tk] * (1.0f / 1024.0f) + RMS_EPS);
            if (dry) {
#pragma unroll
                for (int tk = 0; tk < 4; ++tk)
#pragma unroll
                    for (int q = 0; q < 4; ++q) *(GAS f32x4*)((float*)(F.ws + WS_PROJ) + (size_t)(tok0 + tk) * 1024 + lane * 16 + q * 4) = xn[tk][q] * rstd[tk];
            } else if (l == DEPTH - 1) {
#pragma unroll
                for (int q = 0; q < 4; ++q) { const f32x4 gn = *(const GAS f32x4*)(ngain + lane * 16 + q * 4);
#pragma unroll
                    for (int tk = 0; tk < 4; ++tk) *(GAS f32x4*)(nout + (size_t)(tok0 + tk) * 1024 + lane * 16 + q * 4) = xn[tk][q] * rstd[tk] * gn; }
            } else {
                const float* nsh = (const float*)(F.ws + WS_MOD) + (size_t)(l + 1) * 8 * 6144 + (size_t)bb * 6144 + lane * 16; const bool f8n = ((l + 1) & 1) ? (FP8_ODD != 0) : (FP8_EVEN != 0);
                f32x4 gm[4], sa[4];
#pragma unroll
                for (int q = 0; q < 4; ++q) { const f32x4 gn = *(const GAS f32x4*)(ngain + lane * 16 + q * 4), c = *(const GAS f32x4*)(nsh + 1024 + q * 4); sa[q] = *(const GAS f32x4*)(nsh + q * 4); gm[q] = gn * (c + 1.0f); }
#pragma unroll
                for (int tk = 0; tk < 4; ++tk) { bf16* xr = XRES + (size_t)(tok0 + tk) * 1024 + lane * 16; unsigned xw[8];
#pragma unroll
                    for (int q = 0; q < 4; ++q) { xw[2 * q] = pk2(xn[tk][q].x, xn[tk][q].y); xw[2 * q + 1] = pk2(xn[tk][q].z, xn[tk][q].w); }
                    *(GAS v4u*)xr = (v4u){xw[0], xw[1], xw[2], xw[3]}; *(GAS v4u*)(xr + 8) = (v4u){xw[4], xw[5], xw[6], xw[7]};
                    if (FP8_EVEN && FP8_ODD) { unsigned hw[4];
#pragma unroll
                        for (int q = 0; q < 4; ++q) { const f32x4 hh = xn[tk][q] * rstd[tk] * gm[q] + sa[q]; hw[q] = pk4_fp8x8(hh.x, hh.y, hh.z, hh.w); }
                        *(GAS v4u*)((unsigned char*)HB + (size_t)(tok0 + tk) * 1024 + lane * 16) = (v4u){hw[0], hw[1], hw[2], hw[3]};
                    } else { unsigned char* hp = (unsigned char*)HB + (size_t)(tok0 + tk) * (f8n ? 1024 : 2048) + lane * (f8n ? 16 : 32);
#pragma unroll
                        for (int hf = 0; hf < 2; ++hf) { unsigned hw[4];
#pragma unroll
                            for (int q = 0; q < 4; ++q) { const f32x4 hh = xn[tk][q] * rstd[tk] * gm[q] + sa[q]; hw[q] = pk4_fp8x8(hh.x, hh.y, hh.z, hh.w); }
                            if (!f8n) {
#pragma unroll
                                for (int q = 0; q < 2; ++q) { const f32x4 hh = xn[tk][2 * hf + q] * rstd[tk] * gm[2 * hf + q] + sa[2 * hf + q]; hw[2 * q] = pk2(hh.x, hh.y); hw[2 * q + 1] = pk2(hh.z, hh.w); } }
                            *(GAS v4u*)(hp + (f8n ? 0 : 16 * hf)) = (v4u){hw[0], hw[1], hw[2], hw[3]}; } } } } }
        LDS_WAIT();
#ifdef PEER_BLKSYNC
        if (blk + bstep < bend) xcd_barrier(gbar, F.wave * 64 + lane == 0);
#endif
    }
}
constexpr int N_PHASES = 38;
#ifndef MK_SINGLE
#define MK_SINGLE 1
#endif
__device__ __forceinline__ bool phase_empty(int p) { if (p < 1 || p > 36) return false; const int l = (p - 1) / 9, k = (p - 1) % 9; return k == 3 || (k == 0 && l > 0) || k == 5; }
__global__ void __launch_bounds__(NWAVES * 64, 2) mk_fwd(Args args) {
    extern __shared__ __attribute__((aligned(16))) unsigned char lds[];
    Frame F;
    F.lds = (LAS unsigned char*)lds;
    F.MISC = (volatile LAS unsigned*)(F.lds + MISC_OFF);
    int wave_s = __builtin_amdgcn_readfirstlane((int)(threadIdx.x >> 6));
    for (int u = MK_TID(wave_s); u < (LDS_BYTES - LDSCTL_OFF) / 4; u += NWAVES * 64) ((LAS unsigned*)(F.lds + LDSCTL_OFF))[u] = 0u;
    __syncthreads();
    const int lo = args.ph_lo, hi = args.ph_hi;
    XcdBarrier bar; bar.bar = (unsigned*)(args.ws + WS_CTL) + CW_BAR; bar.x = 0; bar.st = nullptr;
    if (hi - lo > 1) bar = xcd_barrier_post((unsigned*)(args.ws + WS_CTL) + CW_BAR, F.MISC + 8, MK_TID(wave_s) == 0);
    bool again = false;
    for (int p = lo; p < hi; ++p) {
        if (phase_empty(p) || p == 37) continue;
#ifdef PROBE_K
#ifndef PROBE_PARITY
#define PROBE_PARITY_OK(x) true
#else
#define PROBE_PARITY_OK(x) ((x) == PROBE_PARITY)
#endif
        const bool pmatch = (PROBE_K < 0) ? (p == 0) : (p >= 1 && p <= 36 && (p - 1) % 9 == PROBE_K && PROBE_PARITY_OK(((p - 1) / 9) & 1)); const bool dry = pmatch && !again;
#else
        const bool dry = false;
#endif
        KA A; A.kp = (kptr_t)__builtin_amdgcn_kernarg_segment_ptr(); asm volatile("" : "+s"(A.kp));
        { asm volatile("" : "+s"(wave_s)); F.wave = wave_s; F.lane = mk_lane(); F.tid = wave_s * 64 + F.lane;
          int G = gridDim.x, bx = blockIdx.x; asm volatile("" : "+s"(G), "+s"(bx)); F.G = G; F.bx = bx; F.vcu = (G % 8 == 0) ? (bx % 8) * (G / 8) + bx / 8 : bx; }
        unsigned char* ws = A.ws(); F.ws = ws; F.out = A.out(); F.ctl = (gu32*)(ws + WS_CTL);
        bf16* HB = (bf16*)(ws + WS_HB); bf16* MIX = (bf16*)(ws + WS_MIX); bf16* PROJ = (bf16*)(ws + WS_PROJ); bf16* XRES = (bf16*)(ws + WS_XRES);
        if (p == 0) {
#ifndef NO_P0
            p0_prologue(F, A);
#endif
        }
        else {
            const int l = (p - 1) / 9, k = (p - 1) % 9, e = l >> 1; const bool odd = l & 1;
            const float* mod = (const float*)(ws + WS_MOD) + (size_t)l * 8 * 6144;
            if (k == 0) {
#ifndef NO_NORM
                norm_phase(F, A.in(0), A.in(5) + l * 1024, mod, mod + 1024, HB);
                shw_items(F);
#endif
            }
            else if (k == 1) {
#if !defined(NO_GEMM) && !defined(NO_G1E)
                if (!odd) { pg8::Gemm g{HB, (const bf16*)(ws + WS_WINE + (size_t)e * 1536 * 1024 * (FP8_EVEN ? 1 : 2)), M, 1536, FP8_EVEN ? 512 : 1024, FP8_EVEN ? 512 : 1024}; pg8::StaticOrder S; S.init(M, 1536, F.G, F.bx);
                    pg8::EpiActTiles E{PROJ, 1536, 4}; pg8::gemm_phase<pg8::EpiActTiles, pg8::StaticOrder, true, true, FP8_EVEN != 0>(F.lds + RING_OFF, g, S, E, F.wave); }
#endif
#if !defined(NO_GEMM) && !defined(NO_G1O)
                if (odd) { pg8::Gemm g{HB, (const bf16*)(ws + WS_WINO + (size_t)e * 3072 * 1024 * (FP8_ODD ? 1 : 2)), M, 3072, FP8_ODD ? 512 : 1024, FP8_ODD ? 512 : 1024}; pg8::StaticOrder S; S.init(M, 3072, F.G, F.bx);
                    pg8::EpiRope E{PROJ, 3072, (const float*)(ws + WS_ROPE), attn_body::C2}; pg8::gemm_phase<pg8::EpiRope, pg8::StaticOrder, true, true, FP8_ODD != 0>(F.lds + RING_OFF, g, S, E, F.wave); }
#endif
            }
            else if (k == 2) {
                if (!odd) {
#ifndef NO_E2
                    e2_phase(F, A, e);
#endif
                }
                else {
#ifndef NO_ATTN
                    const int lane_ = mk_lane(); const float lam_init = l == 1 ? 0.3555090675909693f : 0.5560582041556405f;
                    const float s1_ = wave_sum(A.in(15)[e * 64 + lane_] * A.in(16)[e * 64 + lane_]), s2_ = wave_sum(A.in(17)[e * 64 + lane_] * A.in(18)[e * 64 + lane_]);
                    const float lam_ = asf((unsigned)__builtin_amdgcn_readfirstlane((int)asu(__expf(s1_) - __expf(s2_) + lam_init)));
                    const attn_body::AttnTensors AT{(const attn_body::bf16*)PROJ, (const attn_body::bf16*)(PROJ + 1024), (const attn_body::bf16*)(PROJ + 2048), (attn_body::bf16*)(ws + WS_OATT), (attn_body::bf16*)(ws + WS_XRES + 64 * MiB), A.in(19) + e * 128, lam_, 1.0f - lam_init};
#ifdef PROBE_AVAR
                    if (dry) attn_body::attn_phase<PROBE_AVAR>((char*)lds + RING_OFF, AT, F.vcu, F.G, F.wave); else
#endif
                    attn_body::attn_phase<0>((char*)lds + RING_OFF, AT, F.vcu, F.G, F.wave);
#endif
                }
            }
            else if (k == 4) {
#if !defined(NO_GEMM) && !defined(NO_G2)
                pg8::Gemm g{odd ? (const bf16*)(ws + WS_XRES + 64 * MiB) : MIX, (const bf16*)(ws + (odd ? WS_WOUTO : WS_WOUTE)) + (size_t)e * 1024 * 1024, M, 1024, 1024, 1024};     pg8::StaticOrder S; S.init(M, 1024, F.G, F.bx);
                if (l == 0) { pg8::EpiResid<true> E{A.in(0), dry ? PROJ : XRES, mod + 2048, 6144, A.in(6) + l * 1024, mod + 4096, (bf16*)(ws + WS_XS), (float*)(ws + WS_SSQ)}; pg8::gemm_phase<pg8::EpiResid<true>, pg8::StaticOrder, true, true>(F.lds + RING_OFF, g, S, E, F.wave); }
                else { pg8::EpiResid<false> E{XRES, dry ? PROJ : XRES, mod + 2048, 6144, A.in(6) + l * 1024, mod + 4096, (bf16*)(ws + WS_XS), (float*)(ws + WS_SSQ)}; pg8::gemm_phase<pg8::EpiResid<false>, pg8::StaticOrder, true, true>(F.lds + RING_OFF, g, S, E, F.wave); }
#endif
            }
            else if (k == 6) {
#if !defined(NO_GEMM) && !defined(NO_G3)
                pg8::Gemm g{(const bf16*)(ws + WS_XS), (const bf16*)(ws + WS_WQ) + (size_t)l * 2048 * 1024, M, 2048, 1024, 1024}; pg8::StaticOrder S; S.init(M, 2048, F.G, F.bx);
#ifdef PROBE_PLAIN3
                if (dry) { pg8::EpiBf16<0> E0{PROJ, 2048, nullptr, 0, 0, 1.f}; pg8::gemm_phase<pg8::EpiBf16<0>, pg8::StaticOrder, true, true>(F.lds + RING_OFF, g, S, E0, F.wave); } else
#endif
                {
                pg8::EpiScaleShift E{(bf16*)(ws + WS_QP), 2048, (const float*)(ws + WS_SSQ), (const float*)(ws + WS_SHW) + (size_t)l * 8 * 2048, 2048, RMS_EPS}; pg8::gemm_phase<pg8::EpiScaleShift, pg8::StaticOrder, true, true>(F.lds + RING_OFF, g, S, E, F.wave);
                }
#endif
            }
            else if (k == 7) {
#ifndef NO_TOPK
                topk_phase(F, l);
#endif
            }
            else {
#ifndef NO_GATHER
#ifdef PROBE_VAR
                if (dry) gather_phase<PROBE_VAR>(F, l, l == DEPTH - 1 ? A.in(25) : A.in(5) + (l + 1) * 1024, A.in(6) + l * 1024, F.out, bar, true); else gather_phase<0>(F, l, l == DEPTH - 1 ? A.in(25) : A.in(5) + (l + 1) * 1024, A.in(6) + l * 1024, F.out, bar, false);
#else
                gather_phase<0>(F, l, l == DEPTH - 1 ? A.in(25) : A.in(5) + (l + 1) * 1024, A.in(6) + l * 1024, F.out, bar, dry);
#endif
#endif
            }
        }
#ifdef PROBE_K
        if (pmatch && !again && PROBE_K != 3) { again = true; xcd_barrier(bar, MK_TID(wave_s) == 0); --p; continue; }
        again = false;
#endif
        if (p + 1 < hi && p < 36) { if (p >= 2 && xcd_local_ok(bar)) xcd_barrier_local(bar, MK_TID(wave_s) == 0); else xcd_barrier(bar, MK_TID(wave_s) == 0); }
#ifndef XCD_STAGGER
#define XCD_STAGGER 1
#endif
        if (XCD_STAGGER && p == 1 && xcd_local_ok(bar)) { for (int i_ = 0; i_ < XCD_STAGGER * (int)(blockIdx.x & 7u); ++i_) __builtin_amdgcn_s_sleep(127); }
    }
}

extern "C" void kernel_launch(void* const* d_in, const int* in_sizes, int n_in, void* d_out, int out_size, void* d_ws, size_t ws_size, hipStream_t stream) {
    static int grid = 0;
    if (grid == 0) {
        if (n_in != 26 || out_size != M * DMODEL || ws_size < WS_END) { fprintf(stderr, "kernel_launch: unexpected problem (n_in %d, out %d, ws %zu; need ws >= %zu)\n", n_in, out_size, ws_size, (size_t)WS_END); grid = -1; return; }
        int dev = 0, cus = 0, per_cu = 0;
        if (hipGetDevice(&dev) != hipSuccess || hipDeviceGetAttribute(&cus, hipDeviceAttributeMultiprocessorCount, dev) != hipSuccess) { grid = -1; return; }
        if (hipFuncSetAttribute((const void*)mk_fwd, hipFuncAttributeMaxDynamicSharedMemorySize, LDS_BYTES) != hipSuccess) { fprintf(stderr, "kernel_launch: hipFuncSetAttribute failed\n"); grid = -1; return; }
        if (hipOccupancyMaxActiveBlocksPerMultiprocessor(&per_cu, (const void*)mk_fwd, NWAVES * 64, LDS_BYTES) != hipSuccess || per_cu < 1) { fprintf(stderr, "kernel_launch: occupancy query says %d blocks per CU\n", per_cu); }
        (void)hipGetLastError();
        grid = cus;
    }
    if (grid < 0) return;
    if (hipMemsetAsync((char*)d_ws + WS_CTL, 0, CTL_ZERO_BYTES, stream) != hipSuccess) return;
    Args a{};
    for (int i = 0; i < 26; ++i) a.in[i] = (const float*)d_in[i];
    a.out = (float*)d_out; a.ws = (unsigned char*)d_ws;
#if MK_SINGLE
    a.ph_lo = 0; a.ph_hi = N_PHASES;
    hipLaunchKernelGGL(mk_fwd, dim3(grid), dim3(NWAVES * 64), LDS_BYTES, stream, a);
#else
    for (int p = 0; p < N_PHASES; ++p) {
        if (p == 37 || (p >= 1 && p <= 36 && ((((p - 1) % 9) == 3 && ((((p - 1) / 9) & 1) == 0)) || (((p - 1) % 9) == 0 && p > 9) || ((p - 1) % 9) == 5))) continue;
        a.ph_lo = p; a.ph_hi = p + 1;
        hipLaunchKernelGGL(mk_fwd, dim3(grid), dim3(NWAVES * 64), LDS_BYTES, stream, a);
    }
#endif
}
```
